# Optimizing an MI355X kernel written in HIP

```python
import math
import jax, jax.numpy as jnp
from jax import lax
import numpy as np

D_MODEL = 2048
BATCH = 4
SEQ = 2048
DEPTH = 1
DEC_BATCH = 32
DEC_SEQ = 16
PAST_LEN = 2048

CHUNK = 64
Q_BLOCK = 128
D_MIX = D_MODEL
D_POOL = D_MIX // 2
POOL_WINDOWS = (2, 4, 8, 16)
N_POOL_GROUPS = len(POOL_WINDOWS)
POOL_GROUP = D_POOL // N_POOL_GROUPS
POOL_HIST = max(POOL_WINDOWS) - 1
N_HEADS = 8
D_NOPE = 128
D_ROPE = 64
D_V = 128
D_MLA = N_HEADS * D_V
Q_RANK = D_MODEL // 4
KV_RANK = D_MODEL // 8
D_PLE = 256
ROPE_THETA = 10000.0
EPS = 1e-6
ATTN_SCALE = (D_NOPE + D_ROPE) ** -0.5
NEG_INF = -1e30
D_IN = 2 * D_POOL + Q_RANK + KV_RANK + D_ROPE + D_MLA
SPLIT_IDX = (D_POOL, 2 * D_POOL, 2 * D_POOL + Q_RANK, 2 * D_POOL + Q_RANK + KV_RANK,
             2 * D_POOL + Q_RANK + KV_RANK + D_ROPE)

kernel_name = 'hymba_pool_mla_streaming_step'


def rms_norm(x, g):
    xf = x.astype(jnp.float32)
    y = xf * lax.rsqrt(jnp.mean(xf * xf, axis=-1, keepdims=True) + EPS)
    return (y * g.astype(jnp.float32)).astype(x.dtype)


def rope_angles(pos):
    inv = ROPE_THETA ** (-(jnp.arange(0, D_ROPE, 2, dtype=jnp.float32) / D_ROPE))
    ang = pos.astype(jnp.float32)[:, None] * inv[None, :]
    return jnp.cos(ang), jnp.sin(ang)


def apply_rope(x, cos, sin):
    xf = x.astype(jnp.float32)
    x1, x2 = xf[..., :D_ROPE // 2], xf[..., D_ROPE // 2:]
    return jnp.concatenate([x1 * cos - x2 * sin, x2 * cos + x1 * sin], axis=-1).astype(x.dtype)


def multiscale_pool(u_hist, u, pos0, w_pool, pool_scale):
    B, T, C = u.shape
    ucat = jnp.concatenate([u_hist, u], axis=1).astype(jnp.float32)
    cs = jnp.concatenate([jnp.zeros((B, 1, C), jnp.float32), jnp.cumsum(ucat, axis=1)], axis=1)
    end = cs[:, POOL_HIST + 1:]
    pos = pos0 + jnp.arange(T)
    means = []
    for gi, w in enumerate(POOL_WINDOWS):
        sl = slice(gi * POOL_GROUP, (gi + 1) * POOL_GROUP)
        start = cs[:, POOL_HIST + 1 - w:POOL_HIST + 1 - w + T, sl]
        cnt = jnp.minimum(pos + 1, w).astype(jnp.float32)[None, :, None]
        means.append((end[..., sl] - start) / cnt)
    d = (jnp.concatenate(means, axis=-1) - u.astype(jnp.float32)).astype(u.dtype)
    d = d.reshape(B, T, N_POOL_GROUPS, POOL_GROUP)
    out = jnp.einsum('btgc,gcd->btgd', d, w_pool).reshape(B, T, C)
    return out * pool_scale


def chunk_causal_attention(q_nope, q_rope, k_nope, k_rope, v, q_pos, k_pos):
    B, T, H, _ = q_nope.shape
    blk = Q_BLOCK if T % Q_BLOCK == 0 else T
    nb = T // blk
    k_chunk = k_pos // CHUNK

    def to_blocks(a):
        return jnp.moveaxis(a.reshape((B, nb, blk) + a.shape[2:]), 1, 0)

    def one_block(args):
        qn, qr, qp = args
        s = (jnp.einsum('bqhd,bkhd->bhqk', qn, k_nope).astype(jnp.float32)
             + jnp.einsum('bqhr,bkr->bhqk', qr, k_rope).astype(jnp.float32)) * ATTN_SCALE
        mask = k_chunk[None, :] <= (qp // CHUNK)[:, None]
        s = jnp.where(mask[None, None], s, NEG_INF)
        pr = jax.nn.softmax(s, axis=-1).astype(v.dtype)
        return jnp.einsum('bhqk,bkhd->bqhd', pr, v)

    out = lax.map(one_block, (to_blocks(q_nope), to_blocks(q_rope), q_pos.reshape(nb, blk)))
    return jnp.moveaxis(out, 0, 1).reshape(B, T, H, D_V)


def hybrid_layer(x, p, pool_hist, ckv_hist, krope_hist, norm_g, w_in, q_norm_g, w_uq, kv_norm_g,
                 w_ukv, q_nope_g, q_rope_g, k_nope_g, k_rope_g, w_pool, pool_scale, w_out,
                 ple_norm_g, w_ple_gate, b_ple_gate, w_ple):
    B, T, _ = x.shape
    pos0 = ckv_hist.shape[1]
    xn = rms_norm(x, norm_g)
    u, g_pool, c_q, c_kv, k_r, g_mla = jnp.split(xn @ w_in, SPLIT_IDX, axis=-1)
    pool_out = multiscale_pool(pool_hist, u, pos0, w_pool, pool_scale) * jax.nn.silu(g_pool)
    new_pool = jnp.concatenate([pool_hist, u], axis=1)[:, -POOL_HIST:]
    q_pos = pos0 + jnp.arange(T)
    cos, sin = rope_angles(q_pos)
    q = (rms_norm(c_q, q_norm_g) @ w_uq).reshape(B, T, N_HEADS, D_NOPE + D_ROPE)
    q_nope = rms_norm(q[..., :D_NOPE], q_nope_g)
    q_rope = apply_rope(rms_norm(q[..., D_NOPE:], q_rope_g), cos[:, None], sin[:, None])
    ckv_new = rms_norm(c_kv, kv_norm_g)
    krope_new = apply_rope(rms_norm(k_r, k_rope_g), cos, sin)
    ckv_all = jnp.concatenate([ckv_hist, ckv_new], axis=1)
    krope_all = jnp.concatenate([krope_hist, krope_new], axis=1)
    S = ckv_all.shape[1]
    kv = (ckv_all @ w_ukv).reshape(B, S, N_HEADS, D_NOPE + D_V)
    k_nope = rms_norm(kv[..., :D_NOPE], k_nope_g)
    v = kv[..., D_NOPE:]
    attn = chunk_causal_attention(q_nope, q_rope, k_nope, krope_all, v, q_pos, jnp.arange(S))
    mla_out = attn.reshape(B, T, D_MLA) * jax.nn.silu(g_mla)
    h = x + jnp.concatenate([pool_out, mla_out], axis=-1) @ w_out
    gate = jax.nn.sigmoid(rms_norm(h, ple_norm_g) @ w_ple_gate + b_ple_gate)
    y = h + gate * (p @ w_ple)
    return y, ckv_new, krope_new, new_pool


def setup_inputs(seed: int = 0) -> dict:
    key = jax.random.key(seed)
    ks = jax.random.split(key, 32)
    f32 = jnp.float32

    def nrm(k, shape, scale=1.0):
        return jax.random.normal(k, shape, f32) * scale

    def gain(k, n):
        return 1.0 + 0.1 * jax.random.normal(k, (DEPTH, n), f32)

    return {
        'x_prompt': nrm(ks[0], (BATCH, SEQ, D_MODEL)),
        'x_sample': nrm(ks[1], (DEC_BATCH, DEC_SEQ, D_MODEL)),
        'cache_ckv': nrm(ks[2], (DEPTH, DEC_BATCH, PAST_LEN, KV_RANK)),
        'cache_krope': nrm(ks[3], (DEPTH, DEC_BATCH, PAST_LEN, D_ROPE)),
        'state_pool': nrm(ks[4], (DEPTH, DEC_BATCH, POOL_HIST, D_POOL)),
        'p_prompt': nrm(ks[5], (DEPTH, BATCH, SEQ, D_PLE)),
        'p_sample': nrm(ks[6], (DEPTH, DEC_BATCH, DEC_SEQ, D_PLE)),
        'norm_g': gain(ks[7], D_MODEL),
        'w_in': nrm(ks[8], (DEPTH, D_MODEL, D_IN), D_MODEL ** -0.5),
        'q_norm_g': gain(ks[9], Q_RANK),
        'w_uq': nrm(ks[10], (DEPTH, Q_RANK, N_HEADS * (D_NOPE + D_ROPE)), Q_RANK ** -0.5),
        'kv_norm_g': gain(ks[11], KV_RANK),
        'w_ukv': nrm(ks[12], (DEPTH, KV_RANK, N_HEADS * (D_NOPE + D_V)), KV_RANK ** -0.5),
        'q_nope_g': gain(ks[13], D_NOPE),
        'q_rope_g': gain(ks[14], D_ROPE),
        'k_nope_g': gain(ks[15], D_NOPE),
        'k_rope_g': gain(ks[16], D_ROPE),
        'w_pool': nrm(ks[17], (DEPTH, N_POOL_GROUPS, POOL_GROUP, POOL_GROUP), POOL_GROUP ** -0.5),
        'pool_scale': gain(ks[18], D_POOL),
        'w_out': nrm(ks[19], (DEPTH, D_MIX, D_MODEL), D_MIX ** -0.5),
        'ple_norm_g': gain(ks[20], D_MODEL),
        'w_ple_gate': nrm(ks[21], (DEPTH, D_MODEL, D_MODEL), D_MODEL ** -0.5),
        'b_ple_gate': nrm(ks[22], (DEPTH, D_MODEL), 0.01),
        'w_ple': nrm(ks[23], (DEPTH, D_PLE, D_MODEL), D_PLE ** -0.5),
    }


def reference(x_prompt, x_sample, cache_ckv, cache_krope, state_pool, p_prompt, p_sample,
              norm_g, w_in, q_norm_g, w_uq, kv_norm_g, w_ukv, q_nope_g, q_rope_g, k_nope_g,
              k_rope_g, w_pool, pool_scale, w_out, ple_norm_g, w_ple_gate, b_ple_gate, w_ple):
    yp, ys = x_prompt, x_sample
    B, dt = x_prompt.shape[0], x_prompt.dtype
    ckv_p, kr_p, pool_p, ckv_s, kr_s, pool_s = [], [], [], [], [], []
    for i in range(DEPTH):
        w = (norm_g[i], w_in[i], q_norm_g[i], w_uq[i], kv_norm_g[i], w_ukv[i], q_nope_g[i],
             q_rope_g[i], k_nope_g[i], k_rope_g[i], w_pool[i], pool_scale[i], w_out[i],
             ple_norm_g[i], w_ple_gate[i], b_ple_gate[i], w_ple[i])
        yp, c1, k1, s1 = hybrid_layer(
            yp, p_prompt[i], jnp.zeros((B, POOL_HIST, D_POOL), dt),
            jnp.zeros((B, 0, KV_RANK), dt), jnp.zeros((B, 0, D_ROPE), dt), *w)
        ys, c2, k2, s2 = hybrid_layer(ys, p_sample[i], state_pool[i], cache_ckv[i], cache_krope[i], *w)
        ckv_p.append(c1); kr_p.append(k1); pool_p.append(s1)
        ckv_s.append(c2); kr_s.append(k2); pool_s.append(s2)
    return (yp, ys, jnp.stack(ckv_p), jnp.stack(kr_p), jnp.stack(pool_p),
            jnp.stack(ckv_s), jnp.stack(kr_s), jnp.stack(pool_s))
```

```cpp
#include <hip/hip_runtime.h>
#include <hip/hip_bf16.h>
#include <cstdio>
#include <cstdint>

#ifndef DUP_PHASE
#define DUP_PHASE -1
#endif
#ifndef MK_N_LAUNCHES
#define MK_N_LAUNCHES 1
#endif

#define LAS __attribute__((address_space(3)))
#define GAS __attribute__((address_space(1)))
typedef unsigned short bf16_t;
typedef short bf16x8 __attribute__((ext_vector_type(8)));
typedef short s16x4 __attribute__((ext_vector_type(4)));
typedef float f32x4 __attribute__((ext_vector_type(4)));
typedef float f32x16 __attribute__((ext_vector_type(16)));
typedef unsigned u32x4 __attribute__((ext_vector_type(4)));
typedef unsigned u32x2 __attribute__((ext_vector_type(2)));
typedef float f32x2_t __attribute__((ext_vector_type(2)));
typedef __bf16 bf16x2_t __attribute__((ext_vector_type(2)));

constexpr int DM = 2048, NBATCH = 4, SEQ = 2048, DBATCH = 32, DSEQ = 16, PAST = 2048;
constexpr int MP = NBATCH * SEQ, MS = DBATCH * DSEQ, MT = MP + MS;
constexpr int DPOOL = 1024, NHEAD = 8, DNOPE = 128, DROPE = 64, DV = 128, QRANK = 512, KVRANK = 256, DPLE = 256;
constexpr int DQK = DNOPE + DROPE;
constexpr int DIN = 3904, DINP = 4096;
constexpr int SKV_S = PAST + DSEQ;
constexpr int POOLH = 15;
constexpr int MZ = 9216;
constexpr float EPS = 1e-6f;
constexpr float C2 = 0.07216878364870322f * 1.4426950408889634f;
constexpr size_t O_Y = 0, O_CKVP = 17825792, O_KRP = 19922944, O_POOLP = 20447232, O_CKVS = 20508672, O_KRS = 20639744, O_POOLS = 20672512;

constexpr size_t MiB = 1u << 20;
constexpr size_t WS_CTL = 0, CTL_ZERO_BYTES = 128 * 1024;
constexpr size_t WS_WIN = 1 * MiB;
constexpr size_t WS_WUQ = 17 * MiB;
constexpr size_t WS_WUKV = 18 * MiB + MiB / 2;
constexpr size_t WS_WPOOL = 19 * MiB + MiB / 2;
constexpr size_t WS_WOUT = 20 * MiB;
constexpr size_t WS_WGATE = 28 * MiB;
constexpr size_t WS_WPLE = 36 * MiB;
constexpr size_t WS_COS = 37 * MiB;
constexpr size_t WS_SIN = 37 * MiB + MiB / 2;
constexpr size_t WS_SSQCQ = 38 * MiB;
constexpr size_t WS_SSQH = 38 * MiB + MiB / 2;
constexpr size_t WS_CKVN = 39 * MiB;
constexpr size_t WS_KRN = 43 * MiB + MiB / 2;
constexpr size_t WS_PBF = 45 * MiB;
constexpr size_t WS_XN = 49 * MiB + MiB / 2;
constexpr size_t WS_CKVB = WS_XN;
constexpr size_t WS_KRB = 227 * MiB;
constexpr int CKVT_LD = 2080; constexpr size_t CKVT_B = (size_t)KVRANK * CKVT_LD * 2; constexpr int NBT_A = 20;
constexpr size_t WS_CKVT_A = 235 * MiB, WS_CKVT_B = WS_WIN;
constexpr int NB_EARLY = 0;
constexpr size_t WS_CKVB2 = WS_CKVT_A;
constexpr size_t WS_UBF = 83 * MiB + MiB / 2;
constexpr size_t WS_CQ = 101 * MiB + MiB / 2;
constexpr size_t WS_MIX = WS_UBF;
constexpr size_t WS_SGP = 117 * MiB + MiB / 2;
constexpr size_t WS_Z = 134 * MiB + MiB / 2;
constexpr size_t WS_PV = WS_SGP;
constexpr size_t WS_SGM = 152 * MiB + MiB / 2;
constexpr size_t WS_QCAT = 169 * MiB + MiB / 2;
constexpr size_t WS_KCAT = 195 * MiB;
constexpr size_t WS_HBF = WS_QCAT;
constexpr size_t WS_V = 211 * MiB;
constexpr size_t WS_END = 256 * MiB;
static_assert(WS_MIX + (size_t)MT * DM * 2 <= WS_SGP && WS_PV + (size_t)MT * DM * 2 <= WS_SGM && WS_HBF + (size_t)MT * DM * 2 <= WS_V && WS_END <= 256 * MiB, "d_ws map");
static_assert(WS_CKVB + (size_t)DBATCH * 1064960 <= WS_UBF && WS_KRB + (size_t)DBATCH * PAST * DROPE * 2 <= WS_CKVT_A && WS_CKVT_A + NBT_A * CKVT_B <= WS_END && (DBATCH - NBT_A) * CKVT_B <= 16 * MiB && WS_V + 16 * MiB <= WS_KRB, "d_ws map (cache copies)");

constexpr int RING_BYTES = 131072;
constexpr int SCR_OFF = RING_BYTES;
constexpr int SCR_BYTES = 16384;
constexpr int MISC_OFF = SCR_OFF + SCR_BYTES;
constexpr int LDS_BYTES = 151552;

#define LDS_WAIT() asm volatile("s_waitcnt lgkmcnt(0)" ::: "memory")
#define VM_WAIT() asm volatile("s_waitcnt vmcnt(0)" ::: "memory")
#define WG_BAR() do { asm volatile("s_waitcnt lgkmcnt(0)" ::: "memory"); __builtin_amdgcn_s_barrier(); asm volatile("" ::: "memory"); } while (0)
#define SBAR() __builtin_amdgcn_sched_barrier(0)
__device__ __forceinline__ unsigned cvtpk(float lo, float hi) { f32x2_t v = {lo, hi}; bf16x2_t b = __builtin_convertvector(v, bf16x2_t); return __builtin_bit_cast(unsigned, b); }
__device__ __forceinline__ u32x4 pack8(f32x4 a, f32x4 b) { u32x4 w; w.x = cvtpk(a[0], a[1]); w.y = cvtpk(a[2], a[3]); w.z = cvtpk(b[0], b[1]); w.w = cvtpk(b[2], b[3]); return w; }
typedef __amdgpu_buffer_rsrc_t rsrc_t;
__device__ __forceinline__ rsrc_t make_rsrc(const void* p, unsigned bytes) { return __builtin_amdgcn_make_buffer_rsrc(const_cast<void*>(p), 0, bytes, 0x00020000); }
__device__ __forceinline__ void st16_wt(rsrc_t r, unsigned byteoff, u32x4 v) { __builtin_amdgcn_raw_buffer_store_b128(v, r, byteoff, 0, 16); }
__device__ __forceinline__ void st16_wt(rsrc_t r, unsigned byteoff, f32x4 v) { __builtin_amdgcn_raw_buffer_store_b128(__builtin_bit_cast(u32x4, v), r, byteoff, 0, 16); }
__device__ __forceinline__ float bf2f(unsigned short h) { return __uint_as_float((unsigned)h << 16); }
__device__ __forceinline__ float silu_f(float v) { return v / (1.f + __expf(-v)); }
__device__ __forceinline__ float sigmoid_f(float v) { return 1.f / (1.f + __expf(-v)); }
__device__ __forceinline__ float wave_sum(float v) {
#pragma unroll
    for (int o = 1; o < 64; o <<= 1) v += __shfl_xor(v, o);
    return v;
}
__device__ __forceinline__ int lane_id() { int l; asm volatile("v_mbcnt_lo_u32_b32 %0, -1, 0\n\tv_mbcnt_hi_u32_b32 %0, -1, %0" : "=v"(l)); return l; }
#define TIDX(wv) (((wv) << 6) | lane_id())
__device__ __forceinline__ int row_pos(int row) { return row < MP ? (row & (SEQ - 1)) : PAST + ((row - MP) & (DSEQ - 1)); }

#define AS4 __attribute__((address_space(4)))
__device__ __forceinline__ const float* arg_in(int k) {
    const char AS4* p = (const char AS4*)__builtin_amdgcn_kernarg_segment_ptr(); int off = k * 8; asm volatile("" : "+s"(off));
    return *(const float* const AS4*)(p + off);
}
#define AIN(k) arg_in(k)

namespace pg8 {
constexpr int BM = 256, BK = 64, HALF = 128, HTB = HALF * BK * 2, STAGE_BYTES = 8 * HTB, NXCD = 8, WGM = 8;
__host__ __device__ __forceinline__ int lds_byte(int r, int c) { const int st = (r >> 4) * 2 + (c >> 5), rr = r & 15, cc = c & 31, ob = rr * 64 + cc * 2; return st * 1024 + (ob ^ (((ob >> 9) & 1) << 5)); }
__host__ __device__ __forceinline__ void stage_rc(int b, int& R, int& C) { const int st = b / 1024, sb = b % 1024, swz = sb ^ (((sb >> 9) & 1) << 5); R = (st >> 1) * 16 + swz / 64; C = (st & 1) * 32 + (swz % 64) / 2; }
__host__ __device__ __forceinline__ int perm32(int rho) { const int n = rho >> 4, i = rho & 15; return 8 * (i >> 2) + 4 * n + (i & 3); }

struct Unit { const char* A; const char* B; int lda, ldb, nt, type, row0, pn, half, slice, uid; };
__device__ __forceinline__ void grid_map(int L, int nM, int nN, int& pm, int& pn) {
    const int nwg = nM * nN; int wgid = L; { const int q = nwg / NXCD, r = nwg % NXCD, xcd = wgid % NXCD, off = wgid / NXCD; wgid = (xcd < r ? xcd * (q + 1) : r * (q + 1) + (xcd - r) * q) + off; }
    const int nig = WGM * nN, gid = wgid / nig, fm = gid * WGM, gsz = (nM - fm) < WGM ? (nM - fm) : WGM;
    pm = fm + ((wgid % nig) % gsz); pn = (wgid % nig) / gsz;
}

template <class Sched, class Epi>
__device__ __forceinline__ void gemm_phase(LAS unsigned char* lds, LAS unsigned char* scr, const Sched& S, const Epi& E, int wv) {
    const int wid = wv, lane = lane_id(), tid = (wv << 6) | lane, wr = wid >> 2, wc = wid & 3, fr = lane & 15, fq = lane >> 4;
    Unit cur, nxt; int ui = 0;
    if (!S.get(0, cur)) return;
    int RA[2], RB[2], CC[2];
#pragma unroll
    for (int i = 0; i < 2; ++i) { int R, C; stage_rc(tid * 16 + i * 8192, R, C); RA[i] = R * 2; RB[i] = ((R & ~31) + perm32(R & 31)) * 2; CC[i] = C * 2; }
    unsigned voffA[2], voffB[2], nvA[2], nvB[2];
#pragma unroll
    for (int i = 0; i < 2; ++i) { voffA[i] = (unsigned)(RA[i] * cur.lda + CC[i]); voffB[i] = (unsigned)(RB[i] * cur.ldb + CC[i]); }
    const size_t kstep = (size_t)(BK * 2);
    unsigned hA = cur.half ? 0u : (unsigned)(HALF * cur.lda * 2), hB = (unsigned)(HALF * cur.ldb * 2);
    const unsigned ldsw = (unsigned)wid * 1024u;
    const int aoff = lds_byte(wr * 64 + fr, fq * 8), boff = lds_byte(wc * 32 + fr, fq * 8);
#define PG8_SA(b, h) (((b) * 2 + (h)) * HTB)
#define PG8_SB(b, h) ((4 + (b) * 2 + (h)) * HTB)
#define PG8_STAGE(bufoff, gbase, voff) do { _Pragma("unroll") for (int _i = 0; _i < 2; ++_i) \
        __builtin_amdgcn_global_load_lds((const unsigned*)((const char*)(gbase) + (voff)[_i]), (LAS unsigned*)(lds + (bufoff) + ldsw + _i * 8192), 16, 0, 0); } while (0)
#define PG8_LDA(dst, b, h) do { _Pragma("unroll") for (int m = 0; m < 4; ++m) _Pragma("unroll") for (int k = 0; k < 2; ++k) dst[m][k] = *(const LAS bf16x8*)(lds + PG8_SA(b, h) + aoff + m * 2048 + k * 1024); } while (0)
#define PG8_LDB(dst, b, h) do { _Pragma("unroll") for (int n = 0; n < 2; ++n) _Pragma("unroll") for (int k = 0; k < 2; ++k) dst[n][k] = *(const LAS bf16x8*)(lds + PG8_SB(b, h) + boff + n * 2048 + k * 1024); } while (0)
#define PG8_MMA(ai, bj, At, Bt) do { __builtin_amdgcn_s_setprio(1); _Pragma("unroll") for (int m = 0; m < 4; ++m) _Pragma("unroll") for (int n = 0; n < 2; ++n) _Pragma("unroll") for (int k = 0; k < 2; ++k) \
        acc[ai][bj][m][n] = __builtin_amdgcn_mfma_f32_16x16x32_bf16(Bt[n][k], At[m][k], acc[ai][bj][m][n], 0, 0, 0); __builtin_amdgcn_s_setprio(0); } while (0)
#define PG8_WAIT_V(n) asm volatile("s_waitcnt vmcnt(" #n ")" ::: "memory")
#define PG8_WAIT_L(n) asm volatile("s_waitcnt lgkmcnt(" #n ")" ::: "memory")
#define PG8_BAR __builtin_amdgcn_s_barrier()
#define PG8_SCHED __builtin_amdgcn_sched_barrier(0)
    f32x4 acc[2][2][4][2];
    { int fr_e = fr, fq_e = fq; asm volatile("" : "+v"(fr_e), "+v"(fq_e)); E.init(acc, cur, wr, wc, fr_e, fq_e); }
    bf16x8 At[4][2], B0[2][2], B1[2][2];
    const char* cA = cur.A; const char* cB = cur.B;
    int rot = ((S.c & 7) * cur.nt) >> 3, nrot = 0;
    S.a_ready(cur, wid);
    { const size_t k0 = (size_t)rot * kstep, k1 = (size_t)((rot + 1) & (cur.nt - 1)) * kstep;
    PG8_STAGE(PG8_SB(0, 0), cB + k0, voffB); PG8_STAGE(PG8_SB(0, 1), cB + hB + k0, voffB); PG8_STAGE(PG8_SA(0, 0), cA + k0, voffA); PG8_STAGE(PG8_SA(0, 1), cA + hA + k0, voffA);
    if (wr == 1) PG8_BAR;
    PG8_WAIT_V(2); PG8_BAR;
    PG8_STAGE(PG8_SB(1, 0), cB + k1, voffB); PG8_STAGE(PG8_SA(1, 0), cA + k1, voffA); PG8_STAGE(PG8_SB(1, 1), cB + hB + k1, voffB); }
    PG8_WAIT_V(6); PG8_BAR;
    for (;;) {
        const bool has_next = S.get(ui + 1, nxt);
        if (!has_next) nxt = cur;
#pragma unroll
        for (int i = 0; i < 2; ++i) { nvA[i] = (unsigned)(RA[i] * nxt.lda + CC[i]); nvB[i] = (unsigned)(RB[i] * nxt.ldb + CC[i]); }
        const unsigned nhA = nxt.half ? 0u : (unsigned)(HALF * nxt.lda * 2), nhB = (unsigned)(HALF * nxt.ldb * 2);
        const char* nA = nxt.A; const char* nB = nxt.B; nrot = ((S.c & 7) * nxt.nt) >> 3; const int nmask = nxt.nt - 1;
        int nt = __builtin_amdgcn_readfirstlane(cur.nt); asm volatile("" : "+s"(nt));
        const bool full = !cur.half;
        for (int t = 0; t < nt; t += 2) {
            const bool last = (t == nt - 2);
            if (last && has_next) S.a_ready(nxt, wid);
            const size_t o1 = (size_t)((t + 1 + rot) & (nt - 1)) * kstep;
            const size_t o2 = (size_t)(last ? (nrot & nmask) : ((t + 2 + rot) & (nt - 1))) * kstep, o3 = (size_t)(last ? ((nrot + 1) & nmask) : ((t + 3 + rot) & (nt - 1))) * kstep;
            const char* a1 = cA + o1;
            const char* a2 = (last ? nA : cA) + o2; const char* b2 = (last ? nB : cB) + o2;
            const char* a3 = (last ? nA : cA) + o3; const char* b3 = (last ? nB : cB) + o3;
            const unsigned hA2 = last ? nhA : hA, hB2 = last ? nhB : hB;
            unsigned vA2[2], vB2[2];
#pragma unroll
            for (int i = 0; i < 2; ++i) { vA2[i] = last ? nvA[i] : voffA[i]; vB2[i] = last ? nvB[i] : voffB[i]; }
            PG8_LDB(B0, 0, 0); PG8_LDB(B1, 0, 1); PG8_SCHED; PG8_LDA(At, 0, 0); PG8_STAGE(PG8_SA(1, 1), a1 + hA, voffA);
            PG8_WAIT_V(8); PG8_WAIT_L(0); PG8_BAR; PG8_MMA(0, 0, At, B0); PG8_MMA(0, 1, At, B1); PG8_BAR; PG8_SCHED;
            if (full) PG8_LDA(At, 0, 1);
            PG8_STAGE(PG8_SB(0, 0), b2, vB2); PG8_STAGE(PG8_SB(0, 1), b2 + hB2, vB2); PG8_STAGE(PG8_SA(0, 0), a2, vA2);
            PG8_WAIT_V(8); PG8_WAIT_L(0); PG8_BAR; if (full) { PG8_MMA(1, 0, At, B0); PG8_MMA(1, 1, At, B1); } PG8_BAR; PG8_SCHED;
            PG8_LDB(B0, 1, 0); PG8_LDB(B1, 1, 1); PG8_SCHED; PG8_LDA(At, 1, 0); PG8_STAGE(PG8_SA(0, 1), a2 + hA2, vA2);
            PG8_WAIT_V(8); PG8_WAIT_L(0); PG8_BAR; PG8_MMA(0, 0, At, B0); PG8_MMA(0, 1, At, B1); PG8_BAR; PG8_SCHED;
            if (full) PG8_LDA(At, 1, 1);
            PG8_STAGE(PG8_SB(1, 0), b3, vB2); PG8_STAGE(PG8_SB(1, 1), b3 + hB2, vB2); PG8_STAGE(PG8_SA(1, 0), a3, vA2);
            PG8_WAIT_V(8); PG8_WAIT_L(0); PG8_BAR; if (full) { PG8_MMA(1, 0, At, B0); PG8_MMA(1, 1, At, B1); } PG8_BAR; PG8_SCHED;
        }
        if (wr == 0) PG8_BAR;
        bool run_epi = true;
        if constexpr (Sched::SPLITK) {
            if (cur.slice >= 0) {
                constexpr int NSLICE = 4; constexpr unsigned SLABB = HALF * BM * 4;
                float* sl = S.slab(cur); const rsrc_t rs = make_rsrc(sl, NSLICE * SLABB); const unsigned lo = (unsigned)(wid * 16 * 64 + lane) * 16u;
#pragma unroll
                for (int bj = 0; bj < 2; ++bj)
#pragma unroll
                    for (int m = 0; m < 4; ++m)
#pragma unroll
                        for (int n = 0; n < 2; ++n) st16_wt(rs, (unsigned)cur.slice * SLABB + lo + (unsigned)(bj * 8 + m * 2 + n) * 1024u, acc[0][bj][m][n]);
                asm volatile("s_waitcnt vmcnt(0)" ::: "memory");
                PG8_BAR; asm volatile("" ::: "memory");
                volatile LAS unsigned* TK = (volatile LAS unsigned*)(lds + MISC_OFF) + 27;
                if (wid == 0 && lane == 0) { const unsigned old = __hip_atomic_fetch_add(S.ticket(cur), 1u, __ATOMIC_RELAXED, __HIP_MEMORY_SCOPE_AGENT);
                    if (old == NSLICE - 1) { __builtin_amdgcn_fence(__ATOMIC_ACQUIRE, "agent"); asm volatile("s_waitcnt vmcnt(0)" ::: "memory"); }
                    *TK = old; }
                asm volatile("s_waitcnt lgkmcnt(0)" ::: "memory"); PG8_BAR; asm volatile("" ::: "memory");
                run_epi = (*TK == NSLICE - 1);
                if (run_epi) {
#pragma unroll
                    for (int sp = 0; sp < NSLICE; ++sp) if (sp != cur.slice) { const char* ob = (const char*)sl + (size_t)sp * SLABB + lo;
#pragma unroll
                        for (int bj = 0; bj < 2; ++bj)
#pragma unroll
                            for (int m = 0; m < 4; ++m)
#pragma unroll
                                for (int n = 0; n < 2; ++n) acc[0][bj][m][n] += *(const f32x4*)(ob + (bj * 8 + m * 2 + n) * 1024); }
                }
                asm volatile("s_waitcnt lgkmcnt(0)" ::: "memory"); PG8_BAR; asm volatile("" ::: "memory");
            }
        }
        if (run_epi) {
        { int fr_e = fr, fq_e = fq; asm volatile("" : "+v"(fr_e), "+v"(fq_e));
          E(acc, cur, wr, wc, fr_e, fq_e, scr); }
        S.done(cur, wid);
        }
        if (!has_next) break;
        { int fr_e = fr, fq_e = fq; asm volatile("" : "+v"(fr_e), "+v"(fq_e)); E.init(acc, nxt, wr, wc, fr_e, fq_e); }
        cur = nxt; cA = nA; cB = nB; hA = nhA; hB = nhB; rot = nrot; ++ui;
#pragma unroll
        for (int i = 0; i < 2; ++i) { voffA[i] = nvA[i]; voffB[i] = nvB[i]; }
        if (wr == 1) PG8_BAR;
    }
    PG8_WAIT_V(0);
    PG8_BAR;
#undef PG8_SA
#undef PG8_SB
#undef PG8_STAGE
#undef PG8_LDA
#undef PG8_LDB
#undef PG8_MMA
#undef PG8_WAIT_V
#undef PG8_WAIT_L
#undef PG8_BAR
#undef PG8_SCHED
}

typedef f32x4 Acc[2][2][4][2];
__device__ __forceinline__ void acc_zero(Acc& acc) {
#pragma unroll
    for (int a = 0; a < 2; ++a)
#pragma unroll
        for (int b = 0; b < 2; ++b)
#pragma unroll
            for (int m = 0; m < 4; ++m)
#pragma unroll
                for (int n = 0; n < 2; ++n) acc[a][b][m][n] = (f32x4){0.f, 0.f, 0.f, 0.f};
}
#define EPI_INIT_ZERO __device__ __forceinline__ void init(Acc& acc, const Unit&, int, int, int, int) const { acc_zero(acc); }
template <int NG>
__device__ __forceinline__ void xwave_rowsum(float (&p)[NG][2][4], LAS unsigned char* scr, int wr, int wc, int fr, int fq) {
    LAS float* red = (LAS float*)scr;
    if (fq == 0) {
#pragma unroll
        for (int gq = 0; gq < NG; ++gq)
#pragma unroll
            for (int ai = 0; ai < 2; ++ai)
#pragma unroll
                for (int m = 0; m < 4; ++m) red[gq * 1024 + (ai * HALF + wr * 64 + m * 16 + fr) * 4 + wc] = p[gq][ai][m];
    }
    WG_BAR();
#pragma unroll
    for (int gq = 0; gq < NG; ++gq)
#pragma unroll
        for (int ai = 0; ai < 2; ++ai)
#pragma unroll
            for (int m = 0; m < 4; ++m) { const f32x4 v = *(const LAS f32x4*)(red + gq * 1024 + (ai * HALF + wr * 64 + m * 16 + fr) * 4); p[gq][ai][m] = (v[0] + v[1]) + (v[2] + v[3]); }
    WG_BAR();
}
__device__ __forceinline__ float sq4(f32x4 v) { return (v[0] * v[0] + v[1] * v[1]) + (v[2] * v[2] + v[3] * v[3]); }
__device__ __forceinline__ float fq_sum(float s) { s += __shfl_xor(s, 16); s += __shfl_xor(s, 32); return s; }

struct EpiBf16 {
    EPI_INIT_ZERO
    bf16_t* O; int ldc; int wt;
    __device__ __forceinline__ void operator()(Acc& acc, const Unit& u, int wr, int wc, int fr, int fq, LAS unsigned char*) const {
        const int row0 = u.row0 + wr * 64 + fr, col0 = u.pn * BM + wc * 32 + 8 * fq;
        if (wt) { const rsrc_t rO = make_rsrc(O, (unsigned)MT * DM * 2);
#pragma unroll
            for (int ai = 0; ai < 2; ++ai) if (ai == 0 || !u.half)
#pragma unroll
                for (int m = 0; m < 4; ++m) { const unsigned off = (unsigned)((row0 + ai * HALF + m * 16) * ldc + col0) * 2u;
#pragma unroll
                    for (int bj = 0; bj < 2; ++bj) st16_wt(rO, off + bj * HALF * 2, pack8(acc[ai][bj][m][0], acc[ai][bj][m][1])); }
            return; }
#pragma unroll
        for (int ai = 0; ai < 2; ++ai) if (ai == 0 || !u.half)
#pragma unroll
            for (int m = 0; m < 4; ++m) { bf16_t* rp = O + (size_t)(row0 + ai * HALF + m * 16) * ldc + col0;
#pragma unroll
                for (int bj = 0; bj < 2; ++bj) *(u32x4*)(rp + bj * HALF) = pack8(acc[ai][bj][m][0], acc[ai][bj][m][1]); }
    }
};

struct EpiInProj {
    EPI_INIT_ZERO
    unsigned char* ws; float* out;
    __device__ __forceinline__ void operator()(Acc& acc, const Unit& u, int wr, int wc, int fr, int fq, LAS unsigned char* scr) const {
        const float* kvg = arg_in(11); const float* krg = arg_in(16);
        bf16_t* UBF = (bf16_t*)(ws + WS_UBF); bf16_t* SGP = (bf16_t*)(ws + WS_SGP); bf16_t* CQ = (bf16_t*)(ws + WS_CQ); bf16_t* CKVN = (bf16_t*)(ws + WS_CKVN); bf16_t* SGM = (bf16_t*)(ws + WS_SGM); bf16_t* KRN = (bf16_t*)(ws + WS_KRN);
        float* SSQCQ = (float*)(ws + WS_SSQCQ); const float* COS = (const float*)(ws + WS_COS); const float* SIN = (const float*)(ws + WS_SIN);
        const int row0 = u.row0 + wr * 64 + fr, cl = wc * 32 + 8 * fq, pn = u.pn;
        if (pn < 4) {
            const bool tail = (((u.row0 >> 8) & 7) == 7) || (u.row0 >= MP);
#pragma unroll
            for (int ai = 0; ai < 2; ++ai) if (ai == 0 || !u.half)
#pragma unroll
                for (int m = 0; m < 4; ++m) { const int row = row0 + ai * HALF + m * 16; bf16_t* rp = UBF + (size_t)row * DPOOL + pn * BM + cl;
#pragma unroll
                    for (int bj = 0; bj < 2; ++bj) *(u32x4*)(rp + bj * HALF) = pack8(acc[ai][bj][m][0], acc[ai][bj][m][1]);
                    if (tail) { float* dst = nullptr;
                        if (row < MP) { const int t = row & (SEQ - 1), b = row >> 11; if (t >= SEQ - POOLH) dst = out + O_POOLP + (size_t)(b * POOLH + t - (SEQ - POOLH)) * DPOOL; }
                        else { const int s = row - MP, b = s >> 4, t = s & 15; if (t >= 1) dst = out + O_POOLS + (size_t)(b * POOLH + t - 1) * DPOOL; }
                        if (dst) { dst += pn * BM + cl;
#pragma unroll
                            for (int bj = 0; bj < 2; ++bj) { *(f32x4*)(dst + bj * HALF) = acc[ai][bj][m][0]; *(f32x4*)(dst + bj * HALF + 4) = acc[ai][bj][m][1]; } } } }
        } else if (pn < 8 || (pn >= 11 && pn < 15)) {
            bf16_t* G0 = pn < 8 ? SGP + (pn - 4) * BM : SGM + (pn - 11) * BM;
#pragma unroll
            for (int ai = 0; ai < 2; ++ai) if (ai == 0 || !u.half)
#pragma unroll
                for (int m = 0; m < 4; ++m) { bf16_t* rp = G0 + (size_t)(row0 + ai * HALF + m * 16) * 1024 + cl;
#pragma unroll
                    for (int bj = 0; bj < 2; ++bj) { f32x4 a = acc[ai][bj][m][0], b = acc[ai][bj][m][1];
#pragma unroll
                        for (int j = 0; j < 4; ++j) { a[j] = silu_f(a[j]); b[j] = silu_f(b[j]); }
                        *(u32x4*)(rp + bj * HALF) = pack8(a, b); } }
        } else if (pn < 10) {
#pragma unroll
            for (int ai = 0; ai < 2; ++ai) if (ai == 0 || !u.half)
#pragma unroll
                for (int m = 0; m < 4; ++m) { const int row = row0 + ai * HALF + m * 16; bf16_t* rp = CQ + (size_t)row * QRANK + (pn - 8) * BM + cl; float s = 0.f;
#pragma unroll
                    for (int bj = 0; bj < 2; ++bj) { *(u32x4*)(rp + bj * HALF) = pack8(acc[ai][bj][m][0], acc[ai][bj][m][1]); s += sq4(acc[ai][bj][m][0]) + sq4(acc[ai][bj][m][1]); }
                    s = fq_sum(s);
                    if (fq == 0) SSQCQ[(size_t)row * 8 + (pn - 8) * 4 + wc] = s; }
        } else if (pn == 10) {
            float p[1][2][4];
#pragma unroll
            for (int ai = 0; ai < 2; ++ai) if (ai == 0 || !u.half)
#pragma unroll
                for (int m = 0; m < 4; ++m) { float s = 0.f;
#pragma unroll
                    for (int bj = 0; bj < 2; ++bj) s += sq4(acc[ai][bj][m][0]) + sq4(acc[ai][bj][m][1]);
                    p[0][ai][m] = fq_sum(s); }
            xwave_rowsum<1>(p, scr, wr, wc, fr, fq);
            f32x4 gv[2][2];
#pragma unroll
            for (int bj = 0; bj < 2; ++bj) { gv[bj][0] = *(const f32x4*)(kvg + bj * HALF + cl); gv[bj][1] = *(const f32x4*)(kvg + bj * HALF + cl + 4); }
#pragma unroll
            for (int ai = 0; ai < 2; ++ai) if (ai == 0 || !u.half)
#pragma unroll
                for (int m = 0; m < 4; ++m) { const int row = row0 + ai * HALF + m * 16; const float r = 1.0f / sqrtf(p[0][ai][m] * (1.f / KVRANK) + EPS);
                    float* dst = (row < MP ? out + O_CKVP + (size_t)row * KVRANK : out + O_CKVS + (size_t)(row - MP) * KVRANK) + cl; bf16_t* rp = CKVN + (size_t)row * KVRANK + cl;
#pragma unroll
                    for (int bj = 0; bj < 2; ++bj) { const f32x4 a = acc[ai][bj][m][0] * r * gv[bj][0], b = acc[ai][bj][m][1] * r * gv[bj][1];
                        *(f32x4*)(dst + bj * HALF) = a; *(f32x4*)(dst + bj * HALF + 4) = b; *(u32x4*)(rp + bj * HALF) = pack8(a, b); } }
        } else {
            if (wc == 0) {
                f32x4 g1[2], g2[2];
#pragma unroll
                for (int n = 0; n < 2; ++n) { g1[n] = *(const f32x4*)(krg + 8 * fq + 4 * n); g2[n] = *(const f32x4*)(krg + 32 + 8 * fq + 4 * n); }
#pragma unroll
                for (int ai = 0; ai < 2; ++ai) if (ai == 0 || !u.half)
#pragma unroll
                    for (int m = 0; m < 4; ++m) { const int row = row0 + ai * HALF + m * 16; float s = 0.f;
#pragma unroll
                        for (int n = 0; n < 2; ++n) s += sq4(acc[ai][0][m][n]) + sq4(acc[ai][1][m][n]);
                        s = fq_sum(s); const float r = 1.0f / sqrtf(s * (1.f / DROPE) + EPS); const int pos = row_pos(row);
                        float* dst = (row < MP ? out + O_KRP + (size_t)row * DROPE : out + O_KRS + (size_t)(row - MP) * DROPE) + 8 * fq; bf16_t* rp = KRN + (size_t)row * DROPE + 8 * fq;
                        f32x4 o1[2], o2[2];
#pragma unroll
                        for (int n = 0; n < 2; ++n) { const f32x4 cs = *(const f32x4*)(COS + pos * 32 + 8 * fq + 4 * n), sn = *(const f32x4*)(SIN + pos * 32 + 8 * fq + 4 * n);
                            const f32x4 y1 = acc[ai][0][m][n] * r * g1[n], y2 = acc[ai][1][m][n] * r * g2[n]; o1[n] = y1 * cs - y2 * sn; o2[n] = y2 * cs + y1 * sn; }
                        *(f32x4*)(dst) = o1[0]; *(f32x4*)(dst + 4) = o1[1]; *(f32x4*)(dst + 32) = o2[0]; *(f32x4*)(dst + 36) = o2[1];
                        *(u32x4*)(rp) = pack8(o1[0], o1[1]); *(u32x4*)(rp + 32) = pack8(o2[0], o2[1]); }
            }
        }
    }
};

struct EpiQ {
    EPI_INIT_ZERO
    unsigned char* ws; const float* gqn; const float* gkn; const float* gqr;
    __device__ __forceinline__ void operator()(Acc& acc, const Unit& u, int wr, int wc, int fr, int fq, LAS unsigned char* scr) const {
        bf16_t* QCAT = (bf16_t*)(ws + WS_QCAT); const float* SSQCQ = (const float*)(ws + WS_SSQCQ); const float* COS = (const float*)(ws + WS_COS); const float* SIN = (const float*)(ws + WS_SIN);
        const int row0 = u.row0 + wr * 64 + fr, pn = u.pn;
#pragma unroll
        for (int ai = 0; ai < 2; ++ai) if (ai == 0 || !u.half)
#pragma unroll
            for (int m = 0; m < 4; ++m) { const int row = row0 + ai * HALF + m * 16; const f32x4 a = *(const f32x4*)(SSQCQ + (size_t)row * 8), b = *(const f32x4*)(SSQCQ + (size_t)row * 8 + 4);
                const float rq = 1.0f / sqrtf((((a[0] + a[1]) + (a[2] + a[3])) + ((b[0] + b[1]) + (b[2] + b[3]))) * (1.f / QRANK) + EPS);
#pragma unroll
                for (int bj = 0; bj < 2; ++bj)
#pragma unroll
                    for (int n = 0; n < 2; ++n) acc[ai][bj][m][n] *= rq;
                if (m & 1) asm volatile("" ::: "memory"); }
        if (pn < 4) {
            float p[2][2][4];
#pragma unroll
            for (int bj = 0; bj < 2; ++bj)
#pragma unroll
                for (int ai = 0; ai < 2; ++ai) if (ai == 0 || !u.half)
#pragma unroll
                    for (int m = 0; m < 4; ++m) p[bj][ai][m] = fq_sum(sq4(acc[ai][bj][m][0]) + sq4(acc[ai][bj][m][1]));
            xwave_rowsum<2>(p, scr, wr, wc, fr, fq);
            const int d0 = wc * 32 + 8 * fq; f32x4 gg[2];
#pragma unroll
            for (int n = 0; n < 2; ++n) gg[n] = *(const f32x4*)(gqn + d0 + 4 * n) * *(const f32x4*)(gkn + d0 + 4 * n) * C2;
#pragma unroll
            for (int ai = 0; ai < 2; ++ai) if (ai == 0 || !u.half)
#pragma unroll
                for (int m = 0; m < 4; ++m) { const int row = row0 + ai * HALF + m * 16;
#pragma unroll
                    for (int bj = 0; bj < 2; ++bj) { const float rn = 1.0f / sqrtf(p[bj][ai][m] * (1.f / DNOPE) + EPS);
                        *(u32x4*)(QCAT + (size_t)row * (NHEAD * DQK) + (2 * pn + bj) * DQK + d0) = pack8(acc[ai][bj][m][0] * rn * gg[0], acc[ai][bj][m][1] * rn * gg[1]); } }
        } else {
            const int hd = 4 * (pn - 4) + wc; f32x4 g1[2], g2[2];
#pragma unroll
            for (int n = 0; n < 2; ++n) { g1[n] = *(const f32x4*)(gqr + 8 * fq + 4 * n) * C2; g2[n] = *(const f32x4*)(gqr + 32 + 8 * fq + 4 * n) * C2; }
#pragma unroll
            for (int ai = 0; ai < 2; ++ai) if (ai == 0 || !u.half)
#pragma unroll
                for (int m = 0; m < 4; ++m) { const int row = row0 + ai * HALF + m * 16; float s = 0.f;
#pragma unroll
                    for (int n = 0; n < 2; ++n) s += sq4(acc[ai][0][m][n]) + sq4(acc[ai][1][m][n]);
                    s = fq_sum(s); const float r = 1.0f / sqrtf(s * (1.f / DROPE) + EPS); const int pos = row_pos(row);
                    f32x4 o1[2], o2[2];
#pragma unroll
                    for (int n = 0; n < 2; ++n) { const f32x4 cs = *(const f32x4*)(COS + pos * 32 + 8 * fq + 4 * n), sn = *(const f32x4*)(SIN + pos * 32 + 8 * fq + 4 * n);
                        const f32x4 y1 = acc[ai][0][m][n] * r * g1[n], y2 = acc[ai][1][m][n] * r * g2[n]; o1[n] = y1 * cs - y2 * sn; o2[n] = y2 * cs + y1 * sn; }
                    bf16_t* rp = QCAT + (size_t)row * (NHEAD * DQK) + hd * DQK + DNOPE + 8 * fq;
                    *(u32x4*)(rp) = pack8(o1[0], o1[1]); *(u32x4*)(rp + 32) = pack8(o2[0], o2[1]); }
        }
    }
};

struct EpiKV {
    EPI_INIT_ZERO
    unsigned char* ws;
    __device__ __forceinline__ void operator()(Acc& acc, const Unit& u, int wr, int wc, int fr, int fq, LAS unsigned char* scr) const {
        bf16_t* KCAT = (bf16_t*)(ws + WS_KCAT); bf16_t* V = (bf16_t*)(ws + WS_V);
        const int row0 = u.row0 + wr * 64 + fr, d0 = wc * 32 + 8 * fq, hd = u.pn;
        float p[1][2][4];
#pragma unroll
        for (int ai = 0; ai < 2; ++ai) if (ai == 0 || !u.half)
#pragma unroll
            for (int m = 0; m < 4; ++m) p[0][ai][m] = fq_sum(sq4(acc[ai][0][m][0]) + sq4(acc[ai][0][m][1]));
        xwave_rowsum<1>(p, scr, wr, wc, fr, fq);
#pragma unroll
        for (int ai = 0; ai < 2; ++ai) if (ai == 0 || !u.half)
#pragma unroll
            for (int m = 0; m < 4; ++m) { const int row = row0 + ai * HALF + m * 16; const float rk = 1.0f / sqrtf(p[0][ai][m] * (1.f / DNOPE) + EPS);
                *(u32x4*)(KCAT + (size_t)row * (NHEAD * DNOPE) + hd * DNOPE + d0) = pack8(acc[ai][0][m][0] * rk, acc[ai][0][m][1] * rk);
                *(u32x4*)(V + (size_t)row * (NHEAD * DV) + hd * DV + d0) = pack8(acc[ai][1][m][0], acc[ai][1][m][1]); }
    }
};

struct EpiOut {
    const float* xp; const float* xs; float* Y; unsigned char* ws;
    __device__ __forceinline__ void init(Acc& acc, const Unit& u, int wr, int wc, int fr, int fq) const {
        const int row0 = u.row0 + wr * 64 + fr, col0 = u.pn * BM + wc * 32 + 8 * fq;
#pragma unroll
        for (int ai = 0; ai < 2; ++ai)
#pragma unroll
            for (int m = 0; m < 4; ++m) { const int row = row0 + ai * HALF + m * 16; const float* xr = (row < MP ? xp + (size_t)row * DM : xs + (size_t)(row - MP) * DM) + col0;
#pragma unroll
                for (int bj = 0; bj < 2; ++bj) { if (ai == 0 || !u.half) { acc[ai][bj][m][0] = *(const f32x4*)(xr + bj * HALF); acc[ai][bj][m][1] = *(const f32x4*)(xr + bj * HALF + 4); }
                                                 else { acc[ai][bj][m][0] = (f32x4){0.f, 0.f, 0.f, 0.f}; acc[ai][bj][m][1] = (f32x4){0.f, 0.f, 0.f, 0.f}; } } }
    }
    __device__ __forceinline__ void operator()(Acc& acc, const Unit& u, int wr, int wc, int fr, int fq, LAS unsigned char* scr) const {
        float* SSQH = (float*)(ws + WS_SSQH); const rsrc_t rY = make_rsrc(Y, (unsigned)MT * DM * 4), rH = make_rsrc(ws + WS_HBF, (unsigned)MT * DM * 2);
        const int row0 = u.row0 + wr * 64 + fr, col0 = u.pn * BM + wc * 32 + 8 * fq;
        float p[1][2][4];
#pragma unroll
        for (int ai = 0; ai < 2; ++ai) if (ai == 0 || !u.half)
#pragma unroll
            for (int m = 0; m < 4; ++m) { const int row = row0 + ai * HALF + m * 16; float s = 0.f;
#pragma unroll
                for (int bj = 0; bj < 2; ++bj) { const f32x4 a = acc[ai][bj][m][0], b = acc[ai][bj][m][1];
                    const unsigned eo = (unsigned)(row * DM + col0 + bj * HALF);
                    if (u.half) { st16_wt(rY, eo * 4u, a); st16_wt(rY, eo * 4u + 16u, b); } else { *(f32x4*)(Y + eo) = a; *(f32x4*)(Y + eo + 4) = b; }
                    st16_wt(rH, eo * 2u, pack8(a, b)); s += sq4(a) + sq4(b); }
                p[0][ai][m] = fq_sum(s); }
        xwave_rowsum<1>(p, scr, wr, wc, fr, fq);
        if (wc == 0 && fq == 0) {
#pragma unroll
            for (int ai = 0; ai < 2; ++ai) if (ai == 0 || !u.half)
#pragma unroll
                for (int m = 0; m < 4; ++m) __hip_atomic_store(SSQH + (size_t)(row0 + ai * HALF + m * 16) * 8 + u.pn, p[0][ai][m], __ATOMIC_RELAXED, __HIP_MEMORY_SCOPE_AGENT);
        }
    }
};

struct EpiGate {
    EPI_INIT_ZERO
    float* Y; unsigned char* ws; const float* bias;
    __device__ __forceinline__ void operator()(Acc& acc, const Unit& u, int wr, int wc, int fr, int fq, LAS unsigned char*) const {
        const bf16_t* PV = (const bf16_t*)(ws + WS_PV); const float* SSQH = (const float*)(ws + WS_SSQH);
        const int row0 = u.row0 + wr * 64 + fr, col0 = u.pn * BM + wc * 32 + 8 * fq;
        f32x4 bv[2][2];
#pragma unroll
        for (int bj = 0; bj < 2; ++bj) { bv[bj][0] = *(const f32x4*)(bias + col0 + bj * HALF); bv[bj][1] = *(const f32x4*)(bias + col0 + bj * HALF + 4); }
#pragma unroll
        for (int ai = 0; ai < 2; ++ai) if (ai == 0 || !u.half)
#pragma unroll
            for (int m = 0; m < 4; ++m) { const int row = row0 + ai * HALF + m * 16; const f32x4 sa = *(const f32x4*)(SSQH + (size_t)row * 8), sb = *(const f32x4*)(SSQH + (size_t)row * 8 + 4);
                const float rh = 1.0f / sqrtf((((sa[0] + sa[1]) + (sa[2] + sa[3])) + ((sb[0] + sb[1]) + (sb[2] + sb[3]))) * (1.f / DM) + EPS);
#pragma unroll
                for (int bj = 0; bj < 2; ++bj) { float* yp = Y + (size_t)row * DM + col0 + bj * HALF; const u32x4 pw = *(const u32x4*)(PV + (size_t)row * DM + col0 + bj * HALF);
                    f32x4 h0 = *(const f32x4*)yp, h1 = *(const f32x4*)(yp + 4); const f32x4 g0 = acc[ai][bj][m][0] * rh + bv[bj][0], g1 = acc[ai][bj][m][1] * rh + bv[bj][1];
                    h0[0] += sigmoid_f(g0[0]) * __uint_as_float(pw.x << 16); h0[1] += sigmoid_f(g0[1]) * __uint_as_float(pw.x & 0xffff0000u);
                    h0[2] += sigmoid_f(g0[2]) * __uint_as_float(pw.y << 16); h0[3] += sigmoid_f(g0[3]) * __uint_as_float(pw.y & 0xffff0000u);
                    h1[0] += sigmoid_f(g1[0]) * __uint_as_float(pw.z << 16); h1[1] += sigmoid_f(g1[1]) * __uint_as_float(pw.z & 0xffff0000u);
                    h1[2] += sigmoid_f(g1[2]) * __uint_as_float(pw.w << 16); h1[3] += sigmoid_f(g1[3]) * __uint_as_float(pw.w & 0xffff0000u);
                    *(f32x4*)yp = h0; *(f32x4*)(yp + 4) = h1; }
                if (m & 1) asm volatile("" ::: "memory"); }
    }
};

struct SchedP1 { const char* ws; int c, G;
    static constexpr bool SPLITK = false;
    __device__ __forceinline__ float* slab(const Unit&) const { return nullptr; }
    __device__ __forceinline__ unsigned* ticket(const Unit&) const { return nullptr; }
    __device__ __forceinline__ void a_ready(const Unit&, int) const {}
    __device__ __forceinline__ void done(const Unit&, int) const {}
    __device__ __forceinline__ bool get(int i, Unit& u) const {
        constexpr int NF = 32 * 16, NH = 4 * 16; int nf = (NF - c + G - 1) / G; nf = nf < 0 ? 0 : nf;
        u.lda = DM; u.ldb = DM; u.nt = DM / BK; u.type = 0; u.slice = -1; u.uid = 0;
        if (i < nf) { int pm, pn; grid_map(c + i * G, 32, 16, pm, pn); u.row0 = pm * BM; u.pn = pn; u.half = 0; }
        else { const int t = c + (i - nf) * G; if (t >= NH) return false; u.row0 = MP + (t >> 4) * HALF; u.pn = t & 15; u.half = 1; }
        u.A = ws + WS_XN + (size_t)u.row0 * DM * 2; u.B = ws + WS_WIN + (size_t)u.pn * BM * DM * 2; return true; }
};
struct SchedP2 { const char* ws; int c, G;
    static constexpr bool SPLITK = false;
    __device__ __forceinline__ float* slab(const Unit&) const { return nullptr; }
    __device__ __forceinline__ unsigned* ticket(const Unit&) const { return nullptr; }
    __device__ __forceinline__ void a_ready(const Unit&, int) const {}
    __device__ __forceinline__ void done(const Unit&, int) const {}
    __device__ __forceinline__ bool get(int i, Unit& u) const {
        int L = c + i * G, pm, pn; u.half = 0; u.slice = -1; u.uid = 0;
        if (L < 204) { grid_map(L, 34, 6, pm, pn); u.type = 0; u.lda = QRANK; u.ldb = QRANK; u.nt = QRANK / BK; u.row0 = pm * BM; u.pn = pn;
            u.A = ws + WS_CQ + (size_t)u.row0 * QRANK * 2; u.B = ws + WS_WUQ + (size_t)pn * BM * QRANK * 2; return true; }
        L -= 204;
        if (L < 256) { grid_map(L, 32, 8, pm, pn); u.type = 1; u.lda = KVRANK; u.ldb = KVRANK; u.nt = KVRANK / BK; u.row0 = pm * BM; u.pn = pn;
            u.A = ws + WS_CKVN + (size_t)u.row0 * KVRANK * 2; u.B = ws + WS_WUKV + (size_t)pn * BM * KVRANK * 2; return true; }
        L -= 256;
        if (L < 144) { grid_map(L, 36, 4, pm, pn); u.type = 2; u.lda = DPOOL; u.ldb = 256; u.nt = 4; u.row0 = pm * BM; u.pn = pn;
            u.A = ws + WS_UBF + ((size_t)u.row0 * DPOOL + pn * 256) * 2; u.B = ws + WS_WPOOL + (size_t)pn * BM * 256 * 2; return true; }
        return false; }
};
struct EpiP2 { unsigned char* ws;
    EPI_INIT_ZERO
    __device__ __forceinline__ void operator()(Acc& acc, const Unit& u, int wr, int wc, int fr, int fq, LAS unsigned char* scr) const {
        if (u.type == 0) { const EpiQ q{ws, arg_in(13), arg_in(15), arg_in(14)}; q(acc, u, wr, wc, fr, fq, scr); }
        else if (u.type == 1) { const EpiKV kv{ws}; kv(acc, u, wr, wc, fr, fq, scr); }
        else { const EpiBf16 z{(bf16_t*)(ws + WS_Z), DPOOL, 0}; z(acc, u, wr, wc, fr, fq, scr); } }
};

struct SchedP45 { const char* ws; unsigned* cnt; int c, G, stream;
    static constexpr bool SPLITK = true;
    __device__ __forceinline__ bool warm(const Unit&) const { return false; }
    __device__ __forceinline__ int panel_of(const Unit& u) const { return u.row0 < MP ? (u.row0 >> 8) : 32 + ((u.row0 - MP) >> 7); }
    __device__ __forceinline__ float* slab(const Unit& u) const { return (float*)(ws + (u.type == 0 ? WS_SGM : WS_V)) + (size_t)u.uid * (4 * HALF * BM); }
    __device__ __forceinline__ unsigned* ticket(const Unit& u) const { return cnt + 64 * ((u.type == 0 ? 38 : 70) + u.uid); }
    __device__ __forceinline__ bool get(int i, Unit& u) const {
        constexpr int NF = 32 * 8, NS = 32 * 4, NH = 32; int pm = 0, pn = 0, type, row0, half = 0, slice = -1, uid = 0; bool ok = true;
        int nf = (NF - c + G - 1) / G; nf = nf < 0 ? 0 : nf; int ns = (NS - c + G - 1) / G; ns = ns < 0 ? 0 : ns;
        const int c2 = (c + G - (128 % G)) % G; int ns2 = (NS - c2 + G - 1) / G; ns2 = ns2 < 0 ? 0 : ns2;
        if (stream == 1) {
            if (i < 2 * nf) { grid_map(c + (i >> 1) * G, 32, 8, pm, pn); type = (i & 1) ? 1 : 0; row0 = pm * BM; }
            else if (i - 2 * nf < ns) { const int j = c + (i - 2 * nf) * G; type = 0; uid = j >> 2; slice = j & 3; row0 = MP + (uid >> 3) * HALF; pn = uid & 7; half = 1; }
            else { const int t = c2 + (i - 2 * nf - ns) * G; ok = t < NH; type = 1; row0 = MP + ((t >> 3) & 3) * HALF; pn = t & 7; half = 1; }
        } else {
            type = 2;
            if (i < nf) { grid_map(c + i * G, 32, 8, pm, pn); row0 = pm * BM; }
            else { const int j = c2 + (i - nf) * G; ok = j < NS; uid = (j >> 2) & 31; slice = j & 3; row0 = MP + (uid >> 3) * HALF; pn = uid & 7; half = 1; }
        }
        const bool ple = type == 1; const int ld = ple ? DPLE : DM; const int nt = slice >= 0 ? 8 : ld / BK; const size_t koff = slice >= 0 ? (size_t)slice * 8 * BK * 2 : 0;
        u.type = type; u.row0 = row0; u.pn = pn; u.half = half; u.slice = slice; u.uid = uid; u.lda = ld; u.ldb = ld; u.nt = nt;
        u.A = ws + (ple ? WS_PBF : (type == 0 ? WS_MIX : WS_HBF)) + (size_t)row0 * ld * 2 + koff;
        u.B = ws + (ple ? WS_WPLE : (type == 0 ? WS_WOUT : WS_WGATE)) + (size_t)pn * BM * ld * 2 + koff;
        return ok; }
    __device__ __forceinline__ void a_ready(const Unit& u, int wid) const {
        if (u.type != 2) return;
        if (wid == 0) {
            unsigned* p1 = cnt + 64 * panel_of(u); unsigned* p2 = cnt + 64 * 37; const unsigned need2 = u.half ? 32u : 0u; unsigned sp = 0;
            while ((unsigned)__builtin_amdgcn_readfirstlane(__hip_atomic_load(p1, __ATOMIC_RELAXED, __HIP_MEMORY_SCOPE_AGENT)) < 8u ||
                   (unsigned)__builtin_amdgcn_readfirstlane(__hip_atomic_load(p2, __ATOMIC_RELAXED, __HIP_MEMORY_SCOPE_AGENT)) < need2) { __builtin_amdgcn_s_sleep(2); if (++sp > (1u << 24)) break; }
            __builtin_amdgcn_fence(__ATOMIC_ACQUIRE, "agent");
            asm volatile("s_waitcnt vmcnt(0)" ::: "memory");
        }
        asm volatile("" ::: "memory"); __builtin_amdgcn_s_barrier(); asm volatile("" ::: "memory");
    }
    __device__ __forceinline__ void done(const Unit& u, int wid) const {
        if (u.type == 2 || (u.type == 1 && !u.half)) return;
        asm volatile("s_waitcnt vmcnt(0)" ::: "memory");
        __builtin_amdgcn_s_barrier(); asm volatile("" ::: "memory");
        if (wid == 0 && lane_id() == 0) __hip_atomic_fetch_add(cnt + 64 * (u.type == 1 ? 37 : panel_of(u)), 1u, __ATOMIC_RELAXED, __HIP_MEMORY_SCOPE_AGENT);
    }
};
struct EpiP45 { unsigned char* ws; float* out;
    __device__ __forceinline__ void init(Acc& acc, const Unit& u, int wr, int wc, int fr, int fq) const {
        if (u.type == 0 && u.slice <= 0) { const EpiOut o{arg_in(0), arg_in(1), out + O_Y, ws}; o.init(acc, u, wr, wc, fr, fq); } else acc_zero(acc); }
    __device__ __forceinline__ void operator()(Acc& acc, const Unit& u, int wr, int wc, int fr, int fq, LAS unsigned char* scr) const {
        if (u.type == 0) { const EpiOut o{nullptr, nullptr, out + O_Y, ws}; o(acc, u, wr, wc, fr, fq, scr); }
        else if (u.type == 1) { const EpiBf16 e{(bf16_t*)(ws + WS_PV), DM, u.half}; e(acc, u, wr, wc, fr, fq, scr); }
        else { const EpiGate g{out + O_Y, ws, arg_in(22)}; g(acc, u, wr, wc, fr, fq, scr); } }
};
}

struct Args { const float* in[24]; float* out; unsigned char* ws; int ph_lo, ph_hi, li, pad; };
enum { I_XP = 0, I_XS, I_CCKV, I_CKR, I_SPOOL, I_PP, I_PS, I_NORMG, I_WIN, I_QNG, I_WUQ, I_KVNG, I_WUKV, I_QNOPEG, I_QROPEG, I_KNOPEG, I_KROPEG, I_WPOOL, I_PSCALE, I_WOUT, I_PLENG, I_WGATE, I_BGATE, I_WPLE };


__device__ __forceinline__ void cache_item(const float* W, bf16_t* CB, bf16_t* CT, int k0, int n0, LAS float* scr, int lane, bool doB, bool doT) {
    float tv[32];
#pragma unroll
    for (int i = 0; i < 32; ++i) tv[i] = W[(size_t)(k0 + 2 * i + (lane >> 5)) * KVRANK + n0 + (lane & 31)];
#pragma unroll
    for (int i = 0; i < 32; ++i) scr[(2 * i + (lane >> 5)) * 33 + (lane & 31)] = tv[i];
    LDS_WAIT(); asm volatile("" ::: "memory");
    const int kb0 = k0 >> 5, s0 = n0 >> 4;
#pragma unroll
    for (int c = 0; c < 4; ++c) { const int kbl = c >> 1, sl = c & 1;
        if (doB) { const LAS float* p = scr + (kbl * 32 + (lane & 31)) * 33 + sl * 16 + 8 * (lane >> 5);
          u32x4 o; o.x = cvtpk(p[0], p[1]); o.y = cvtpk(p[2], p[3]); o.z = cvtpk(p[4], p[5]); o.w = cvtpk(p[6], p[7]);
          *(u32x4*)(CB + ((size_t)((kb0 + kbl) * 16 + s0 + sl) * 64 + lane) * 8) = o; }
        if (doT) { const LAS float* p = scr + (kbl * 32 + 8 * (lane >> 4)) * 33 + sl * 16 + (lane & 15);
          u32x4 o; o.x = cvtpk(p[0 * 33], p[1 * 33]); o.y = cvtpk(p[2 * 33], p[3 * 33]); o.z = cvtpk(p[4 * 33], p[5 * 33]); o.w = cvtpk(p[6 * 33], p[7 * 33]);
          *(u32x4*)(CT + ((size_t)((kb0 + kbl) * 16 + s0 + sl) * 64 + lane) * 8) = o; } }
    LDS_WAIT(); asm volatile("" ::: "memory");
}
__device__ __forceinline__ bf16_t* ckvt_base(unsigned char* ws, int b) { return (bf16_t*)(ws + (b < NBT_A ? WS_CKVT_A + (size_t)b * CKVT_B : WS_CKVT_B + (size_t)(b - NBT_A) * CKVT_B)); }

__device__ __forceinline__ void transpose_item(const float* W, int N, bf16_t* WT, int ldt, int k0, int n0, int drow0, const float* kgain, LAS float* scr, int lane) {
    float tv[32];
#pragma unroll
    for (int i = 0; i < 32; ++i) tv[i] = W[(size_t)(k0 + 2 * i + (lane >> 5)) * N + n0 + (lane & 31)];
    if (kgain) {
#pragma unroll
        for (int i = 0; i < 32; ++i) tv[i] *= kgain[k0 + 2 * i + (lane >> 5)]; }
#pragma unroll
    for (int i = 0; i < 32; ++i) scr[(2 * i + (lane >> 5)) * 33 + (lane & 31)] = tv[i];
    LDS_WAIT(); asm volatile("" ::: "memory");
    const int c = lane & 7;
#pragma unroll
    for (int j = 0; j < 4; ++j) { const int n = (lane >> 3) + 8 * j; const LAS float* s = scr + (8 * c) * 33 + n;
        u32x4 o; o.x = cvtpk(s[0 * 33], s[1 * 33]); o.y = cvtpk(s[2 * 33], s[3 * 33]); o.z = cvtpk(s[4 * 33], s[5 * 33]); o.w = cvtpk(s[6 * 33], s[7 * 33]);
        *(u32x4*)(WT + (size_t)(drow0 + n) * ldt + k0 + 8 * c) = o; }
    LDS_WAIT(); asm volatile("" ::: "memory");
}

__device__ __forceinline__ void p0_prologue(const Args& a, LAS unsigned char* lds, int vcu, int G, int wv, int part) {
    const int lane = lane_id(), wave = wv, tid = (wv << 6) | lane;
    LAS float* scr = (LAS float*)(lds + wave * 16384);
    const int gw = vcu * 8 + wave, NGW = G * 8;
    unsigned char* ws = a.ws;
    bf16_t* Win_t = (bf16_t*)(ws + WS_WIN);
    const int gt = vcu * 512 + tid, NGT = G * 512;
    if (part == 0) {
        constexpr int I_IN = 32 * 122;
        { const float* W = AIN(I_WIN);
          for (int r = gw; r < I_IN; r += NGW) { const int kb = r / 122, nb = r % 122, n0 = 32 * nb; const int d = n0 < 2816 ? n0 : (n0 == 2816 ? 3840 : (n0 == 2848 ? 3968 : n0 - 64));
              transpose_item(W, DIN, Win_t, DM, 64 * kb, n0, d, nullptr, scr, lane); } }
        {
            bf16_t* XN = (bf16_t*)(ws + WS_XN); const float* gp = AIN(I_NORMG); const float* xp = AIN(I_XP); const float* xs = AIN(I_XS);
            for (int m = gw; m < MT; m += NGW) {
                const float* xr = (m < MP ? xp + (size_t)m * DM : xs + (size_t)(m - MP) * DM) + 4 * lane;
                f32x4 v[8]; float sm = 0.f;
#pragma unroll
                for (int j = 0; j < 8; ++j) { v[j] = *(const f32x4*)(xr + 256 * j); sm += pg8::sq4(v[j]); }
                const float r = 1.0f / sqrtf(wave_sum(sm) * (1.f / DM) + EPS);
#pragma unroll
                for (int j = 0; j < 8; ++j) { const f32x4 gv = *(const f32x4*)(gp + 4 * lane + 256 * j); const f32x4 o = v[j] * r * gv;
                    u32x2 w; w.x = cvtpk(o[0], o[1]); w.y = cvtpk(o[2], o[3]); *(u32x2*)(XN + (size_t)m * DM + 4 * lane + 256 * j) = w; }
            }
        }
        {
            float* COS = (float*)(ws + WS_COS); float* SIN = (float*)(ws + WS_SIN);
            for (int i = tid * G + vcu; i < SKV_S * 32; i += 512 * G) { const int pos = i >> 5, fi = i & 31; const float inv = (float)exp(-(double)fi * (1.0 / 32.0) * 9.210340371976184); const float ang = (float)pos * inv;
                float sv, cv; sincosf(ang, &sv, &cv); COS[i] = cv; SIN[i] = sv; }
        }
        {
            for (int i = gt; i < 192 * (DM / 8); i += NGT) { const int rr = i >> 8, c = (i & 255) * 8; const int row = 3840 + (rr < 96 ? 32 + rr : 160 + (rr - 96));
                *(u32x4*)(Win_t + (size_t)row * DM + c) = (u32x4){0u, 0u, 0u, 0u}; }
        }
        return;
    }
    bf16_t* Wuq_t = (bf16_t*)(ws + WS_WUQ); bf16_t* Wukv_t = (bf16_t*)(ws + WS_WUKV); bf16_t* Wpool_t = (bf16_t*)(ws + WS_WPOOL);
    bf16_t* Wout_t = (bf16_t*)(ws + WS_WOUT); bf16_t* Wgate_t = (bf16_t*)(ws + WS_WGATE); bf16_t* Wple_t = (bf16_t*)(ws + WS_WPLE);
    constexpr int I_UQ = 8 * 48, I_UKV = 4 * 64, I_POOL = 4 * 4 * 8, I_OUT = 32 * 64, I_GATE = 32 * 64, I_PLE = 4 * 64;
    constexpr int NITEMS = I_UQ + I_UKV + I_POOL + I_OUT + I_GATE + I_PLE;
    static_assert(NITEMS == 5120, "chunk map");
    unsigned* cctr = (unsigned*)(ws + WS_CTL) + 11776 + 64 * a.li;
    volatile LAS unsigned* MISCp = (volatile LAS unsigned*)(lds + MISC_OFF);
    for (;;) {
        if (tid == 0) MISCp[23] = __hip_atomic_fetch_add(cctr, 1u, __ATOMIC_RELAXED, __HIP_MEMORY_SCOPE_AGENT);
        __syncthreads();
        const int ch = (int)MISCp[23];
        __syncthreads();
        if (ch >= 852 + NBT_A * 32) break;
        if (ch >= 852) { const int item = (ch - 852) * 8 + wave, bb = item >> 8, kbk = (item & 255) >> 3, nb = item & 7;
            cache_item(AIN(I_CCKV) + (size_t)bb * PAST * KVRANK, nullptr, ckvt_base(ws, bb), 64 * kbk, 32 * nb, scr, lane, false, true); continue; }
        if (ch < 640) {
            int r = ch * 8 + wave;
            if (r < I_UQ) { const int kb = r / 48, nb = r % 48, n0 = 32 * nb, h = n0 / DQK, j0 = n0 % DQK;
                const int d = j0 < 128 ? h * 128 + j0 : 1024 + 256 * (h >> 2) + 32 * (h & 3) + (j0 == 160 ? 128 : 0);
                transpose_item(AIN(I_WUQ), NHEAD * DQK, Wuq_t, QRANK, 64 * kb, n0, d, AIN(I_QNG), scr, lane); continue; } r -= I_UQ;
            if (r < I_UKV) { const int kb = r / 64, nb = r % 64; transpose_item(AIN(I_WUKV), 2048, Wukv_t, KVRANK, 64 * kb, 32 * nb, 32 * nb, nullptr, scr, lane); continue; } r -= I_UKV;
            if (r < I_POOL) { const int gq = r / 32, kb = (r % 32) / 8, nb = r % 8; transpose_item(AIN(I_WPOOL) + (size_t)gq * 65536, 256, Wpool_t, 256, 64 * kb, 32 * nb, gq * 256 + 32 * nb, nullptr, scr, lane); continue; } r -= I_POOL;
            if (r < I_OUT) { const int kb = r / 64, nb = r % 64; transpose_item(AIN(I_WOUT), DM, Wout_t, DM, 64 * kb, 32 * nb, 32 * nb, nullptr, scr, lane); continue; } r -= I_OUT;
            if (r < I_GATE) { const int kb = r / 64, nb = r % 64; transpose_item(AIN(I_WGATE), DM, Wgate_t, DM, 64 * kb, 32 * nb, 32 * nb, AIN(I_PLENG), scr, lane); continue; } r -= I_GATE;
            { const int kb = r / 64, nb = r % 64; transpose_item(AIN(I_WPLE), DM, Wple_t, DPLE, 64 * kb, 32 * nb, 32 * nb, nullptr, scr, lane); }
        } else if (ch < 708) {
            bf16_t* PBF = (bf16_t*)(ws + WS_PBF); const float* pp = AIN(I_PP); const float* ps = AIN(I_PS);
#pragma unroll
            for (int k = 0; k < 8; ++k) { const int i = (ch - 640) * 4096 + tid + k * 512, m = i >> 5, c = (i & 31) * 8; const float* src = (m < MP ? pp + (size_t)m * DPLE : ps + (size_t)(m - MP) * DPLE) + c;
                *(u32x4*)(PBF + (size_t)m * DPLE + c) = pack8(*(const f32x4*)src, *(const f32x4*)(src + 4)); }
        } else if (ch < 724) {
            bf16_t* UBF = (bf16_t*)(ws + WS_UBF); const float* sp = AIN(I_SPOOL);
#pragma unroll
            for (int k = 0; k < 8; ++k) { const int i = (ch - 708) * 4096 + tid + k * 512, rr = i >> 7, c = (i & 127) * 8; u32x4 w = {0u, 0u, 0u, 0u};
                if (rr < DBATCH * POOLH) { const float* src = sp + (size_t)rr * DPOOL + c; w = pack8(*(const f32x4*)src, *(const f32x4*)(src + 4)); }
                *(u32x4*)(UBF + (size_t)(MT + rr) * DPOOL + c) = w; }
        } else {
            const float* src = AIN(I_CKR) + (size_t)(ch - 724) * 32768; bf16_t* dst = (bf16_t*)(ws + WS_KRB) + (size_t)(ch - 724) * 32768;
#pragma unroll
            for (int k = 0; k < 8; ++k) { const int o = tid * 8 + k * 4096; *(u32x4*)(dst + o) = pack8(*(const f32x4*)(src + o), *(const f32x4*)(src + o + 4)); }
        }
    }
}

namespace pattn {
constexpr int KVBLK = 64, NW = 8, QBLK = 32;
constexpr int SHM_V = 16384, SHM_KN = 16384, SHM_KR = 8192;
constexpr int L_V = 0, L_KN = 2 * SHM_V, L_KR = L_KN + 2 * SHM_KN, L_WS = L_KR + 2 * SHM_KR, L_END = L_WS + NW * 64 * 4;
constexpr int LDQ = NHEAD * DQK, LDK = NHEAD * DNOPE, LDV = NHEAD * DV;
constexpr float THR = 4.0f;
#define KSWZ(row, colB) ((row) * 256 + ((colB) ^ (((row) & 7) << 4)))
#define RSWZ(row, colB) ((row) * 128 + ((colB) ^ (((row) & 7) << 4)))
__device__ __forceinline__ int crow(int r, int hi) { return (r & 3) + 8 * (r >> 2) + 4 * hi; }

__device__ __forceinline__ void partialSM(f32x16& p0, f32x16& p1, float& m_reg, float& alpha) {
    float pmax = p0[0];
#pragma unroll
    for (int r = 1; r < 16; ++r) pmax = fmaxf(pmax, p0[r]);
#pragma unroll
    for (int r = 0; r < 16; ++r) pmax = fmaxf(pmax, p1[r]);
    { auto rr = __builtin_amdgcn_permlane32_swap(__float_as_uint(pmax), __float_as_uint(pmax), false, false); pmax = fmaxf(__uint_as_float(rr[0]), __uint_as_float(rr[1])); }
    float mn;
    if (__builtin_expect(__all(pmax - m_reg <= THR), 1)) { mn = m_reg; alpha = 1.f; }
    else { mn = fmaxf(m_reg, pmax); alpha = __builtin_amdgcn_exp2f(m_reg - mn); m_reg = mn; }
#pragma unroll
    for (int r = 0; r < 16; ++r) p0[r] = p0[r] - mn;
#pragma unroll
    for (int r = 0; r < 16; ++r) p1[r] = p1[r] - mn;
#pragma unroll
    for (int r = 0; r < 16; ++r) p0[r] = __builtin_amdgcn_exp2f(p0[r]);
}
__device__ __forceinline__ void finishSM(f32x16& p0, f32x16& p1, float alpha, float& l_reg, bf16x8& pa0, bf16x8& pa1, bf16x8& pa2, bf16x8& pa3) {
#pragma unroll
    for (int r = 0; r < 16; ++r) p1[r] = __builtin_amdgcn_exp2f(p1[r]);
    float ps = 0;
#pragma unroll
    for (int r = 0; r < 16; ++r) ps += p0[r];
#pragma unroll
    for (int r = 0; r < 16; ++r) ps += p1[r];
    { auto rr = __builtin_amdgcn_permlane32_swap(__float_as_uint(ps), __float_as_uint(ps), false, false); ps = __uint_as_float(rr[0]) + __uint_as_float(rr[1]); }
    l_reg = l_reg * alpha + ps;
#define PK4(P, BASE, OUT) do { unsigned a0 = cvtpk(P[BASE + 0], P[BASE + 1]), a1 = cvtpk(P[BASE + 2], P[BASE + 3]);   \
    unsigned b0 = cvtpk(P[BASE + 4], P[BASE + 5]), b1 = cvtpk(P[BASE + 6], P[BASE + 7]);                              \
    auto r0 = __builtin_amdgcn_permlane32_swap(a0, b0, false, false); auto r1 = __builtin_amdgcn_permlane32_swap(a1, b1, false, false); \
    u32x4 w = {r0[0], r1[0], r0[1], r1[1]}; OUT = __builtin_bit_cast(bf16x8, w); } while (0)
    PK4(p0, 0, pa0); PK4(p0, 8, pa1); PK4(p1, 0, pa2); PK4(p1, 8, pa3);
#undef PK4
}
__device__ __forceinline__ void qkt(f32x16& p0, f32x16& p1, LAS const unsigned char* Kn, LAS const unsigned char* Kr, const bf16x8* qr, int r32, int hi) {
    p0 = f32x16{}; p1 = f32x16{};
#pragma unroll
    for (int d0 = 0; d0 < 8; ++d0) { const int cb = (d0 * 16 + hi * 8) * 2;
        const bf16x8 b0 = *(LAS const bf16x8*)(Kn + KSWZ(r32, cb)); const bf16x8 b1 = *(LAS const bf16x8*)(Kn + KSWZ(32 + r32, cb));
        p0 = __builtin_amdgcn_mfma_f32_32x32x16_bf16(b0, qr[d0], p0, 0, 0, 0); p1 = __builtin_amdgcn_mfma_f32_32x32x16_bf16(b1, qr[d0], p1, 0, 0, 0); }
#pragma unroll
    for (int d0 = 0; d0 < 4; ++d0) { const int cb = (d0 * 16 + hi * 8) * 2;
        const bf16x8 b0 = *(LAS const bf16x8*)(Kr + RSWZ(r32, cb)); const bf16x8 b1 = *(LAS const bf16x8*)(Kr + RSWZ(32 + r32, cb));
        p0 = __builtin_amdgcn_mfma_f32_32x32x16_bf16(b0, qr[8 + d0], p0, 0, 0, 0); p1 = __builtin_amdgcn_mfma_f32_32x32x16_bf16(b1, qr[8 + d0], p1, 0, 0, 0); }
}
__device__ __forceinline__ int v_st(int k, int c) { const int kk = (k & ~0xC) | ((k & 4) << 1) | ((k & 8) >> 1); return ((kk >> 3) * 4 + (c >> 5)) * 512 + ((kk & 7) * 32 + (c & 31)) * 2; }
__device__ __forceinline__ int v_rd_base(int lane) { return ((lane & 3) << 3) | (((lane >> 2) & 3) << 6) | (((lane >> 4) & 1) << 5) | (((lane >> 5) & 1) << 8); }
constexpr int v_rd_off(int d0, int ks, int half) { return d0 * 512 + ks * 4096 + half * 2048; }
template <int OFF> __device__ __forceinline__ s16x4 tr_read(int vb) { s16x4 r; asm volatile("ds_read_b64_tr_b16 %0, %1 offset:%2" : "=&v"(r) : "v"(vb), "i"(OFF) : "memory"); return r; }
template <int D0> __device__ __forceinline__ void pv_one(f32x16& od, int vb, bf16x8 pa0, bf16x8 pa1, bf16x8 pa2, bf16x8 pa3) {
    const s16x4 l0 = tr_read<v_rd_off(D0, 0, 0)>(vb), h0 = tr_read<v_rd_off(D0, 0, 1)>(vb), l1 = tr_read<v_rd_off(D0, 1, 0)>(vb), h1 = tr_read<v_rd_off(D0, 1, 1)>(vb);
    const s16x4 l2 = tr_read<v_rd_off(D0, 2, 0)>(vb), h2 = tr_read<v_rd_off(D0, 2, 1)>(vb), l3 = tr_read<v_rd_off(D0, 3, 0)>(vb), h3 = tr_read<v_rd_off(D0, 3, 1)>(vb);
    asm volatile("s_waitcnt lgkmcnt(0)" ::: "memory"); SBAR();
#define PK(L, H) (bf16x8){L[0], L[1], L[2], L[3], H[0], H[1], H[2], H[3]}
    od = __builtin_amdgcn_mfma_f32_32x32x16_bf16(pa0, PK(l0, h0), od, 0, 0, 0);
    od = __builtin_amdgcn_mfma_f32_32x32x16_bf16(pa1, PK(l1, h1), od, 0, 0, 0);
    od = __builtin_amdgcn_mfma_f32_32x32x16_bf16(pa2, PK(l2, h2), od, 0, 0, 0);
    od = __builtin_amdgcn_mfma_f32_32x32x16_bf16(pa3, PK(l3, h3), od, 0, 0, 0);
#undef PK
}
__device__ __forceinline__ void pv_d0(f32x16* o, int vb, bf16x8 pa0, bf16x8 pa1, bf16x8 pa2, bf16x8 pa3) {
    pv_one<0>(o[0], vb, pa0, pa1, pa2, pa3); pv_one<1>(o[1], vb, pa0, pa1, pa2, pa3); pv_one<2>(o[2], vb, pa0, pa1, pa2, pa3); pv_one<3>(o[3], vb, pa0, pa1, pa2, pa3);
}

__device__ __forceinline__ void unit(int b, int h, int qb, const bf16_t* __restrict__ QCAT, const bf16_t* __restrict__ KCAT, const bf16_t* __restrict__ KRN, const bf16_t* __restrict__ Vb, const bf16_t* __restrict__ SGM, bf16_t* MIX, LAS unsigned char* lds, int wv) {
    int lane = lane_id(); asm volatile("" : "+v"(lane));
    const int wid = wv, tid = (wv << 6) | lane, r32 = lane & 31, hi = lane >> 5;
    const long rowbase = (long)b * SEQ; const int q0 = qb * 256;
    LAS unsigned char* V_lds = lds + L_V; LAS unsigned char* KN_lds = lds + L_KN; LAS unsigned char* KR_lds = lds + L_KR;
    LAS float* wsf = (LAS float*)(lds + L_WS) + wid * 64; LAS float* li_l = wsf; LAS float* al_l = wsf + 32;
    const bf16_t* Kh = KCAT + rowbase * LDK + h * DNOPE; const bf16_t* Vh = Vb + rowbase * LDV + h * DV; const bf16_t* Kr = KRN + rowbase * DROPE;
    float m_reg = -1e30f, l_reg = 0.f; f32x16 o[4]; o[0] = f32x16{}; o[1] = f32x16{}; o[2] = f32x16{}; o[3] = f32x16{};
    bf16x8 qr[12];
    { const bf16_t* Qw = QCAT + (rowbase + q0 + wid * QBLK + r32) * LDQ + h * DQK + hi * 8;
#pragma unroll
      for (int d0 = 0; d0 < 12; ++d0) qr[d0] = *(const bf16x8*)(Qw + d0 * 16); }
    const int cw = 4 * qb + (wid >> 1);
    const int NT = 4 * qb + 4;
    const int sr = tid >> 4, sc = (tid & 15) * 8, vst0 = v_st(sr, sc), vst1 = v_st(32 + sr, sc);
    const int krr = tid >> 3, krc = (tid & 7) * 8;
    const int vb0 = (int)(uintptr_t)V_lds + v_rd_base(lane);
    bf16x8 sv0, sv1, sk0, sk1, skr;
#define SLOAD(k0) do { sv0 = *(const bf16x8*)(Vh + (long)((k0) + sr) * LDV + sc); sv1 = *(const bf16x8*)(Vh + (long)((k0) + 32 + sr) * LDV + sc); \
    sk0 = *(const bf16x8*)(Kh + (long)((k0) + sr) * LDK + sc); sk1 = *(const bf16x8*)(Kh + (long)((k0) + 32 + sr) * LDK + sc); \
    skr = *(const bf16x8*)(Kr + (long)((k0) + krr) * DROPE + krc); } while (0)
#define SWRITE(bb) do { *(LAS bf16x8*)(V_lds + (bb) * SHM_V + vst0) = sv0; *(LAS bf16x8*)(V_lds + (bb) * SHM_V + vst1) = sv1; \
    *(LAS bf16x8*)(KN_lds + (bb) * SHM_KN + KSWZ(sr, sc * 2)) = sk0; *(LAS bf16x8*)(KN_lds + (bb) * SHM_KN + KSWZ(32 + sr, sc * 2)) = sk1; \
    *(LAS bf16x8*)(KR_lds + (bb) * SHM_KR + RSWZ(krr, krc * 2)) = skr; } while (0)
#define RESC(a) do { if (__any((a) < 1.f)) { if (hi == 0) al_l[r32] = (a); asm volatile("s_waitcnt lgkmcnt(0)" ::: "memory"); \
    _Pragma("unroll") for (int d = 0; d < 4; ++d) _Pragma("unroll") for (int r = 0; r < 16; ++r) o[d][r] *= al_l[crow(r, hi)]; } } while (0)
#define QKT(P0, P1, bb, j) do { if ((j) <= cw) qkt(P0, P1, KN_lds + (bb) * SHM_KN, KR_lds + (bb) * SHM_KR, qr, r32, hi); \
    else { _Pragma("unroll") for (int r = 0; r < 16; ++r) { P0[r] = -1e30f; P1[r] = -1e30f; } } } while (0)
#define PV(bb, j) do { if ((j) <= cw) pv_d0(o, vb0 + (bb) * SHM_V, pa0, pa1, pa2, pa3); } while (0)
    f32x16 pA0, pA1, pB0, pB1; float alA, alB; bf16x8 pa0, pa1, pa2, pa3;
    SLOAD(0); SWRITE(0); __syncthreads();
    QKT(pA0, pA1, 0, 0); partialSM(pA0, pA1, m_reg, alA);
    SLOAD(KVBLK); SWRITE(1); __syncthreads();
    for (int j = 1; j + 1 < NT; j += 2) {
        SBAR(); QKT(pB0, pB1, 1, j);
        finishSM(pA0, pA1, alA, l_reg, pa0, pa1, pa2, pa3); SBAR();
        SLOAD((j + 1) * KVBLK); SBAR();
        PV(0, j - 1); partialSM(pB0, pB1, m_reg, alB);
        __syncthreads(); SWRITE(0);
        RESC(alB); __syncthreads();
        SBAR(); QKT(pA0, pA1, 0, j + 1);
        finishSM(pB0, pB1, alB, l_reg, pa0, pa1, pa2, pa3); SBAR();
        SLOAD((j + 2) * KVBLK); SBAR();
        PV(1, j); partialSM(pA0, pA1, m_reg, alA);
        __syncthreads(); SWRITE(1);
        RESC(alA); __syncthreads();
    }
    SBAR(); QKT(pB0, pB1, 1, NT - 1);
    finishSM(pA0, pA1, alA, l_reg, pa0, pa1, pa2, pa3); SBAR();
    PV(0, NT - 2); partialSM(pB0, pB1, m_reg, alB);
    __syncthreads(); RESC(alB);
    finishSM(pB0, pB1, alB, l_reg, pa0, pa1, pa2, pa3); SBAR();
    PV(1, NT - 1);
    if (hi == 0) li_l[r32] = l_reg; asm volatile("s_waitcnt lgkmcnt(0)" ::: "memory");
    float rli[16];
#pragma unroll
    for (int r = 0; r < 16; ++r) rli[r] = __builtin_amdgcn_rcpf(li_l[crow(r, hi)]);
    __syncthreads();
    LAS bf16_t* stg = (LAS bf16_t*)(lds + wid * 8192);
#pragma unroll
    for (int r = 0; r < 16; ++r) { const int orow = crow(r, hi);
#pragma unroll
        for (int d0 = 0; d0 < 4; ++d0) { const float v = o[d0][r] * rli[r]; stg[orow * 128 + d0 * 32 + r32] = (bf16_t)(cvtpk(v, 0.f) & 0xffffu); } }
    asm volatile("s_waitcnt lgkmcnt(0)" ::: "memory");
    const long orow0 = rowbase + q0 + wid * QBLK;
#pragma unroll
    for (int i = 0; i < 8; ++i) { const int row = i * 4 + (lane >> 4), ch = lane & 15; const u32x4 v = *(LAS const u32x4*)(stg + row * 128 + ch * 8);
        const u32x4 gq = *(const u32x4*)(SGM + (orow0 + row) * 1024 + h * DV + ch * 8); u32x4 w;
        w.x = cvtpk(__uint_as_float(v.x << 16) * __uint_as_float(gq.x << 16), __uint_as_float(v.x & 0xffff0000u) * __uint_as_float(gq.x & 0xffff0000u));
        w.y = cvtpk(__uint_as_float(v.y << 16) * __uint_as_float(gq.y << 16), __uint_as_float(v.y & 0xffff0000u) * __uint_as_float(gq.y & 0xffff0000u));
        w.z = cvtpk(__uint_as_float(v.z << 16) * __uint_as_float(gq.z << 16), __uint_as_float(v.z & 0xffff0000u) * __uint_as_float(gq.z & 0xffff0000u));
        w.w = cvtpk(__uint_as_float(v.w << 16) * __uint_as_float(gq.w << 16), __uint_as_float(v.w & 0xffff0000u) * __uint_as_float(gq.w & 0xffff0000u));
        *(u32x4*)(MIX + (orow0 + row) * DM + DPOOL + h * DV + ch * 8) = w; }
    __syncthreads();
#undef SLOAD
#undef SWRITE
#undef RESC
#undef QKT
#undef PV
}
}

namespace sattn {
__device__ __forceinline__ int crow(int r, int hi) { return (r & 3) + 8 * (r >> 2) + 4 * hi; }
__device__ __forceinline__ bf16x8 packf8(const f32x16& a, int base, float s) {
    u32x4 w; w.x = cvtpk(a[base + 0] * s, a[base + 1] * s); w.y = cvtpk(a[base + 2] * s, a[base + 3] * s); w.z = cvtpk(a[base + 4] * s, a[base + 5] * s); w.w = cvtpk(a[base + 6] * s, a[base + 7] * s);
    return __builtin_bit_cast(bf16x8, w);
}
constexpr int NKB = (SKV_S + 31) / 32;
constexpr int WROW = 528;
constexpr int PS_OFF = 69632;
constexpr int QF_OFF = 256 * WROW;
constexpr int CQ_STRIDE = 260;

__device__ __forceinline__ void unit(int b, int h, const bf16_t* __restrict__ CKVB, const bf16_t* __restrict__ KRB, const bf16_t* __restrict__ CKVN, const bf16_t* __restrict__ KRN, const bf16_t* __restrict__ CT,
                                     const bf16_t* __restrict__ Wukv_t, const bf16_t* __restrict__ QCAT, const bf16_t* __restrict__ SGM, bf16_t* MIX, LAS unsigned char* lds, LAS unsigned char* scr, int wv) {
    int lane = lane_id(); asm volatile("" : "+v"(lane));
    const int wid = wv, tid = (wv << 6) | lane, r32 = lane & 31, hh = lane >> 5;
    LAS unsigned char* qf = lds + QF_OFF;
    { const bf16_t* Wsrc = Wukv_t + (size_t)h * 256 * KVRANK;
#pragma unroll 4
      for (int i = 0; i < 8; ++i) { const int gi = tid + 512 * i, row = gi >> 5, c16 = gi & 31; const u32x4 v = *(const u32x4*)(Wsrc + (size_t)gi * 8);
          *(LAS u32x4*)(lds + row * WROW + (c16 << 4)) = v; } }
    { const bf16_t* qp = QCAT + (size_t)(MP + b * DSEQ + (r32 & 15)) * (NHEAD * DQK) + h * DQK;
      for (int f = wid; f < 12; f += 8) { u32x4 v = {0u, 0u, 0u, 0u};
          if (r32 < DSEQ) { if (f < 8) { const bf16_t* p = qp + (f >> 1) * 32 + (f & 1) * 16 + 4 * hh; const u32x2 lo = *(const u32x2*)p, hi2 = *(const u32x2*)(p + 8); v = (u32x4){lo.x, lo.y, hi2.x, hi2.y}; }
                            else v = *(const u32x4*)(qp + DNOPE + (f - 8) * 16 + 8 * hh); }
          *(LAS u32x4*)(qf + f * 1024 + lane * 16) = v; } }
    __syncthreads();
    float m_run = -1e30f, l_run = 0.f; f32x4 ol[16];
#pragma unroll
    for (int i = 0; i < 16; ++i) ol[i] = (f32x4){0.f, 0.f, 0.f, 0.f};
    LAS float* rks = (LAS float*)(lds + MISC_OFF + 256) + wid * 32;
    LAS unsigned char* ps = lds + PS_OFF + wid * 2048;
    LAS const unsigned char* wk = lds + r32 * WROW + hh * 16; LAS const unsigned char* qfl = qf + lane * 16;
    const int q16 = lane & 15, kq = lane >> 4;
    const bf16_t* ctl = CT + (size_t)lane * 8; const bf16_t* cbl = CKVB + (size_t)b * (CKVT_B / 2) + (size_t)lane * 8;
    for (int kb = wid; kb < NKB; kb += 8) {
        int key = kb * 32 + r32; if (key > SKV_S - 1) key = SKV_S - 1;
        const bf16_t* kp = (key < PAST ? KRB + (size_t)(b * PAST + key) * DROPE : KRN + (size_t)(MP + b * DSEQ + key - PAST) * DROPE) + 8 * hh;
        f32x16 z = f32x16{}; float ssq = 0.f;
        bf16x8 rf[4];
#pragma unroll
        for (int s = 0; s < 4; ++s) rf[s] = *(const bf16x8*)(kp + 16 * s);
        {
        bf16x8 cf[16];
#pragma unroll
        for (int s = 0; s < 16; ++s) cf[s] = *(const bf16x8*)(cbl + (size_t)(kb * 16 + s) * 512);
#pragma unroll
        for (int dh = 0; dh < 2; ++dh) {
            f32x16 acc[2];
#pragma unroll
            for (int d2 = 0; d2 < 2; ++d2) { acc[d2] = f32x16{};
#pragma unroll
                for (int s = 0; s < 16; ++s) { const bf16x8 wa = *(LAS const bf16x8*)(wk + (dh * 2 + d2) * 32 * WROW + s * 32);
                    acc[d2] = __builtin_amdgcn_mfma_f32_32x32x16_bf16(wa, cf[s], acc[d2], 0, 0, 0); } }
            SBAR();
            bf16x8 kn[4];
#pragma unroll
            for (int d2 = 0; d2 < 2; ++d2) {
#pragma unroll
                for (int r = 0; r < 16; ++r) ssq += acc[d2][r] * acc[d2][r];
                kn[2 * d2] = packf8(acc[d2], 0, 1.f); kn[2 * d2 + 1] = packf8(acc[d2], 8, 1.f); }
            SBAR();
#pragma unroll
            for (int f = 0; f < 4; ++f) { const bf16x8 qb = *(LAS const bf16x8*)(qfl + (dh * 4 + f) * 1024); z = __builtin_amdgcn_mfma_f32_32x32x16_bf16(kn[f], qb, z, 0, 0, 0); }
            SBAR();
        }
        }
        bf16x8 af[16];
        { const bf16_t* ck = ctl + (size_t)kb * 16 * 512;
#pragma unroll
          for (int lb = 0; lb < 16; ++lb) af[lb] = *(const bf16x8*)(ck + lb * 512); }
        { auto rr = __builtin_amdgcn_permlane32_swap(__float_as_uint(ssq), __float_as_uint(ssq), false, false); ssq = __uint_as_float(rr[0]) + __uint_as_float(rr[1]); }
        rks[lane & 31] = 1.0f / sqrtf(ssq * (1.f / DNOPE) + EPS);
        asm volatile("s_waitcnt lgkmcnt(0)" ::: "memory");
#pragma unroll
        for (int g4 = 0; g4 < 4; ++g4) { const f32x4 rv = *(LAS const f32x4*)(rks + 8 * g4 + 4 * hh);
#pragma unroll
            for (int j = 0; j < 4; ++j) z[4 * g4 + j] *= rv[j]; }
#pragma unroll
        for (int s = 0; s < 4; ++s) { const bf16x8 qb = *(LAS const bf16x8*)(qfl + (8 + s) * 1024); z = __builtin_amdgcn_mfma_f32_32x32x16_bf16(rf[s], qb, z, 0, 0, 0); }
        SBAR();
        if (kb == NKB - 1) {
#pragma unroll
            for (int r = 0; r < 16; ++r) if (kb * 32 + crow(r, hh) >= SKV_S) z[r] = -1e30f;
        }
        float mx = z[0];
#pragma unroll
        for (int r = 1; r < 16; ++r) mx = fmaxf(mx, z[r]);
        { auto rr = __builtin_amdgcn_permlane32_swap(__float_as_uint(mx), __float_as_uint(mx), false, false); mx = fmaxf(__uint_as_float(rr[0]), __uint_as_float(rr[1])); }
        const float mn = fmaxf(m_run, mx), alpha = __builtin_amdgcn_exp2f(m_run - mn); m_run = mn;
        float psum = 0.f;
#pragma unroll
        for (int r = 0; r < 16; ++r) { z[r] = __builtin_amdgcn_exp2f(z[r] - mn); psum += z[r]; }
        l_run = l_run * alpha + psum;
        if (r32 < DSEQ) {
#pragma unroll
            for (int k4 = 0; k4 < 4; ++k4) { u32x2 w; w.x = cvtpk(z[4 * k4], z[4 * k4 + 1]); w.y = cvtpk(z[4 * k4 + 2], z[4 * k4 + 3]); *(LAS u32x2*)(ps + (r32 * 4 + k4) * 16 + 8 * hh) = w; }
            if (hh == 0) *(LAS float*)(ps + 1024 + 4 * r32) = alpha;
        }
        asm volatile("s_waitcnt lgkmcnt(0)" ::: "memory");
        const bf16x8 pf = *(LAS const bf16x8*)(ps + (q16 * 4 + kq) * 16); const float al16 = *(LAS const float*)(ps + 1024 + 4 * q16);
        SBAR();
#pragma unroll
        for (int lb = 0; lb < 16; ++lb) ol[lb] = __builtin_amdgcn_mfma_f32_16x16x32_bf16(af[lb], pf, ol[lb] * al16, 0, 0, 0);
        SBAR();
    }
    { auto rr = __builtin_amdgcn_permlane32_swap(__float_as_uint(l_run), __float_as_uint(l_run), false, false); l_run = __uint_as_float(rr[0]) + __uint_as_float(rr[1]); }
    __syncthreads();
    LAS float* comb = (LAS float*)lds; LAS float* ml = (LAS float*)(lds + QF_OFF);
    const int lane2 = lane_id(), tid2 = (wv << 6) | lane2;
    { const int qq = lane2 & 15, rq = lane2 >> 4;
#pragma unroll
      for (int lb = 0; lb < 16; ++lb) *(LAS f32x4*)(comb + (wid * 16 + qq) * CQ_STRIDE + lb * 16 + 4 * rq) = ol[lb];
      if (lane2 < DSEQ) { ml[wid * 16 + lane2] = m_run; ml[128 + wid * 16 + lane2] = l_run; } }
    __syncthreads();
    { const int q = tid2 >> 5, l0 = (tid2 & 31) * 8; float M = ml[q];
#pragma unroll
      for (int w = 1; w < 8; ++w) M = fmaxf(M, ml[w * 16 + q]);
      float L = 0.f; f32x4 a0 = {0.f, 0.f, 0.f, 0.f}, a1 = {0.f, 0.f, 0.f, 0.f};
#pragma unroll
      for (int w = 0; w < 8; ++w) { const float e = __builtin_amdgcn_exp2f(ml[w * 16 + q] - M); L += ml[128 + w * 16 + q] * e; const LAS float* cp = comb + (w * 16 + q) * CQ_STRIDE + l0;
          a0 += *(LAS const f32x4*)cp * e; a1 += *(LAS const f32x4*)(cp + 4) * e; }
      const float rl = 1.0f / L;
      __syncthreads();
      *(LAS f32x4*)(comb + q * CQ_STRIDE + l0) = a0 * rl; *(LAS f32x4*)(comb + q * CQ_STRIDE + l0 + 4) = a1 * rl; }
    __syncthreads();
    { const int q16b = lane2 & 15, kqb = lane2 >> 4; const bf16_t* wvp = Wukv_t + ((size_t)h * 256 + 128 + wid * 16 + q16b) * KVRANK + 8 * kqb;
      const LAS float* arow = comb + q16b * CQ_STRIDE + 8 * kqb;
      f32x4 od = {0.f, 0.f, 0.f, 0.f};
#pragma unroll
      for (int ks = 0; ks < 8; ++ks) { const f32x4 x0 = *(LAS const f32x4*)(arow + 32 * ks), x1 = *(LAS const f32x4*)(arow + 32 * ks + 4);
          const bf16x8 af2 = __builtin_bit_cast(bf16x8, pack8(x0, x1)); const bf16x8 bf2 = *(const bf16x8*)(wvp + 32 * ks);
          od = __builtin_amdgcn_mfma_f32_16x16x32_bf16(af2, bf2, od, 0, 0, 0); }
      const int dim = wid * 16 + q16b;
#pragma unroll
      for (int r = 0; r < 4; ++r) { const size_t row = (size_t)(MP + b * DSEQ + 4 * kqb + r);
          const float gt = bf2f(SGM[row * 1024 + h * DV + dim]); MIX[row * DM + DPOOL + h * DV + dim] = (bf16_t)(cvtpk(od[r] * gt, 0.f) & 0xffffu); } }
    __syncthreads();
}
}

__device__ __forceinline__ void pool_window_block(int blk, const bf16_t* __restrict__ Z, const bf16_t* __restrict__ SGP, const float* __restrict__ pscale, bf16_t* MIX, int wv) {
    const int tid = TIDX(wv), m0 = blk * 32 + (tid >> 7) * 8, col = (tid & 127) * 8, w = 2 << (col >> 8);
    const bool smp = m0 >= MP; const int sb = (m0 - MP) >> 4;
    const int u0 = smp ? POOLH + ((m0 - MP) & 15) : (m0 & (SEQ - 1));
    const long base_new = smp ? (long)(MP + sb * DSEQ) - POOLH : (long)(m0 - u0);
    const long base_hist = (long)MT + sb * POOLH;
#define ZROW(u) ((smp && (u) < POOLH) ? base_hist + (u) : base_new + (u))
#define LD8(dst, u) do { const u32x4 v_ = *(const u32x4*)(Z + ZROW(u) * DPOOL + col); dst[0] = __uint_as_float(v_.x << 16); dst[1] = __uint_as_float(v_.x & 0xffff0000u); dst[2] = __uint_as_float(v_.y << 16); dst[3] = __uint_as_float(v_.y & 0xffff0000u); \
    dst[4] = __uint_as_float(v_.z << 16); dst[5] = __uint_as_float(v_.z & 0xffff0000u); dst[6] = __uint_as_float(v_.w << 16); dst[7] = __uint_as_float(v_.w & 0xffff0000u); } while (0)
    float S[8];
#pragma unroll
    for (int i = 0; i < 8; ++i) S[i] = 0.f;
    for (int j = 1; j < w; ++j) { const int u = u0 - j; if (u >= 0) { float t[8]; LD8(t, u);
#pragma unroll
        for (int i = 0; i < 8; ++i) S[i] += t[i]; } }
    const f32x4 p0 = *(const f32x4*)(pscale + col), p1 = *(const f32x4*)(pscale + col + 4);
#pragma unroll
    for (int r = 0; r < 8; ++r) { const int u = u0 + r; float zc[8]; LD8(zc, u);
#pragma unroll
        for (int i = 0; i < 8; ++i) S[i] += zc[i];
        const int pos1 = smp ? SEQ : u + 1; const float rc = 1.0f / (float)(pos1 < w ? pos1 : w);
        const u32x4 gq = *(const u32x4*)(SGP + (size_t)(m0 + r) * DPOOL + col);
        const float gv[8] = {__uint_as_float(gq.x << 16), __uint_as_float(gq.x & 0xffff0000u), __uint_as_float(gq.y << 16), __uint_as_float(gq.y & 0xffff0000u),
                             __uint_as_float(gq.z << 16), __uint_as_float(gq.z & 0xffff0000u), __uint_as_float(gq.w << 16), __uint_as_float(gq.w & 0xffff0000u)};
        float ov[8];
#pragma unroll
        for (int i = 0; i < 8; ++i) ov[i] = (S[i] * rc - zc[i]) * (i < 4 ? p0[i] : p1[i - 4]) * gv[i];
        u32x4 wv4; wv4.x = cvtpk(ov[0], ov[1]); wv4.y = cvtpk(ov[2], ov[3]); wv4.z = cvtpk(ov[4], ov[5]); wv4.w = cvtpk(ov[6], ov[7]);
        *(u32x4*)(MIX + (size_t)(m0 + r) * DM + col) = wv4;
        const int ud = u - w + 1; if (ud >= 0) { float t[8]; LD8(t, ud);
#pragma unroll
            for (int i = 0; i < 8; ++i) S[i] -= t[i]; } }
#undef ZROW
#undef LD8
}

#define XB_TMO      128
#define XB_XCNT(j)  (256  + 64 * (j))
#define XB_XSUB(j)  (1280 + 64 * (j))
#define XB_XGEN(j)  (2304 + 64 * (j))
#define XB_TOP      3328
#define XB_TOPGEN   3392
#define XCD_BAR_WORDS 3456
#define XB_SPIN_CAP (1u << 22)
__device__ __forceinline__ unsigned xb_ld(unsigned* p)              { return __hip_atomic_load(p, __ATOMIC_RELAXED, __HIP_MEMORY_SCOPE_AGENT); }
__device__ __forceinline__ unsigned xb_add(unsigned* p, unsigned v) { return __hip_atomic_fetch_add(p, v, __ATOMIC_RELAXED, __HIP_MEMORY_SCOPE_AGENT); }
__device__ __forceinline__ unsigned xb_xcc_id() { return (unsigned)__builtin_amdgcn_s_getreg((3 << 11) | 20) & 0xFu; }
#define XB_SPIN(cond, bar) do { unsigned _sp = 0; while (cond) { __builtin_amdgcn_s_sleep(1); \
    if ((++_sp & 255u) == 0u) { if (xb_ld(&(bar)[XB_TMO])) break; if (_sp > XB_SPIN_CAP) { atomicAdd(&(bar)[XB_TMO], 1u); break; } } } } while (0)
struct XcdBarrier { unsigned* bar; unsigned x; volatile LAS unsigned* st; };
__device__ __forceinline__ XcdBarrier xcd_barrier_post(unsigned* bar, volatile LAS unsigned* st, int wv) {
    XcdBarrier b; b.bar = bar; b.x = xb_xcc_id(); b.st = st;
    if (TIDX(wv) == 0) (void)xb_add(&bar[XB_XCNT(b.x)], 1u);
    return b;
}
__device__ __forceinline__ void xcd_barrier_complete(unsigned* bar, unsigned x, unsigned& nloc, unsigned& nx) {
    const unsigned G = gridDim.x * gridDim.y * gridDim.z;
    unsigned sum, cnt, mine, sp = 0u;
    for (;;) {
        sum = 0u; cnt = 0u; mine = 0u;
#pragma unroll
        for (unsigned j = 0; j < 16; ++j) { const unsigned c = xb_ld(&bar[XB_XCNT(j)]); sum += c; cnt += (c > 0u) ? 1u : 0u; mine = (j == x) ? c : mine; }
        if (sum == G) break;
        __builtin_amdgcn_s_sleep(1);
        if ((++sp & 255u) == 0u) { if (xb_ld(&bar[XB_TMO])) break; if (sp > XB_SPIN_CAP) { atomicAdd(&bar[XB_TMO], 1u); break; } }
    }
    nloc = mine > 0u ? mine : 1u; nx = cnt > 0u ? cnt : 1u;
}
__device__ __forceinline__ void xcd_barrier(const XcdBarrier& b, int wv) {
    asm volatile("s_waitcnt vmcnt(0)" ::: "memory");
    __syncthreads();
    if (TIDX(wv) == 0) {
        unsigned* bar = b.bar;
        __builtin_amdgcn_s_waitcnt(0);
        unsigned nloc = b.st[0], nx = b.st[1];
        if (nloc == 0u) { xcd_barrier_complete(bar, b.x, nloc, nx); b.st[0] = nloc; b.st[1] = nx; }
        const unsigned old = xb_add(&bar[XB_XSUB(b.x)], 1u);
        const unsigned gen = old / nloc;
        if (old + 1u == (gen + 1u) * nloc) {
            __builtin_amdgcn_fence(__ATOMIC_RELEASE, "agent");
            asm volatile("s_waitcnt vmcnt(0)" ::: "memory");
            const unsigned og = xb_add(&bar[XB_TOP], 1u);
            const unsigned tg = og / nx;
            if (og + 1u == (tg + 1u) * nx) xb_add(&bar[XB_TOPGEN], 1u);
            else XB_SPIN(xb_ld(&bar[XB_TOPGEN]) == tg, bar);
            __builtin_amdgcn_fence(__ATOMIC_ACQUIRE, "agent");
            xb_add(&bar[XB_XGEN(b.x)], 1u);
            asm volatile("s_waitcnt vmcnt(0)" ::: "memory");
        } else {
            XB_SPIN(xb_ld(&bar[XB_XGEN(b.x)]) == gen, bar);
            __builtin_amdgcn_fence(__ATOMIC_ACQUIRE, "agent");
            asm volatile("s_waitcnt vmcnt(0)" ::: "memory");
        }
    }
    __syncthreads();
}

constexpr int N_PHASES = 5;
__global__ void __launch_bounds__(512, 2) hymba_fwd(Args a) {
    extern __shared__ __attribute__((aligned(16))) unsigned char lds_raw[];
    LAS unsigned char* lds = (LAS unsigned char*)lds_raw;
    LAS unsigned char* scr = lds + SCR_OFF;
    volatile LAS unsigned* MISC = (volatile LAS unsigned*)(lds + MISC_OFF);
    const int wv = __builtin_amdgcn_readfirstlane((int)threadIdx.x >> 6);
    const int tid = TIDX(wv);
    const int G = gridDim.x; const int bx = blockIdx.x; const int vcu = (G % 8 == 0) ? (bx % 8) * (G / 8) + bx / 8 : bx;
    unsigned char* ws = a.ws; float* out = a.out;
    if (tid < 64) MISC[tid] = 0u;
    __syncthreads();
    XcdBarrier bar; bar.bar = (unsigned*)(ws + WS_CTL) + 1024 + a.li * XCD_BAR_WORDS; bar.x = 0; bar.st = nullptr;
    const bool one_launch = (a.ph_hi - a.ph_lo) > 1;
    if (one_launch) bar = xcd_barrier_post((unsigned*)(ws + WS_CTL) + 1024 + a.li * XCD_BAR_WORDS, MISC + 8, wv);
    const int lo = a.ph_lo, hi = a.ph_hi;
#ifndef PHASE_MASK
#define PHASE_MASK 63
#endif
#define IN(k) (((PHASE_MASK >> (k)) & 1) && lo <= (k) && (k) < hi)
#define SEAM(k) do { if (IN(k) && IN((k) + 1)) xcd_barrier(bar, wv); } while (0)
#define WSP(T, off) ((T*)(ws + (off)))
    if (IN(0)) { p0_prologue(a, lds, vcu, G, wv, 0); __syncthreads(); }
    SEAM(0);
    if (IN(1)) {
        pg8::SchedP1 S{(const char*)ws, bx, G};
        pg8::EpiInProj E{ws, out};
        pg8::gemm_phase(lds, scr, S, E, wv);
        __syncthreads(); p0_prologue(a, lds, vcu, G, wv, 1);
    }
    SEAM(1);
    if (IN(2)) {
        { pg8::SchedP2 S{(const char*)ws, bx, G};
          pg8::EpiP2 E{ws};
          pg8::gemm_phase(lds, scr, S, E, wv); }
        {
            const float* c1 = AIN(I_CCKV);
            unsigned* cctr = (unsigned*)(ws + WS_CTL) + 11520 + 64 * a.li; constexpr int NC = DBATCH * 256 / 8;
            for (;;) {
                if (TIDX(wv) == 0) MISC[22] = __hip_atomic_fetch_add(cctr, 1u, __ATOMIC_RELAXED, __HIP_MEMORY_SCOPE_AGENT);
                __syncthreads();
                const int ch = (int)MISC[22];
                __syncthreads();
                if (ch >= NC) break;
                const int item = ch * 8 + wv, bb = item >> 8, kbk = (item & 255) >> 3, nb = item & 7;
                cache_item(c1 + (size_t)bb * PAST * KVRANK, WSP(bf16_t, WS_CKVB) + (size_t)bb * (CKVT_B / 2), ckvt_base(ws, bb), 64 * kbk, 32 * nb, (LAS float*)(lds + wv * 16384), lane_id(), true, bb >= NBT_A);
            }
            { const bf16_t* CKVN = WSP(bf16_t, WS_CKVN);
              for (int i = vcu * 512 + TIDX(wv); i < DBATCH * 16 * 64; i += G * 512) { const int bb = i >> 10, sb = (i >> 6) & 15, ln = i & 63;
                  const bf16_t* nk = CKVN + (size_t)(MP + bb * DSEQ) * KVRANK; const size_t fo = ((size_t)(64 * 16 + sb) * 64 + ln) * 8;
                  { const int t = ln & 31; u32x4 w = {0u, 0u, 0u, 0u}; if (t < DSEQ) w = *(const u32x4*)(nk + (size_t)t * KVRANK + 16 * sb + 8 * (ln >> 5));
                    *(u32x4*)(WSP(bf16_t, WS_CKVB) + (size_t)bb * (CKVT_B / 2) + fo) = w; }
                  { const int kq = ln >> 4; u32x4 w = {0u, 0u, 0u, 0u};
                    if (kq < 2) { const bf16_t* p = nk + (size_t)(8 * kq) * KVRANK + 16 * sb + (ln & 15);
                        w.x = p[0] | ((unsigned)p[KVRANK] << 16); w.y = p[2 * KVRANK] | ((unsigned)p[3 * KVRANK] << 16); w.z = p[4 * KVRANK] | ((unsigned)p[5 * KVRANK] << 16); w.w = p[6 * KVRANK] | ((unsigned)p[7 * KVRANK] << 16); }
                    *(u32x4*)(ckvt_base(ws, bb) + fo) = w; } } }
        }
    }
    SEAM(2);
    if (IN(3)) {
        const int qx = bx & 7; unsigned* ctr = (unsigned*)(ws + WS_CTL) + 8192 + 1024 * a.li + 64 * qx;
        for (;;) {
            if (TIDX(wv) == 0) MISC[20] = __hip_atomic_fetch_add(ctr, 1u, __ATOMIC_RELAXED, __HIP_MEMORY_SCOPE_AGENT);
            __syncthreads();
            const int it = (int)MISC[20];
            __syncthreads();
            if (it >= 98) break;
            if (it >= 64) { const int blk = (it - 64) * 8 + qx; pool_window_block(blk, WSP(bf16_t, WS_Z), WSP(bf16_t, WS_SGP), AIN(I_PSCALE), WSP(bf16_t, WS_MIX), wv); }
            else if (it >= 8 && it < 40) { const int j = it - 8, sb = qx * 4 + (j >> 3), sh = j & 7;
                sattn::unit(sb, sh, WSP(bf16_t, WS_CKVB), WSP(bf16_t, WS_KRB), WSP(bf16_t, WS_CKVN), WSP(bf16_t, WS_KRN), ckvt_base(ws, sb), WSP(bf16_t, WS_WUKV), WSP(bf16_t, WS_QCAT), WSP(bf16_t, WS_SGM), WSP(bf16_t, WS_MIX), lds, scr, wv); }
            else { const int k = it < 8 ? it : it - 32, qb = 7 - (k >> 2), bh = qx * 4 + (k & 3);
                pattn::unit(bh >> 3, bh & 7, qb, WSP(bf16_t, WS_QCAT), WSP(bf16_t, WS_KCAT), WSP(bf16_t, WS_KRN), WSP(bf16_t, WS_V), WSP(bf16_t, WS_SGM), WSP(bf16_t, WS_MIX), lds, wv); }
        }
    }
    SEAM(3);
    if (IN(4)) {
        unsigned* pcnt = (unsigned*)(ws + WS_CTL) + 13312 + 2560 * a.li;
        pg8::EpiP45 E{ws, out};
        { pg8::SchedP45 S{(const char*)ws, pcnt, bx, G, 1}; pg8::gemm_phase(lds, scr, S, E, wv); }
        { pg8::SchedP45 S{(const char*)ws, pcnt, bx, G, 2}; pg8::gemm_phase(lds, scr, S, E, wv); }
    }
#undef IN
#undef SEAM
}

extern "C" void kernel_launch(void* const* d_in, const int* in_sizes, int n_in, void* d_out, int out_size, void* d_ws, size_t ws_size, hipStream_t stream) {
    static int grid = 0;
    if (grid == 0) {
        if (n_in != 24 || in_sizes[0] != MP * DM || out_size != 21164032 || ws_size < WS_END) {
            fprintf(stderr, "kernel_launch: shape mismatch: n_in %d in0 %d out %d ws %zu (need >= %zu)\n", n_in, n_in > 0 ? in_sizes[0] : -1, out_size, ws_size, (size_t)WS_END); grid = -1; return; }
        int dev = 0, cus = 0, per_cu = 0;
        if (hipGetDevice(&dev) != hipSuccess || hipDeviceGetAttribute(&cus, hipDeviceAttributeMultiprocessorCount, dev) != hipSuccess) { fprintf(stderr, "kernel_launch: device query failed\n"); grid = -1; return; }
        if (hipFuncSetAttribute((const void*)hymba_fwd, hipFuncAttributeMaxDynamicSharedMemorySize, LDS_BYTES) != hipSuccess) { fprintf(stderr, "kernel_launch: hipFuncSetAttribute failed\n"); grid = -1; return; }
        if (hipOccupancyMaxActiveBlocksPerMultiprocessor(&per_cu, (const void*)hymba_fwd, 512, LDS_BYTES) != hipSuccess || per_cu < 1)
            fprintf(stderr, "kernel_launch: note: occupancy query reports %d workgroups per CU\n", per_cu);
        (void)hipGetLastError();
        grid = cus;
    }
    if (grid < 0) return;
    if (hipMemsetAsync((char*)d_ws + WS_CTL, 0, CTL_ZERO_BYTES, stream) != hipSuccess) { fprintf(stderr, "kernel_launch: memset failed\n"); return; }
    Args a{};
    for (int i = 0; i < 24; ++i) a.in[i] = (const float*)d_in[i];
    a.out = (float*)d_out; a.ws = (unsigned char*)d_ws;
#if MK_N_LAUNCHES == 1
    a.ph_lo = 0; a.ph_hi = N_PHASES;
    hipLaunchKernelGGL(hymba_fwd, dim3(grid), dim3(512), LDS_BYTES, stream, a);
#else
    for (int p = 0; p < N_PHASES; ++p) { a.ph_lo = p; a.ph_hi = p + 1; hipLaunchKernelGGL(hymba_fwd, dim3(grid), dim3(512), LDS_BYTES, stream, a); }
#endif
    const hipError_t le = hipPeekAtLastError();
    if (le != hipSuccess) fprintf(stderr, "kernel_launch: launch failed: %s\n", hipGetErrorName(le));
}
```

```cpp
#include <hip/hip_runtime.h>
#include <hip/hip_bf16.h>
#include <cstdio>
#include <cstdint>

#ifndef DUP_PHASE
#define DUP_PHASE -1
#endif
#ifndef MK_N_LAUNCHES
#define MK_N_LAUNCHES 1
#endif

#define LAS __attribute__((address_space(3)))
#define GAS __attribute__((address_space(1)))
typedef unsigned short bf16_t;
typedef short bf16x8 __attribute__((ext_vector_type(8)));
typedef short s16x4 __attribute__((ext_vector_type(4)));
typedef float f32x4 __attribute__((ext_vector_type(4)));
typedef float f32x16 __attribute__((ext_vector_type(16)));
typedef unsigned u32x4 __attribute__((ext_vector_type(4)));
typedef unsigned u32x2 __attribute__((ext_vector_type(2)));
typedef float f32x2_t __attribute__((ext_vector_type(2)));
typedef __bf16 bf16x2_t __attribute__((ext_vector_type(2)));

constexpr int DM = 2048, NBATCH = 4, SEQ = 2048, DBATCH = 32, DSEQ = 16, PAST = 2048;
constexpr int MP = NBATCH * SEQ, MS = DBATCH * DSEQ, MT = MP + MS;
constexpr int DPOOL = 1024, NHEAD = 8, DNOPE = 128, DROPE = 64, DV = 128, QRANK = 512, KVRANK = 256, DPLE = 256;
constexpr int DQK = DNOPE + DROPE;
constexpr int DIN = 3904, DINP = 4096;
constexpr int SKV_S = PAST + DSEQ;
constexpr int POOLH = 15;
constexpr int MZ = 9216;
constexpr float EPS = 1e-6f;
constexpr float C2 = 0.07216878364870322f * 1.4426950408889634f;
constexpr size_t O_Y = 0, O_CKVP = 17825792, O_KRP = 19922944, O_POOLP = 20447232, O_CKVS = 20508672, O_KRS = 20639744, O_POOLS = 20672512;

constexpr size_t MiB = 1u << 20;
constexpr size_t WS_CTL = 0, CTL_ZERO_BYTES = 128 * 1024;
constexpr size_t WS_WIN = 1 * MiB;
constexpr size_t WS_WUQ = 17 * MiB;
constexpr size_t WS_WUKV = 18 * MiB + MiB / 2;
constexpr size_t WS_WPOOL = 19 * MiB + MiB / 2;
constexpr size_t WS_WOUT = 20 * MiB;
constexpr size_t WS_WGATE = 28 * MiB;
constexpr size_t WS_WPLE = 36 * MiB;
constexpr size_t WS_COS = 37 * MiB;
constexpr size_t WS_SIN = 37 * MiB + MiB / 2;
constexpr size_t WS_SSQCQ = 38 * MiB;
constexpr size_t WS_SSQH = 38 * MiB + MiB / 2;
constexpr size_t WS_CKVN = 39 * MiB;
constexpr size_t WS_KRN = 43 * MiB + MiB / 2;
constexpr size_t WS_PBF = 45 * MiB;
constexpr size_t WS_XN = 49 * MiB + MiB / 2;
constexpr size_t WS_CKVB = WS_XN;
constexpr size_t WS_KRB = 227 * MiB;
constexpr int CKVT_LD = 2080; constexpr size_t CKVT_B = (size_t)KVRANK * CKVT_LD * 2; constexpr int NBT_A = 20;
constexpr size_t WS_CKVT_A = 235 * MiB, WS_CKVT_B = WS_WIN;
constexpr int NB_EARLY = 0;
constexpr size_t WS_CKVB2 = WS_CKVT_A;
constexpr size_t WS_UBF = 83 * MiB + MiB / 2;
constexpr size_t WS_CQ = 101 * MiB + MiB / 2;
constexpr size_t WS_MIX = WS_UBF;
constexpr size_t WS_SGP = 117 * MiB + MiB / 2;
constexpr size_t WS_Z = 134 * MiB + MiB / 2;
constexpr size_t WS_PV = WS_SGP;
constexpr size_t WS_SGM = 152 * MiB + MiB / 2;
constexpr size_t WS_QCAT = 169 * MiB + MiB / 2;
constexpr size_t WS_KCAT = 195 * MiB;
constexpr size_t WS_HBF = WS_QCAT;
constexpr size_t WS_V = 211 * MiB;
constexpr size_t WS_END = 256 * MiB;
static_assert(WS_MIX + (size_t)MT * DM * 2 <= WS_SGP && WS_PV + (size_t)MT * DM * 2 <= WS_SGM && WS_HBF + (size_t)MT * DM * 2 <= WS_V && WS_END <= 256 * MiB, "d_ws map");
static_assert(WS_CKVB + (size_t)DBATCH * 1064960 <= WS_UBF && WS_KRB + (size_t)DBATCH * PAST * DROPE * 2 <= WS_CKVT_A && WS_CKVT_A + NBT_A * CKVT_B <= WS_END && (DBATCH - NBT_A) * CKVT_B <= 16 * MiB && WS_V + 16 * MiB <= WS_KRB, "d_ws map (cache copies)");

constexpr int RING_BYTES = 131072;
constexpr int SCR_OFF = RING_BYTES;
constexpr int SCR_BYTES = 16384;
constexpr int MISC_OFF = SCR_OFF + SCR_BYTES;
constexpr int LDS_BYTES = 151552;

#define LDS_WAIT() asm volatile("s_waitcnt lgkmcnt(0)" ::: "memory")
#define VM_WAIT() asm volatile("s_waitcnt vmcnt(0)" ::: "memory")
#define WG_BAR() do { asm volatile("s_waitcnt lgkmcnt(0)" ::: "memory"); __builtin_amdgcn_s_barrier(); asm volatile("" ::: "memory"); } while (0)
#define SBAR() __builtin_amdgcn_sched_barrier(0)
__device__ __forceinline__ unsigned cvtpk(float lo, float hi) { f32x2_t v = {lo, hi}; bf16x2_t b = __builtin_convertvector(v, bf16x2_t); return __builtin_bit_cast(unsigned, b); }
__device__ __forceinline__ u32x4 pack8(f32x4 a, f32x4 b) { u32x4 w; w.x = cvtpk(a[0], a[1]); w.y = cvtpk(a[2], a[3]); w.z = cvtpk(b[0], b[1]); w.w = cvtpk(b[2], b[3]); return w; }
typedef __amdgpu_buffer_rsrc_t rsrc_t;
__device__ __forceinline__ rsrc_t make_rsrc(const void* p, unsigned bytes) { return __builtin_amdgcn_make_buffer_rsrc(const_cast<void*>(p), 0, bytes, 0x00020000); }
__device__ __forceinline__ void st16_wt(rsrc_t r, unsigned byteoff, u32x4 v) { __builtin_amdgcn_raw_buffer_store_b128(v, r, byteoff, 0, 16); }
__device__ __forceinline__ void st16_wt(rsrc_t r, unsigned byteoff, f32x4 v) { __builtin_amdgcn_raw_buffer_store_b128(__builtin_bit_cast(u32x4, v), r, byteoff, 0, 16); }
__device__ __forceinline__ float bf2f(unsigned short h) { return __uint_as_float((unsigned)h << 16); }
__device__ __forceinline__ float silu_f(float v) { return v / (1.f + __expf(-v)); }
__device__ __forceinline__ float sigmoid_f(float v) { return 1.f / (1.f + __expf(-v)); }
__device__ __forceinline__ float wave_sum(float v) {
#pragma unroll
    for (int o = 1; o < 64; o <<= 1) v += __shfl_xor(v, o);
    return v;
}
__device__ __forceinline__ int lane_id() { int l; asm volatile("v_mbcnt_lo_u32_b32 %0, -1, 0\n\tv_mbcnt_hi_u32_b32 %0, -1, %0" : "=v"(l)); return l; }
#define TIDX(wv) (((wv) << 6) | lane_id())
__device__ __forceinline__ int row_pos(int row) { return row < MP ? (row & (SEQ - 1)) : PAST + ((row - MP) & (DSEQ - 1)); }

#define AS4 __attribute__((address_space(4)))
__device__ __forceinline__ const float* arg_in(int k) {
    const char AS4* p = (const char AS4*)__builtin_amdgcn_kernarg_segment_ptr(); int off = k * 8; asm volatile("" : "+s"(off));
    return *(const float* const AS4*)(p + off);
}
#define AIN(k) arg_in(k)

namespace pg8 {
constexpr int BM = 256, BK = 64, HALF = 128, HTB = HALF * BK * 2, STAGE_BYTES = 8 * HTB, NXCD = 8, WGM = 8;
__host__ __device__ __forceinline__ int lds_byte(int r, int c) { const int st = (r >> 4) * 2 + (c >> 5), rr = r & 15, cc = c & 31, ob = rr * 64 + cc * 2; return st * 1024 + (ob ^ (((ob >> 9) & 1) << 5)); }
__host__ __device__ __forceinline__ void stage_rc(int b, int& R, int& C) { const int st = b / 1024, sb = b % 1024, swz = sb ^ (((sb >> 9) & 1) << 5); R = (st >> 1) * 16 + swz / 64; C = (st & 1) * 32 + (swz % 64) / 2; }
__host__ __device__ __forceinline__ int perm32(int rho) { const int n = rho >> 4, i = rho & 15; return 8 * (i >> 2) + 4 * n + (i & 3); }

struct Unit { const char* A; const char* B; int lda, ldb, nt, type, row0, pn, half, slice, uid; };
__device__ __forceinline__ void grid_map(int L, int nM, int nN, int& pm, int& pn) {
    const int nwg = nM * nN; int wgid = L; { const int q = nwg / NXCD, r = nwg % NXCD, xcd = wgid % NXCD, off = wgid / NXCD; wgid = (xcd < r ? xcd * (q + 1) : r * (q + 1) + (xcd - r) * q) + off; }
    const int nig = WGM * nN, gid = wgid / nig, fm = gid * WGM, gsz = (nM - fm) < WGM ? (nM - fm) : WGM;
    pm = fm + ((wgid % nig) % gsz); pn = (wgid % nig) / gsz;
}

template <class Sched, class Epi>
__device__ __forceinline__ void gemm_phase(LAS unsigned char* lds, LAS unsigned char* scr, const Sched& S, const Epi& E, int wv) {
    const int wid = wv, lane = lane_id(), tid = (wv << 6) | lane, wr = wid >> 2, wc = wid & 3, fr = lane & 15, fq = lane >> 4;
    Unit cur, nxt; int ui = 0;
    if (!S.get(0, cur)) return;
    int RA[2], RB[2], CC[2];
#pragma unroll
    for (int i = 0; i < 2; ++i) { int R, C; stage_rc(tid * 16 + i * 8192, R, C); RA[i] = R * 2; RB[i] = ((R & ~31) + perm32(R & 31)) * 2; CC[i] = C * 2; }
    unsigned voffA[2], voffB[2], nvA[2], nvB[2];
#pragma unroll
    for (int i = 0; i < 2; ++i) { voffA[i] = (unsigned)(RA[i] * cur.lda + CC[i]); voffB[i] = (unsigned)(RB[i] * cur.ldb + CC[i]); }
    const size_t kstep = (size_t)(BK * 2);
    unsigned hA = cur.half ? 0u : (unsigned)(HALF * cur.lda * 2), hB = (unsigned)(HALF * cur.ldb * 2);
    const unsigned ldsw = (unsigned)wid * 1024u;
    const int aoff = lds_byte(wr * 64 + fr, fq * 8), boff = lds_byte(wc * 32 + fr, fq * 8);
#define PG8_SA(b, h) (((b) * 2 + (h)) * HTB)
#define PG8_SB(b, h) ((4 + (b) * 2 + (h)) * HTB)
#define PG8_STAGE(bufoff, gbase, voff) do { _Pragma("unroll") for (int _i = 0; _i < 2; ++_i) \
        __builtin_amdgcn_global_load_lds((const unsigned*)((const char*)(gbase) + (voff)[_i]), (LAS unsigned*)(lds + (bufoff) + ldsw + _i * 8192), 16, 0, 0); } while (0)
#define PG8_LDA(dst, b, h) do { _Pragma("unroll") for (int m = 0; m < 4; ++m) _Pragma("unroll") for (int k = 0; k < 2; ++k) dst[m][k] = *(const LAS bf16x8*)(lds + PG8_SA(b, h) + aoff + m * 2048 + k * 1024); } while (0)
#define PG8_LDB(dst, b, h) do { _Pragma("unroll") for (int n = 0; n < 2; ++n) _Pragma("unroll") for (int k = 0; k < 2; ++k) dst[n][k] = *(const LAS bf16x8*)(lds + PG8_SB(b, h) + boff + n * 2048 + k * 1024); } while (0)
#define PG8_MMA(ai, bj, At, Bt) do { __builtin_amdgcn_s_setprio(1); _Pragma("unroll") for (int m = 0; m < 4; ++m) _Pragma("unroll") for (int n = 0; n < 2; ++n) _Pragma("unroll") for (int k = 0; k < 2; ++k) \
        acc[ai][bj][m][n] = __builtin_amdgcn_mfma_f32_16x16x32_bf16(Bt[n][k], At[m][k], acc[ai][bj][m][n], 0, 0, 0); __builtin_amdgcn_s_setprio(0); } while (0)
#define PG8_WAIT_V(n) asm volatile("s_waitcnt vmcnt(" #n ")" ::: "memory")
#define PG8_WAIT_L(n) asm volatile("s_waitcnt lgkmcnt(" #n ")" ::: "memory")
#define PG8_BAR __builtin_amdgcn_s_barrier()
#define PG8_SCHED __builtin_amdgcn_sched_barrier(0)
    f32x4 acc[2][2][4][2];
    { int fr_e = fr, fq_e = fq; asm volatile("" : "+v"(fr_e), "+v"(fq_e)); E.init(acc, cur, wr, wc, fr_e, fq_e); }
    bf16x8 At[4][2], B0[2][2], B1[2][2];
    const char* cA = cur.A; const char* cB = cur.B;
    int rot = ((S.c & 7) * cur.nt) >> 3, nrot = 0;
    S.a_ready(cur, wid);
    { const size_t k0 = (size_t)rot * kstep, k1 = (size_t)((rot + 1) & (cur.nt - 1)) * kstep;
    PG8_STAGE(PG8_SB(0, 0), cB + k0, voffB); PG8_STAGE(PG8_SB(0, 1), cB + hB + k0, voffB); PG8_STAGE(PG8_SA(0, 0), cA + k0, voffA); PG8_STAGE(PG8_SA(0, 1), cA + hA + k0, voffA);
    if (wr == 1) PG8_BAR;
    PG8_WAIT_V(2); PG8_BAR;
    PG8_STAGE(PG8_SB(1, 0), cB + k1, voffB); PG8_STAGE(PG8_SA(1, 0), cA + k1, voffA); PG8_STAGE(PG8_SB(1, 1), cB + hB + k1, voffB); }
    PG8_WAIT_V(6); PG8_BAR;
    for (;;) {
        const bool has_next = S.get(ui + 1, nxt);
        if (!has_next) nxt = cur;
#pragma unroll
        for (int i = 0; i < 2; ++i) { nvA[i] = (unsigned)(RA[i] * nxt.lda + CC[i]); nvB[i] = (unsigned)(RB[i] * nxt.ldb + CC[i]); }
        const unsigned nhA = nxt.half ? 0u : (unsigned)(HALF * nxt.lda * 2), nhB = (unsigned)(HALF * nxt.ldb * 2);
        const char* nA = nxt.A; const char* nB = nxt.B; nrot = ((S.c & 7) * nxt.nt) >> 3; const int nmask = nxt.nt - 1;
        int nt = __builtin_amdgcn_readfirstlane(cur.nt); asm volatile("" : "+s"(nt));
        const bool full = !cur.half;
        for (int t = 0; t < nt; t += 2) {
            const bool last = (t == nt - 2);
            if (last && has_next) S.a_ready(nxt, wid);
            const size_t o1 = (size_t)((t + 1 + rot) & (nt - 1)) * kstep;
            const size_t o2 = (size_t)(last ? (nrot & nmask) : ((t + 2 + rot) & (nt - 1))) * kstep, o3 = (size_t)(last ? ((nrot + 1) & nmask) : ((t + 3 + rot) & (nt - 1))) * kstep;
            const char* a1 = cA + o1;
            const char* a2 = (last ? nA : cA) + o2; const char* b2 = (last ? nB : cB) + o2;
            const char* a3 = (last ? nA : cA) + o3; const char* b3 = (last ? nB : cB) + o3;
            const unsigned hA2 = last ? nhA : hA, hB2 = last ? nhB : hB;
            unsigned vA2[2], vB2[2];
#pragma unroll
            for (int i = 0; i < 2; ++i) { vA2[i] = last ? nvA[i] : voffA[i]; vB2[i] = last ? nvB[i] : voffB[i]; }
            PG8_LDB(B0, 0, 0); PG8_LDB(B1, 0, 1); PG8_SCHED; PG8_LDA(At, 0, 0); PG8_STAGE(PG8_SA(1, 1), a1 + hA, voffA);
            PG8_WAIT_V(8); PG8_WAIT_L(0); PG8_BAR; PG8_MMA(0, 0, At, B0); PG8_MMA(0, 1, At, B1); PG8_BAR; PG8_SCHED;
            if (full) PG8_LDA(At, 0, 1);
            PG8_STAGE(PG8_SB(0, 0), b2, vB2); PG8_STAGE(PG8_SB(0, 1), b2 + hB2, vB2); PG8_STAGE(PG8_SA(0, 0), a2, vA2);
            PG8_WAIT_V(8); PG8_WAIT_L(0); PG8_BAR; if (full) { PG8_MMA(1, 0, At, B0); PG8_MMA(1, 1, At, B1); } PG8_BAR; PG8_SCHED;
            PG8_LDB(B0, 1, 0); PG8_LDB(B1, 1, 1); PG8_SCHED; PG8_LDA(At, 1, 0); PG8_STAGE(PG8_SA(0, 1), a2 + hA2, vA2);
            PG8_WAIT_V(8); PG8_WAIT_L(0); PG8_BAR; PG8_MMA(0, 0, At, B0); PG8_MMA(0, 1, At, B1); PG8_BAR; PG8_SCHED;
            if (full) PG8_LDA(At, 1, 1);
            PG8_STAGE(PG8_SB(1, 0), b3, vB2); PG8_STAGE(PG8_SB(1, 1), b3 + hB2, vB2); PG8_STAGE(PG8_SA(1, 0), a3, vA2);
            PG8_WAIT_V(8); PG8_WAIT_L(0); PG8_BAR; if (full) { PG8_MMA(1, 0, At, B0); PG8_MMA(1, 1, At, B1); } PG8_BAR; PG8_SCHED;
        }
        if (wr == 0) PG8_BAR;
        bool run_epi = true;
        if constexpr (Sched::SPLITK) {
            if (cur.slice >= 0) {
                constexpr int NSLICE = 4; constexpr unsigned SLABB = HALF * BM * 4;
                float* sl = S.slab(cur); const rsrc_t rs = make_rsrc(sl, NSLICE * SLABB); const unsigned lo = (unsigned)(wid * 16 * 64 + lane) * 16u;
#pragma unroll
                for (int bj = 0; bj < 2; ++bj)
#pragma unroll
                    for (int m = 0; m < 4; ++m)
#pragma unroll
                        for (int n = 0; n < 2; ++n) st16_wt(rs, (unsigned)cur.slice * SLABB + lo + (unsigned)(bj * 8 + m * 2 + n) * 1024u, acc[0][bj][m][n]);
                asm volatile("s_waitcnt vmcnt(0)" ::: "memory");
                PG8_BAR; asm volatile("" ::: "memory");
                volatile LAS unsigned* TK = (volatile LAS unsigned*)(lds + MISC_OFF) + 27;
                if (wid == 0 && lane == 0) { const unsigned old = __hip_atomic_fetch_add(S.ticket(cur), 1u, __ATOMIC_RELAXED, __HIP_MEMORY_SCOPE_AGENT);
                    if (old == NSLICE - 1) { __builtin_amdgcn_fence(__ATOMIC_ACQUIRE, "agent"); asm volatile("s_waitcnt vmcnt(0)" ::: "memory"); }
                    *TK = old; }
                asm volatile("s_waitcnt lgkmcnt(0)" ::: "memory"); PG8_BAR; asm volatile("" ::: "memory");
                run_epi = (*TK == NSLICE - 1);
                if (run_epi) {
#pragma unroll
                    for (int sp = 0; sp < NSLICE; ++sp) if (sp != cur.slice) { const char* ob = (const char*)sl + (size_t)sp * SLABB + lo;
#pragma unroll
                        for (int bj = 0; bj < 2; ++bj)
#pragma unroll
                            for (int m = 0; m < 4; ++m)
#pragma unroll
                                for (int n = 0; n < 2; ++n) acc[0][bj][m][n] += *(const f32x4*)(ob + (bj * 8 + m * 2 + n) * 1024); }
                }
                asm volatile("s_waitcnt lgkmcnt(0)" ::: "memory"); PG8_BAR; asm volatile("" ::: "memory");
            }
        }
        if (run_epi) {
        { int fr_e = fr, fq_e = fq; asm volatile("" : "+v"(fr_e), "+v"(fq_e));
          E(acc, cur, wr, wc, fr_e, fq_e, scr); }
        S.done(cur, wid);
        }
        if (!has_next) break;
        { int fr_e = fr, fq_e = fq; asm volatile("" : "+v"(fr_e), "+v"(fq_e)); E.init(acc, nxt, wr, wc, fr_e, fq_e); }
        cur = nxt; cA = nA; cB = nB; hA = nhA; hB = nhB; rot = nrot; ++ui;
#pragma unroll
        for (int i = 0; i < 2; ++i) { voffA[i] = nvA[i]; voffB[i] = nvB[i]; }
        if (wr == 1) PG8_BAR;
    }
    PG8_WAIT_V(0);
    PG8_BAR;
#undef PG8_SA
#undef PG8_SB
#undef PG8_STAGE
#undef PG8_LDA
#undef PG8_LDB
#undef PG8_MMA
#undef PG8_WAIT_V
#undef PG8_WAIT_L
#undef PG8_BAR
#undef PG8_SCHED
}

typedef f32x4 Acc[2][2][4][2];
__device__ __forceinline__ void acc_zero(Acc& acc) {
#pragma unroll
    for (int a = 0; a < 2; ++a)
#pragma unroll
        for (int b = 0; b < 2; ++b)
#pragma unroll
            for (int m = 0; m < 4; ++m)
#pragma unroll
                for (int n = 0; n < 2; ++n) acc[a][b][m][n] = (f32x4){0.f, 0.f, 0.f, 0.f};
}
#define EPI_INIT_ZERO __device__ __forceinline__ void init(Acc& acc, const Unit&, int, int, int, int) const { acc_zero(acc); }
template <int NG>
__device__ __forceinline__ void xwave_rowsum(float (&p)[NG][2][4], LAS unsigned char* scr, int wr, int wc, int fr, int fq) {
    LAS float* red = (LAS float*)scr;
    if (fq == 0) {
#pragma unroll
        for (int gq = 0; gq < NG; ++gq)
#pragma unroll
            for (int ai = 0; ai < 2; ++ai)
#pragma unroll
                for (int m = 0; m < 4; ++m) red[gq * 1024 + (ai * HALF + wr * 64 + m * 16 + fr) * 4 + wc] = p[gq][ai][m];
    }
    WG_BAR();
#pragma unroll
    for (int gq = 0; gq < NG; ++gq)
#pragma unroll
        for (int ai = 0; ai < 2; ++ai)
#pragma unroll
            for (int m = 0; m < 4; ++m) { const f32x4 v = *(const LAS f32x4*)(red + gq * 1024 + (ai * HALF + wr * 64 + m * 16 + fr) * 4); p[gq][ai][m] = (v[0] + v[1]) + (v[2] + v[3]); }
    WG_BAR();
}
__device__ __forceinline__ float sq4(f32x4 v) { return (v[0] * v[0] + v[1] * v[1]) + (v[2] * v[2] + v[3] * v[3]); }
__device__ __forceinline__ float fq_sum(float s) { s += __shfl_xor(s, 16); s += __shfl_xor(s, 32); return s; }

struct EpiBf16 {
    EPI_INIT_ZERO
    bf16_t* O; int ldc; int wt;
    __device__ __forceinline__ void operator()(Acc& acc, const Unit& u, int wr, int wc, int fr, int fq, LAS unsigned char*) const {
        const int row0 = u.row0 + wr * 64 + fr, col0 = u.pn * BM + wc * 32 + 8 * fq;
        if (wt) { const rsrc_t rO = make_rsrc(O, (unsigned)MT * DM * 2);
#pragma unroll
            for (int ai = 0; ai < 2; ++ai) if (ai == 0 || !u.half)
#pragma unroll
                for (int m = 0; m < 4; ++m) { const unsigned off = (unsigned)((row0 + ai * HALF + m * 16) * ldc + col0) * 2u;
#pragma unroll
                    for (int bj = 0; bj < 2; ++bj) st16_wt(rO, off + bj * HALF * 2, pack8(acc[ai][bj][m][0], acc[ai][bj][m][1])); }
            return; }
#pragma unroll
        for (int ai = 0; ai < 2; ++ai) if (ai == 0 || !u.half)
#pragma unroll
            for (int m = 0; m < 4; ++m) { bf16_t* rp = O + (size_t)(row0 + ai * HALF + m * 16) * ldc + col0;
#pragma unroll
                for (int bj = 0; bj < 2; ++bj) *(u32x4*)(rp + bj * HALF) = pack8(acc[ai][bj][m][0], acc[ai][bj][m][1]); }
    }
};

struct EpiInProj {
    EPI_INIT_ZERO
    unsigned char* ws; float* out;
    __device__ __forceinline__ void operator()(Acc& acc, const Unit& u, int wr, int wc, int fr, int fq, LAS unsigned char* scr) const {
        const float* kvg = arg_in(11); const float* krg = arg_in(16);
        bf16_t* UBF = (bf16_t*)(ws + WS_UBF); bf16_t* SGP = (bf16_t*)(ws + WS_SGP); bf16_t* CQ = (bf16_t*)(ws + WS_CQ); bf16_t* CKVN = (bf16_t*)(ws + WS_CKVN); bf16_t* SGM = (bf16_t*)(ws + WS_SGM); bf16_t* KRN = (bf16_t*)(ws + WS_KRN);
        float* SSQCQ = (float*)(ws + WS_SSQCQ); const float* COS = (const float*)(ws + WS_COS); const float* SIN = (const float*)(ws + WS_SIN);
        const int row0 = u.row0 + wr * 64 + fr, cl = wc * 32 + 8 * fq, pn = u.pn;
        if (pn < 4) {
            const bool tail = (((u.row0 >> 8) & 7) == 7) || (u.row0 >= MP);
#pragma unroll
            for (int ai = 0; ai < 2; ++ai) if (ai == 0 || !u.half)
#pragma unroll
                for (int m = 0; m < 4; ++m) { const int row = row0 + ai * HALF + m * 16; bf16_t* rp = UBF + (size_t)row * DPOOL + pn * BM + cl;
#pragma unroll
                    for (int bj = 0; bj < 2; ++bj) *(u32x4*)(rp + bj * HALF) = pack8(acc[ai][bj][m][0], acc[ai][bj][m][1]);
                    if (tail) { float* dst = nullptr;
                        if (row < MP) { const int t = row & (SEQ - 1), b = row >> 11; if (t >= SEQ - POOLH) dst = out + O_POOLP + (size_t)(b * POOLH + t - (SEQ - POOLH)) * DPOOL; }
                        else { const int s = row - MP, b = s >> 4, t = s & 15; if (t >= 1) dst = out + O_POOLS + (size_t)(b * POOLH + t - 1) * DPOOL; }
                        if (dst) { dst += pn * BM + cl;
#pragma unroll
                            for (int bj = 0; bj < 2; ++bj) { *(f32x4*)(dst + bj * HALF) = acc[ai][bj][m][0]; *(f32x4*)(dst + bj * HALF + 4) = acc[ai][bj][m][1]; } } } }
        } else if (pn < 8 || (pn >= 11 && pn < 15)) {
            bf16_t* G0 = pn < 8 ? SGP + (pn - 4) * BM : SGM + (pn - 11) * BM;
#pragma unroll
            for (int ai = 0; ai < 2; ++ai) if (ai == 0 || !u.half)
#pragma unroll
                for (int m = 0; m < 4; ++m) { bf16_t* rp = G0 + (size_t)(row0 + ai * HALF + m * 16) * 1024 + cl;
#pragma unroll
                    for (int bj = 0; bj < 2; ++bj) { f32x4 a = acc[ai][bj][m][0], b = acc[ai][bj][m][1];
#pragma unroll
                        for (int j = 0; j < 4; ++j) { a[j] = silu_f(a[j]); b[j] = silu_f(b[j]); }
                        *(u32x4*)(rp + bj * HALF) = pack8(a, b); } }
        } else if (pn < 10) {
#pragma unroll
            for (int ai = 0; ai < 2; ++ai) if (ai == 0 || !u.half)
#pragma unroll
                for (int m = 0; m < 4; ++m) { const int row = row0 + ai * HALF + m * 16; bf16_t* rp = CQ + (size_t)row * QRANK + (pn - 8) * BM + cl; float s = 0.f;
#pragma unroll
                    for (int bj = 0; bj < 2; ++bj) { *(u32x4*)(rp + bj * HALF) = pack8(acc[ai][bj][m][0], acc[ai][bj][m][1]); s += sq4(acc[ai][bj][m][0]) + sq4(acc[ai][bj][m][1]); }
                    s = fq_sum(s);
                    if (fq == 0) SSQCQ[(size_t)row * 8 + (pn - 8) * 4 + wc] = s; }
        } else if (pn == 10) {
            float p[1][2][4];
#pragma unroll
            for (int ai = 0; ai < 2; ++ai) if (ai == 0 || !u.half)
#pragma unroll
                for (int m = 0; m < 4; ++m) { float s = 0.f;
#pragma unroll
                    for (int bj = 0; bj < 2; ++bj) s += sq4(acc[ai][bj][m][0]) + sq4(acc[ai][bj][m][1]);
                    p[0][ai][m] = fq_sum(s); }
            xwave_rowsum<1>(p, scr, wr, wc, fr, fq);
            f32x4 gv[2][2];
#pragma unroll
            for (int bj = 0; bj < 2; ++bj) { gv[bj][0] = *(const f32x4*)(kvg + bj * HALF + cl); gv[bj][1] = *(const f32x4*)(kvg + bj * HALF + cl + 4); }
#pragma unroll
            for (int ai = 0; ai < 2; ++ai) if (ai == 0 || !u.half)
#pragma unroll
                for (int m = 0; m < 4; ++m) { const int row = row0 + ai * HALF + m * 16; const float r = 1.0f / sqrtf(p[0][ai][m] * (1.f / KVRANK) + EPS);
                    float* dst = (row < MP ? out + O_CKVP + (size_t)row * KVRANK : out + O_CKVS + (size_t)(row - MP) * KVRANK) + cl; bf16_t* rp = CKVN + (size_t)row * KVRANK + cl;
#pragma unroll
                    for (int bj = 0; bj < 2; ++bj) { const f32x4 a = acc[ai][bj][m][0] * r * gv[bj][0], b = acc[ai][bj][m][1] * r * gv[bj][1];
                        *(f32x4*)(dst + bj * HALF) = a; *(f32x4*)(dst + bj * HALF + 4) = b; *(u32x4*)(rp + bj * HALF) = pack8(a, b); } }
        } else {
            if (wc == 0) {
                f32x4 g1[2], g2[2];
#pragma unroll
                for (int n = 0; n < 2; ++n) { g1[n] = *(const f32x4*)(krg + 8 * fq + 4 * n); g2[n] = *(const f32x4*)(krg + 32 + 8 * fq + 4 * n); }
#pragma unroll
                for (int ai = 0; ai < 2; ++ai) if (ai == 0 || !u.half)
#pragma unroll
                    for (int m = 0; m < 4; ++m) { const int row = row0 + ai * HALF + m * 16; float s = 0.f;
#pragma unroll
                        for (int n = 0; n < 2; ++n) s += sq4(acc[ai][0][m][n]) + sq4(acc[ai][1][m][n]);
                        s = fq_sum(s); const float r = 1.0f / sqrtf(s * (1.f / DROPE) + EPS); const int pos = row_pos(row);
                        float* dst = (row < MP ? out + O_KRP + (size_t)row * DROPE : out + O_KRS + (size_t)(row - MP) * DROPE) + 8 * fq; bf16_t* rp = KRN + (size_t)row * DROPE + 8 * fq;
                        f32x4 o1[2], o2[2];
#pragma unroll
                        for (int n = 0; n < 2; ++n) { const f32x4 cs = *(const f32x4*)(COS + pos * 32 + 8 * fq + 4 * n), sn = *(const f32x4*)(SIN + pos * 32 + 8 * fq + 4 * n);
                            const f32x4 y1 = acc[ai][0][m][n] * r * g1[n], y2 = acc[ai][1][m][n] * r * g2[n]; o1[n] = y1 * cs - y2 * sn; o2[n] = y2 * cs + y1 * sn; }
                        *(f32x4*)(dst) = o1[0]; *(f32x4*)(dst + 4) = o1[1]; *(f32x4*)(dst + 32) = o2[0]; *(f32x4*)(dst + 36) = o2[1];
                        *(u32x4*)(rp) = pack8(o1[0], o1[1]); *(u32x4*)(rp + 32) = pack8(o2[0], o2[1]); }
            }
        }
    }
};

struct EpiQ {
    EPI_INIT_ZERO
    unsigned char* ws; const float* gqn; const float* gkn; const float* gqr;
    __device__ __forceinline__ void operator()(Acc& acc, const Unit& u, int wr, int wc, int fr, int fq, LAS unsigned char* scr) const {
        bf16_t* QCAT = (bf16_t*)(ws + WS_QCAT); const float* SSQCQ = (const float*)(ws + WS_SSQCQ); const float* COS = (const float*)(ws + WS_COS); const float* SIN = (const float*)(ws + WS_SIN);
        const int row0 = u.row0 + wr * 64 + fr, pn = u.pn;
#pragma unroll
        for (int ai = 0; ai < 2; ++ai) if (ai == 0 || !u.half)
#pragma unroll
            for (int m = 0; m < 4; ++m) { const int row = row0 + ai * HALF + m * 16; const f32x4 a = *(const f32x4*)(SSQCQ + (size_t)row * 8), b = *(const f32x4*)(SSQCQ + (size_t)row * 8 + 4);
                const float rq = 1.0f / sqrtf((((a[0] + a[1]) + (a[2] + a[3])) + ((b[0] + b[1]) + (b[2] + b[3]))) * (1.f / QRANK) + EPS);
#pragma unroll
                for (int bj = 0; bj < 2; ++bj)
#pragma unroll
                    for (int n = 0; n < 2; ++n) acc[ai][bj][m][n] *= rq;
                if (m & 1) asm volatile("" ::: "memory"); }
        if (pn < 4) {
            float p[2][2][4];
#pragma unroll
            for (int bj = 0; bj < 2; ++bj)
#pragma unroll
                for (int ai = 0; ai < 2; ++ai) if (ai == 0 || !u.half)
#pragma unroll
                    for (int m = 0; m < 4; ++m) p[bj][ai][m] = fq_sum(sq4(acc[ai][bj][m][0]) + sq4(acc[ai][bj][m][1]));
            xwave_rowsum<2>(p, scr, wr, wc, fr, fq);
            const int d0 = wc * 32 + 8 * fq; f32x4 gg[2];
#pragma unroll
            for (int n = 0; n < 2; ++n) gg[n] = *(const f32x4*)(gqn + d0 + 4 * n) * *(const f32x4*)(gkn + d0 + 4 * n) * C2;
#pragma unroll
            for (int ai = 0; ai < 2; ++ai) if (ai == 0 || !u.half)
#pragma unroll
                for (int m = 0; m < 4; ++m) { const int row = row0 + ai * HALF + m * 16;
#pragma unroll
                    for (int bj = 0; bj < 2; ++bj) { const float rn = 1.0f / sqrtf(p[bj][ai][m] * (1.f / DNOPE) + EPS);
                        *(u32x4*)(QCAT + (size_t)row * (NHEAD * DQK) + (2 * pn + bj) * DQK + d0) = pack8(acc[ai][bj][m][0] * rn * gg[0], acc[ai][bj][m][1] * rn * gg[1]); } }
        } else {
            const int hd = 4 * (pn - 4) + wc; f32x4 g1[2], g2[2];
#pragma unroll
            for (int n = 0; n < 2; ++n) { g1[n] = *(const f32x4*)(gqr + 8 * fq + 4 * n) * C2; g2[n] = *(const f32x4*)(gqr + 32 + 8 * fq + 4 * n) * C2; }
#pragma unroll
            for (int ai = 0; ai < 2; ++ai) if (ai == 0 || !u.half)
#pragma unroll
                for (int m = 0; m < 4; ++m) { const int row = row0 + ai * HALF + m * 16; float s = 0.f;
#pragma unroll
                    for (int n = 0; n < 2; ++n) s += sq4(acc[ai][0][m][n]) + sq4(acc[ai][1][m][n]);
                    s = fq_sum(s); const float r = 1.0f / sqrtf(s * (1.f / DROPE) + EPS); const int pos = row_pos(row);
                    f32x4 o1[2], o2[2];
#pragma unroll
                    for (int n = 0; n < 2; ++n) { const f32x4 cs = *(const f32x4*)(COS + pos * 32 + 8 * fq + 4 * n), sn = *(const f32x4*)(SIN + pos * 32 + 8 * fq + 4 * n);
                        const f32x4 y1 = acc[ai][0][m][n] * r * g1[n], y2 = acc[ai][1][m][n] * r * g2[n]; o1[n] = y1 * cs - y2 * sn; o2[n] = y2 * cs + y1 * sn; }
                    bf16_t* rp = QCAT + (size_t)row * (NHEAD * DQK) + hd * DQK + DNOPE + 8 * fq;
                    *(u32x4*)(rp) = pack8(o1[0], o1[1]); *(u32x4*)(rp + 32) = pack8(o2[0], o2[1]); }
        }
    }
};

struct EpiKV {
    EPI_INIT_ZERO
    unsigned char* ws;
    __device__ __forceinline__ void operator()(Acc& acc, const Unit& u, int wr, int wc, int fr, int fq, LAS unsigned char* scr) const {
        bf16_t* KCAT = (bf16_t*)(ws + WS_KCAT); bf16_t* V = (bf16_t*)(ws + WS_V);
        const int row0 = u.row0 + wr * 64 + fr, d0 = wc * 32 + 8 * fq, hd = u.pn;
        float p[1][2][4];
#pragma unroll
        for (int ai = 0; ai < 2; ++ai) if (ai == 0 || !u.half)
#pragma unroll
            for (int m = 0; m < 4; ++m) p[0][ai][m] = fq_sum(sq4(acc[ai][0][m][0]) + sq4(acc[ai][0][m][1]));
        xwave_rowsum<1>(p, scr, wr, wc, fr, fq);
#pragma unroll
        for (int ai = 0; ai < 2; ++ai) if (ai == 0 || !u.half)
#pragma unroll
            for (int m = 0; m < 4; ++m) { const int row = row0 + ai * HALF + m * 16; const float rk = 1.0f / sqrtf(p[0][ai][m] * (1.f / DNOPE) + EPS);
                *(u32x4*)(KCAT + (size_t)row * (NHEAD * DNOPE) + hd * DNOPE + d0) = pack8(acc[ai][0][m][0] * rk, acc[ai][0][m][1] * rk);
                *(u32x4*)(V + (size_t)row * (NHEAD * DV) + hd * DV + d0) = pack8(acc[ai][1][m][0], acc[ai][1][m][1]); }
    }
};

struct EpiOut {
    const float* xp; const float* xs; float* Y; unsigned char* ws;
    __device__ __forceinline__ void init(Acc& acc, const Unit& u, int wr, int wc, int fr, int fq) const {
        const int row0 = u.row0 + wr * 64 + fr, col0 = u.pn * BM + wc * 32 + 8 * fq;
#pragma unroll
        for (int ai = 0; ai < 2; ++ai)
#pragma unroll
            for (int m = 0; m < 4; ++m) { const int row = row0 + ai * HALF + m * 16; const float* xr = (row < MP ? xp + (size_t)row * DM : xs + (size_t)(row - MP) * DM) + col0;
#pragma unroll
                for (int bj = 0; bj < 2; ++bj) { if (ai == 0 || !u.half) { acc[ai][bj][m][0] = *(const f32x4*)(xr + bj * HALF); acc[ai][bj][m][1] = *(const f32x4*)(xr + bj * HALF + 4); }
                                                 else { acc[ai][bj][m][0] = (f32x4){0.f, 0.f, 0.f, 0.f}; acc[ai][bj][m][1] = (f32x4){0.f, 0.f, 0.f, 0.f}; } } }
    }
    __device__ __forceinline__ void operator()(Acc& acc, const Unit& u, int wr, int wc, int fr, int fq, LAS unsigned char* scr) const {
        float* SSQH = (float*)(ws + WS_SSQH); const rsrc_t rH = make_rsrc(ws + WS_HBF, (unsigned)MT * DM * 2);
        const int row0 = u.row0 + wr * 64 + fr, col0 = u.pn * BM + wc * 32 + 8 * fq;
        float p[1][2][4];
#pragma unroll
        for (int ai = 0; ai < 2; ++ai) if (ai == 0 || !u.half)
#pragma unroll
            for (int m = 0; m < 4; ++m) { const int row = row0 + ai * HALF + m * 16; float s = 0.f;
#pragma unroll
                for (int bj = 0; bj < 2; ++bj) { const f32x4 a = acc[ai][bj][m][0], b = acc[ai][bj][m][1];
                    const unsigned eo = (unsigned)(row * DM + col0 + bj * HALF);
                    st16_wt(rH, eo * 2u, pack8(a, b)); s += sq4(a) + sq4(b); }
                p[0][ai][m] = fq_sum(s); }
        xwave_rowsum<1>(p, scr, wr, wc, fr, fq);
        if (wc == 0 && fq == 0) {
#pragma unroll
            for (int ai = 0; ai < 2; ++ai) if (ai == 0 || !u.half)
#pragma unroll
                for (int m = 0; m < 4; ++m) __hip_atomic_store(SSQH + (size_t)(row0 + ai * HALF + m * 16) * 8 + u.pn, p[0][ai][m], __ATOMIC_RELAXED, __HIP_MEMORY_SCOPE_AGENT);
        }
    }
};

struct EpiGate {
    EPI_INIT_ZERO
    float* Y; unsigned char* ws; const float* bias;
    __device__ __forceinline__ void operator()(Acc& acc, const Unit& u, int wr, int wc, int fr, int fq, LAS unsigned char*) const {
        const bf16_t* PV = (const bf16_t*)(ws + WS_PV); const bf16_t* HB = (const bf16_t*)(ws + WS_HBF); const float* SSQH = (const float*)(ws + WS_SSQH);
        const int row0 = u.row0 + wr * 64 + fr, col0 = u.pn * BM + wc * 32 + 8 * fq;
        f32x4 bv[2][2];
#pragma unroll
        for (int bj = 0; bj < 2; ++bj) { bv[bj][0] = *(const f32x4*)(bias + col0 + bj * HALF); bv[bj][1] = *(const f32x4*)(bias + col0 + bj * HALF + 4); }
#pragma unroll
        for (int ai = 0; ai < 2; ++ai) if (ai == 0 || !u.half)
#pragma unroll
            for (int m = 0; m < 4; ++m) { const int row = row0 + ai * HALF + m * 16; const f32x4 sa = *(const f32x4*)(SSQH + (size_t)row * 8), sb = *(const f32x4*)(SSQH + (size_t)row * 8 + 4);
                const float rh = 1.0f / sqrtf((((sa[0] + sa[1]) + (sa[2] + sa[3])) + ((sb[0] + sb[1]) + (sb[2] + sb[3]))) * (1.f / DM) + EPS);
#pragma unroll
                for (int bj = 0; bj < 2; ++bj) { float* yp = Y + (size_t)row * DM + col0 + bj * HALF; const u32x4 pw = *(const u32x4*)(PV + (size_t)row * DM + col0 + bj * HALF);
                    const u32x4 hw = *(const u32x4*)(HB + (size_t)row * DM + col0 + bj * HALF);
                    f32x4 h0 = {__uint_as_float(hw.x << 16), __uint_as_float(hw.x & 0xffff0000u), __uint_as_float(hw.y << 16), __uint_as_float(hw.y & 0xffff0000u)};
                    f32x4 h1 = {__uint_as_float(hw.z << 16), __uint_as_float(hw.z & 0xffff0000u), __uint_as_float(hw.w << 16), __uint_as_float(hw.w & 0xffff0000u)}; const f32x4 g0 = acc[ai][bj][m][0] * rh + bv[bj][0], g1 = acc[ai][bj][m][1] * rh + bv[bj][1];
                    h0[0] += sigmoid_f(g0[0]) * __uint_as_float(pw.x << 16); h0[1] += sigmoid_f(g0[1]) * __uint_as_float(pw.x & 0xffff0000u);
                    h0[2] += sigmoid_f(g0[2]) * __uint_as_float(pw.y << 16); h0[3] += sigmoid_f(g0[3]) * __uint_as_float(pw.y & 0xffff0000u);
                    h1[0] += sigmoid_f(g1[0]) * __uint_as_float(pw.z << 16); h1[1] += sigmoid_f(g1[1]) * __uint_as_float(pw.z & 0xffff0000u);
                    h1[2] += sigmoid_f(g1[2]) * __uint_as_float(pw.w << 16); h1[3] += sigmoid_f(g1[3]) * __uint_as_float(pw.w & 0xffff0000u);
                    *(f32x4*)yp = h0; *(f32x4*)(yp + 4) = h1; }
                if (m & 1) asm volatile("" ::: "memory"); }
    }
};

struct SchedP1 { const char* ws; int c, G;
    static constexpr bool SPLITK = false;
    __device__ __forceinline__ float* slab(const Unit&) const { return nullptr; }
    __device__ __forceinline__ unsigned* ticket(const Unit&) const { return nullptr; }
    __device__ __forceinline__ void a_ready(const Unit&, int) const {}
    __device__ __forceinline__ void done(const Unit&, int) const {}
    __device__ __forceinline__ bool get(int i, Unit& u) const {
        constexpr int NF = 32 * 16, NH = 4 * 16; int nf = (NF - c + G - 1) / G; nf = nf < 0 ? 0 : nf;
        u.lda = DM; u.ldb = DM; u.nt = DM / BK; u.type = 0; u.slice = -1; u.uid = 0;
        if (i < nf) { int pm, pn; grid_map(c + i * G, 32, 16, pm, pn); u.row0 = pm * BM; u.pn = pn; u.half = 0; }
        else { const int t = c + (i - nf) * G; if (t >= NH) return false; u.row0 = MP + (t >> 4) * HALF; u.pn = t & 15; u.half = 1; }
        u.A = ws + WS_XN + (size_t)u.row0 * DM * 2; u.B = ws + WS_WIN + (size_t)u.pn * BM * DM * 2; return true; }
};
struct SchedP2 { const char* ws; int c, G;
    static constexpr bool SPLITK = false;
    __device__ __forceinline__ float* slab(const Unit&) const { return nullptr; }
    __device__ __forceinline__ unsigned* ticket(const Unit&) const { return nullptr; }
    __device__ __forceinline__ void a_ready(const Unit&, int) const {}
    __device__ __forceinline__ void done(const Unit&, int) const {}
    __device__ __forceinline__ bool get(int i, Unit& u) const {
        int L = c + i * G, pm, pn; u.half = 0; u.slice = -1; u.uid = 0;
        if (L < 204) { grid_map(L, 34, 6, pm, pn); u.type = 0; u.lda = QRANK; u.ldb = QRANK; u.nt = QRANK / BK; u.row0 = pm * BM; u.pn = pn;
            u.A = ws + WS_CQ + (size_t)u.row0 * QRANK * 2; u.B = ws + WS_WUQ + (size_t)pn * BM * QRANK * 2; return true; }
        L -= 204;
        if (L < 256) { grid_map(L, 32, 8, pm, pn); u.type = 1; u.lda = KVRANK; u.ldb = KVRANK; u.nt = KVRANK / BK; u.row0 = pm * BM; u.pn = pn;
            u.A = ws + WS_CKVN + (size_t)u.row0 * KVRANK * 2; u.B = ws + WS_WUKV + (size_t)pn * BM * KVRANK * 2; return true; }
        L -= 256;
        if (L < 144) { grid_map(L, 36, 4, pm, pn); u.type = 2; u.lda = DPOOL; u.ldb = 256; u.nt = 4; u.row0 = pm * BM; u.pn = pn;
            u.A = ws + WS_UBF + ((size_t)u.row0 * DPOOL + pn * 256) * 2; u.B = ws + WS_WPOOL + (size_t)pn * BM * 256 * 2; return true; }
        return false; }
};
struct EpiP2 { unsigned char* ws;
    EPI_INIT_ZERO
    __device__ __forceinline__ void operator()(Acc& acc, const Unit& u, int wr, int wc, int fr, int fq, LAS unsigned char* scr) const {
        if (u.type == 0) { const EpiQ q{ws, arg_in(13), arg_in(15), arg_in(14)}; q(acc, u, wr, wc, fr, fq, scr); }
        else if (u.type == 1) { const EpiKV kv{ws}; kv(acc, u, wr, wc, fr, fq, scr); }
        else { const EpiBf16 z{(bf16_t*)(ws + WS_Z), DPOOL, 0}; z(acc, u, wr, wc, fr, fq, scr); } }
};

struct SchedP45 { const char* ws; unsigned* cnt; int c, G, stream;
    static constexpr bool SPLITK = true;
    __device__ __forceinline__ bool warm(const Unit&) const { return false; }
    __device__ __forceinline__ int panel_of(const Unit& u) const { return u.row0 < MP ? (u.row0 >> 8) : 32 + ((u.row0 - MP) >> 7); }
    __device__ __forceinline__ float* slab(const Unit& u) const { return (float*)(ws + (u.type == 0 ? WS_SGM : WS_V)) + (size_t)u.uid * (4 * HALF * BM); }
    __device__ __forceinline__ unsigned* ticket(const Unit& u) const { return cnt + 64 * ((u.type == 0 ? 38 : 70) + u.uid); }
    __device__ __forceinline__ bool get(int i, Unit& u) const {
        constexpr int NF = 32 * 8, NS = 32 * 4, NH = 32; int pm = 0, pn = 0, type, row0, half = 0, slice = -1, uid = 0; bool ok = true;
        int nf = (NF - c + G - 1) / G; nf = nf < 0 ? 0 : nf; int ns = (NS - c + G - 1) / G; ns = ns < 0 ? 0 : ns;
        const int c2 = (c + G - (128 % G)) % G; int ns2 = (NS - c2 + G - 1) / G; ns2 = ns2 < 0 ? 0 : ns2;
        if (stream == 1) {
            if (i < 2 * nf) { grid_map(c + (i >> 1) * G, 32, 8, pm, pn); type = (i & 1) ? 1 : 0; row0 = pm * BM; }
            else if (i - 2 * nf < ns) { const int j = c + (i - 2 * nf) * G; type = 0; uid = j >> 2; slice = j & 3; row0 = MP + (uid >> 3) * HALF; pn = uid & 7; half = 1; }
            else { const int t = c2 + (i - 2 * nf - ns) * G; ok = t < NH; type = 1; row0 = MP + ((t >> 3) & 3) * HALF; pn = t & 7; half = 1; }
        } else {
            type = 2;
            if (i < nf) { grid_map(c + i * G, 32, 8, pm, pn); row0 = pm * BM; }
            else { const int j = c2 + (i - nf) * G; ok = j < NS; uid = (j >> 2) & 31; slice = j & 3; row0 = MP + (uid >> 3) * HALF; pn = uid & 7; half = 1; }
        }
        const bool ple = type == 1; const int ld = ple ? DPLE : DM; const int nt = slice >= 0 ? 8 : ld / BK; const size_t koff = slice >= 0 ? (size_t)slice * 8 * BK * 2 : 0;
        u.type = type; u.row0 = row0; u.pn = pn; u.half = half; u.slice = slice; u.uid = uid; u.lda = ld; u.ldb = ld; u.nt = nt;
        u.A = ws + (ple ? WS_PBF : (type == 0 ? WS_MIX : WS_HBF)) + (size_t)row0 * ld * 2 + koff;
        u.B = ws + (ple ? WS_WPLE : (type == 0 ? WS_WOUT : WS_WGATE)) + (size_t)pn * BM * ld * 2 + koff;
        return ok; }
    __device__ __forceinline__ void a_ready(const Unit& u, int wid) const {
        if (u.type != 2) return;
        if (wid == 0) {
            unsigned* p1 = cnt + 64 * panel_of(u); unsigned* p2 = cnt + 64 * 37; const unsigned need2 = u.half ? 32u : 0u; unsigned sp = 0;
            while ((unsigned)__builtin_amdgcn_readfirstlane(__hip_atomic_load(p1, __ATOMIC_RELAXED, __HIP_MEMORY_SCOPE_AGENT)) < 8u ||
                   (unsigned)__builtin_amdgcn_readfirstlane(__hip_atomic_load(p2, __ATOMIC_RELAXED, __HIP_MEMORY_SCOPE_AGENT)) < need2) { __builtin_amdgcn_s_sleep(2); if (++sp > (1u << 24)) break; }
            __builtin_amdgcn_fence(__ATOMIC_ACQUIRE, "agent");
            asm volatile("s_waitcnt vmcnt(0)" ::: "memory");
        }
        asm volatile("" ::: "memory"); __builtin_amdgcn_s_barrier(); asm volatile("" ::: "memory");
    }
    __device__ __forceinline__ void done(const Unit& u, int wid) const {
        if (u.type == 2 || (u.type == 1 && !u.half)) return;
        asm volatile("s_waitcnt vmcnt(0)" ::: "memory");
        __builtin_amdgcn_s_barrier(); asm volatile("" ::: "memory");
        if (wid == 0 && lane_id() == 0) __hip_atomic_fetch_add(cnt + 64 * (u.type == 1 ? 37 : panel_of(u)), 1u, __ATOMIC_RELAXED, __HIP_MEMORY_SCOPE_AGENT);
    }
};
struct EpiP45 { unsigned char* ws; float* out;
    __device__ __forceinline__ void init(Acc& acc, const Unit& u, int wr, int wc, int fr, int fq) const {
        if (u.type == 0 && u.slice <= 0) { const EpiOut o{arg_in(0), arg_in(1), out + O_Y, ws}; o.init(acc, u, wr, wc, fr, fq); } else acc_zero(acc); }
    __device__ __forceinline__ void operator()(Acc& acc, const Unit& u, int wr, int wc, int fr, int fq, LAS unsigned char* scr) const {
        if (u.type == 0) { const EpiOut o{nullptr, nullptr, out + O_Y, ws}; o(acc, u, wr, wc, fr, fq, scr); }
        else if (u.type == 1) { const EpiBf16 e{(bf16_t*)(ws + WS_PV), DM, u.half}; e(acc, u, wr, wc, fr, fq, scr); }
        else { const EpiGate g{out + O_Y, ws, arg_in(22)}; g(acc, u, wr, wc, fr, fq, scr); } }
};
}

struct Args { const float* in[24]; float* out; unsigned char* ws; int ph_lo, ph_hi, li, pad; };
enum { I_XP = 0, I_XS, I_CCKV, I_CKR, I_SPOOL, I_PP, I_PS, I_NORMG, I_WIN, I_QNG, I_WUQ, I_KVNG, I_WUKV, I_QNOPEG, I_QROPEG, I_KNOPEG, I_KROPEG, I_WPOOL, I_PSCALE, I_WOUT, I_PLENG, I_WGATE, I_BGATE, I_WPLE };


__device__ __forceinline__ void cache_item(const float* W, bf16_t* CB, bf16_t* CT, int k0, int n0, LAS float* scr, int lane, bool doB, bool doT) {
    float tv[32];
#pragma unroll
    for (int i = 0; i < 32; ++i) tv[i] = W[(size_t)(k0 + 2 * i + (lane >> 5)) * KVRANK + n0 + (lane & 31)];
#pragma unroll
    for (int i = 0; i < 32; ++i) scr[(2 * i + (lane >> 5)) * 33 + (lane & 31)] = tv[i];
    LDS_WAIT(); asm volatile("" ::: "memory");
    const int kb0 = k0 >> 5, s0 = n0 >> 4;
#pragma unroll
    for (int c = 0; c < 4; ++c) { const int kbl = c >> 1, sl = c & 1;
        if (doB) { const LAS float* p = scr + (kbl * 32 + (lane & 31)) * 33 + sl * 16 + 8 * (lane >> 5);
          u32x4 o; o.x = cvtpk(p[0], p[1]); o.y = cvtpk(p[2], p[3]); o.z = cvtpk(p[4], p[5]); o.w = cvtpk(p[6], p[7]);
          *(u32x4*)(CB + ((size_t)((kb0 + kbl) * 16 + s0 + sl) * 64 + lane) * 8) = o; }
        if (doT) { const LAS float* p = scr + (kbl * 32 + 8 * (lane >> 4)) * 33 + sl * 16 + (lane & 15);
          u32x4 o; o.x = cvtpk(p[0 * 33], p[1 * 33]); o.y = cvtpk(p[2 * 33], p[3 * 33]); o.z = cvtpk(p[4 * 33], p[5 * 33]); o.w = cvtpk(p[6 * 33], p[7 * 33]);
          *(u32x4*)(CT + ((size_t)((kb0 + kbl) * 16 + s0 + sl) * 64 + lane) * 8) = o; } }
    LDS_WAIT(); asm volatile("" ::: "memory");
}
__device__ __forceinline__ bf16_t* ckvt_base(unsigned char* ws, int b) { return (bf16_t*)(ws + (b < NBT_A ? WS_CKVT_A + (size_t)b * CKVT_B : WS_CKVT_B + (size_t)(b - NBT_A) * CKVT_B)); }

__device__ __forceinline__ void transpose_item(const float* W, int N, bf16_t* WT, int ldt, int k0, int n0, int drow0, const float* kgain, LAS float* scr, int lane) {
    float tv[32];
#pragma unroll
    for (int i = 0; i < 32; ++i) tv[i] = W[(size_t)(k0 + 2 * i + (lane >> 5)) * N + n0 + (lane & 31)];
    if (kgain) {
#pragma unroll
        for (int i = 0; i < 32; ++i) tv[i] *= kgain[k0 + 2 * i + (lane >> 5)]; }
#pragma unroll
    for (int i = 0; i < 32; ++i) scr[(2 * i + (lane >> 5)) * 33 + (lane & 31)] = tv[i];
    LDS_WAIT(); asm volatile("" ::: "memory");
    const int c = lane & 7;
#pragma unroll
    for (int j = 0; j < 4; ++j) { const int n = (lane >> 3) + 8 * j; const LAS float* s = scr + (8 * c) * 33 + n;
        u32x4 o; o.x = cvtpk(s[0 * 33], s[1 * 33]); o.y = cvtpk(s[2 * 33], s[3 * 33]); o.z = cvtpk(s[4 * 33], s[5 * 33]); o.w = cvtpk(s[6 * 33], s[7 * 33]);
        *(u32x4*)(WT + (size_t)(drow0 + n) * ldt + k0 + 8 * c) = o; }
    LDS_WAIT(); asm volatile("" ::: "memory");
}

__device__ __forceinline__ void p0_prologue(const Args& a, LAS unsigned char* lds, int vcu, int G, int wv, int part) {
    const int lane = lane_id(), wave = wv, tid = (wv << 6) | lane;
    LAS float* scr = (LAS float*)(lds + wave * 16384);
    const int gw = vcu * 8 + wave, NGW = G * 8;
    unsigned char* ws = a.ws;
    bf16_t* Win_t = (bf16_t*)(ws + WS_WIN);
    const int gt = vcu * 512 + tid, NGT = G * 512;
    if (part == 0) {
        constexpr int I_IN = 32 * 122;
        { const float* W = AIN(I_WIN);
          for (int r = gw; r < I_IN; r += NGW) { const int kb = r / 122, nb = r % 122, n0 = 32 * nb; const int d = n0 < 2816 ? n0 : (n0 == 2816 ? 3840 : (n0 == 2848 ? 3968 : n0 - 64));
              transpose_item(W, DIN, Win_t, DM, 64 * kb, n0, d, nullptr, scr, lane); } }
        {
            bf16_t* XN = (bf16_t*)(ws + WS_XN); const float* gp = AIN(I_NORMG); const float* xp = AIN(I_XP); const float* xs = AIN(I_XS);
            for (int m = gw; m < MT; m += NGW) {
                const float* xr = (m < MP ? xp + (size_t)m * DM : xs + (size_t)(m - MP) * DM) + 4 * lane;
                f32x4 v[8]; float sm = 0.f;
#pragma unroll
                for (int j = 0; j < 8; ++j) { v[j] = *(const f32x4*)(xr + 256 * j); sm += pg8::sq4(v[j]); }
                const float r = 1.0f / sqrtf(wave_sum(sm) * (1.f / DM) + EPS);
#pragma unroll
                for (int j = 0; j < 8; ++j) { const f32x4 gv = *(const f32x4*)(gp + 4 * lane + 256 * j); const f32x4 o = v[j] * r * gv;
                    u32x2 w; w.x = cvtpk(o[0], o[1]); w.y = cvtpk(o[2], o[3]); *(u32x2*)(XN + (size_t)m * DM + 4 * lane + 256 * j) = w; }
            }
        }
        {
            float* COS = (float*)(ws + WS_COS); float* SIN = (float*)(ws + WS_SIN);
            for (int i = tid * G + vcu; i < SKV_S * 32; i += 512 * G) { const int pos = i >> 5, fi = i & 31; const float inv = (float)exp(-(double)fi * (1.0 / 32.0) * 9.210340371976184); const float ang = (float)pos * inv;
                float sv, cv; sincosf(ang, &sv, &cv); COS[i] = cv; SIN[i] = sv; }
        }
        {
            for (int i = gt; i < 192 * (DM / 8); i += NGT) { const int rr = i >> 8, c = (i & 255) * 8; const int row = 3840 + (rr < 96 ? 32 + rr : 160 + (rr - 96));
                *(u32x4*)(Win_t + (size_t)row * DM + c) = (u32x4){0u, 0u, 0u, 0u}; }
        }
        return;
    }
    bf16_t* Wuq_t = (bf16_t*)(ws + WS_WUQ); bf16_t* Wukv_t = (bf16_t*)(ws + WS_WUKV); bf16_t* Wpool_t = (bf16_t*)(ws + WS_WPOOL);
    bf16_t* Wout_t = (bf16_t*)(ws + WS_WOUT); bf16_t* Wgate_t = (bf16_t*)(ws + WS_WGATE); bf16_t* Wple_t = (bf16_t*)(ws + WS_WPLE);
    constexpr int I_UQ = 8 * 48, I_UKV = 4 * 64, I_POOL = 4 * 4 * 8, I_OUT = 32 * 64, I_GATE = 32 * 64, I_PLE = 4 * 64;
    constexpr int NITEMS = I_UQ + I_UKV + I_POOL + I_OUT + I_GATE + I_PLE;
    static_assert(NITEMS == 5120, "chunk map");
    unsigned* cctr = (unsigned*)(ws + WS_CTL) + 11776 + 64 * a.li;
    volatile LAS unsigned* MISCp = (volatile LAS unsigned*)(lds + MISC_OFF);
    for (;;) {
        if (tid == 0) MISCp[23] = __hip_atomic_fetch_add(cctr, 1u, __ATOMIC_RELAXED, __HIP_MEMORY_SCOPE_AGENT);
        __syncthreads();
        const int ch = (int)MISCp[23];
        __syncthreads();
        if (ch >= 852 + NBT_A * 32) break;
        if (ch >= 852) { const int item = (ch - 852) * 8 + wave, bb = item >> 8, kbk = (item & 255) >> 3, nb = item & 7;
            cache_item(AIN(I_CCKV) + (size_t)bb * PAST * KVRANK, nullptr, ckvt_base(ws, bb), 64 * kbk, 32 * nb, scr, lane, false, true); continue; }
        if (ch < 640) {
            int r = ch * 8 + wave;
            if (r < I_UQ) { const int kb = r / 48, nb = r % 48, n0 = 32 * nb, h = n0 / DQK, j0 = n0 % DQK;
                const int d = j0 < 128 ? h * 128 + j0 : 1024 + 256 * (h >> 2) + 32 * (h & 3) + (j0 == 160 ? 128 : 0);
                transpose_item(AIN(I_WUQ), NHEAD * DQK, Wuq_t, QRANK, 64 * kb, n0, d, AIN(I_QNG), scr, lane); continue; } r -= I_UQ;
            if (r < I_UKV) { const int kb = r / 64, nb = r % 64; transpose_item(AIN(I_WUKV), 2048, Wukv_t, KVRANK, 64 * kb, 32 * nb, 32 * nb, nullptr, scr, lane); continue; } r -= I_UKV;
            if (r < I_POOL) { const int gq = r / 32, kb = (r % 32) / 8, nb = r % 8; transpose_item(AIN(I_WPOOL) + (size_t)gq * 65536, 256, Wpool_t, 256, 64 * kb, 32 * nb, gq * 256 + 32 * nb, nullptr, scr, lane); continue; } r -= I_POOL;
            if (r < I_OUT) { const int kb = r / 64, nb = r % 64; transpose_item(AIN(I_WOUT), DM, Wout_t, DM, 64 * kb, 32 * nb, 32 * nb, nullptr, scr, lane); continue; } r -= I_OUT;
            if (r < I_GATE) { const int kb = r / 64, nb = r % 64; transpose_item(AIN(I_WGATE), DM, Wgate_t, DM, 64 * kb, 32 * nb, 32 * nb, AIN(I_PLENG), scr, lane); continue; } r -= I_GATE;
            { const int kb = r / 64, nb = r % 64; transpose_item(AIN(I_WPLE), DM, Wple_t, DPLE, 64 * kb, 32 * nb, 32 * nb, nullptr, scr, lane); }
        } else if (ch < 708) {
            bf16_t* PBF = (bf16_t*)(ws + WS_PBF); const float* pp = AIN(I_PP); const float* ps = AIN(I_PS);
#pragma unroll
            for (int k = 0; k < 8; ++k) { const int i = (ch - 640) * 4096 + tid + k * 512, m = i >> 5, c = (i & 31) * 8; const float* src = (m < MP ? pp + (size_t)m * DPLE : ps + (size_t)(m - MP) * DPLE) + c;
                *(u32x4*)(PBF + (size_t)m * DPLE + c) = pack8(*(const f32x4*)src, *(const f32x4*)(src + 4)); }
        } else if (ch < 724) {
            bf16_t* UBF = (bf16_t*)(ws + WS_UBF); const float* sp = AIN(I_SPOOL);
#pragma unroll
            for (int k = 0; k < 8; ++k) { const int i = (ch - 708) * 4096 + tid + k * 512, rr = i >> 7, c = (i & 127) * 8; u32x4 w = {0u, 0u, 0u, 0u};
                if (rr < DBATCH * POOLH) { const float* src = sp + (size_t)rr * DPOOL + c; w = pack8(*(const f32x4*)src, *(const f32x4*)(src + 4)); }
                *(u32x4*)(UBF + (size_t)(MT + rr) * DPOOL + c) = w; }
        } else {
            const float* src = AIN(I_CKR) + (size_t)(ch - 724) * 32768; bf16_t* dst = (bf16_t*)(ws + WS_KRB) + (size_t)(ch - 724) * 32768;
#pragma unroll
            for (int k = 0; k < 8; ++k) { const int o = tid * 8 + k * 4096; *(u32x4*)(dst + o) = pack8(*(const f32x4*)(src + o), *(const f32x4*)(src + o + 4)); }
        }
    }
}

namespace pattn {
constexpr int KVBLK = 64, NW = 8, QBLK = 32;
constexpr int SHM_V = 16384, SHM_KN = 16384, SHM_KR = 8192;
constexpr int L_V = 0, L_KN = 2 * SHM_V, L_KR = L_KN + 2 * SHM_KN, L_WS = L_KR + 2 * SHM_KR, L_END = L_WS + NW * 64 * 4;
constexpr int LDQ = NHEAD * DQK, LDK = NHEAD * DNOPE, LDV = NHEAD * DV;
constexpr float THR = 4.0f;
#define KSWZ(row, colB) ((row) * 256 + ((colB) ^ (((row) & 7) << 4)))
#define RSWZ(row, colB) ((row) * 128 + ((colB) ^ (((row) & 7) << 4)))
__device__ __forceinline__ int crow(int r, int hi) { return (r & 3) + 8 * (r >> 2) + 4 * hi; }

__device__ __forceinline__ void partialSM(f32x16& p0, f32x16& p1, float& m_reg, float& alpha) {
    float pmax = p0[0];
#pragma unroll
    for (int r = 1; r < 16; ++r) pmax = fmaxf(pmax, p0[r]);
#pragma unroll
    for (int r = 0; r < 16; ++r) pmax = fmaxf(pmax, p1[r]);
    { auto rr = __builtin_amdgcn_permlane32_swap(__float_as_uint(pmax), __float_as_uint(pmax), false, false); pmax = fmaxf(__uint_as_float(rr[0]), __uint_as_float(rr[1])); }
    float mn;
    if (__builtin_expect(__all(pmax - m_reg <= THR), 1)) { mn = m_reg; alpha = 1.f; }
    else { mn = fmaxf(m_reg, pmax); alpha = __builtin_amdgcn_exp2f(m_reg - mn); m_reg = mn; }
#pragma unroll
    for (int r = 0; r < 16; ++r) p0[r] = p0[r] - mn;
#pragma unroll
    for (int r = 0; r < 16; ++r) p1[r] = p1[r] - mn;
#pragma unroll
    for (int r = 0; r < 16; ++r) p0[r] = __builtin_amdgcn_exp2f(p0[r]);
}
__device__ __forceinline__ void finishSM(f32x16& p0, f32x16& p1, float alpha, float& l_reg, bf16x8& pa0, bf16x8& pa1, bf16x8& pa2, bf16x8& pa3) {
#pragma unroll
    for (int r = 0; r < 16; ++r) p1[r] = __builtin_amdgcn_exp2f(p1[r]);
    float ps = 0;
#pragma unroll
    for (int r = 0; r < 16; ++r) ps += p0[r];
#pragma unroll
    for (int r = 0; r < 16; ++r) ps += p1[r];
    { auto rr = __builtin_amdgcn_permlane32_swap(__float_as_uint(ps), __float_as_uint(ps), false, false); ps = __uint_as_float(rr[0]) + __uint_as_float(rr[1]); }
    l_reg = l_reg * alpha + ps;
#define PK4(P, BASE, OUT) do { unsigned a0 = cvtpk(P[BASE + 0], P[BASE + 1]), a1 = cvtpk(P[BASE + 2], P[BASE + 3]);   \
    unsigned b0 = cvtpk(P[BASE + 4], P[BASE + 5]), b1 = cvtpk(P[BASE + 6], P[BASE + 7]);                              \
    auto r0 = __builtin_amdgcn_permlane32_swap(a0, b0, false, false); auto r1 = __builtin_amdgcn_permlane32_swap(a1, b1, false, false); \
    u32x4 w = {r0[0], r1[0], r0[1], r1[1]}; OUT = __builtin_bit_cast(bf16x8, w); } while (0)
    PK4(p0, 0, pa0); PK4(p0, 8, pa1); PK4(p1, 0, pa2); PK4(p1, 8, pa3);
#undef PK4
}
__device__ __forceinline__ void qkt(f32x16& p0, f32x16& p1, LAS const unsigned char* Kn, LAS const unsigned char* Kr, const bf16x8* qr, int r32, int hi) {
    p0 = f32x16{}; p1 = f32x16{};
#pragma unroll
    for (int d0 = 0; d0 < 8; ++d0) { const int cb = (d0 * 16 + hi * 8) * 2;
        const bf16x8 b0 = *(LAS const bf16x8*)(Kn + KSWZ(r32, cb)); const bf16x8 b1 = *(LAS const bf16x8*)(Kn + KSWZ(32 + r32, cb));
        p0 = __builtin_amdgcn_mfma_f32_32x32x16_bf16(b0, qr[d0], p0, 0, 0, 0); p1 = __builtin_amdgcn_mfma_f32_32x32x16_bf16(b1, qr[d0], p1, 0, 0, 0); }
#pragma unroll
    for (int d0 = 0; d0 < 4; ++d0) { const int cb = (d0 * 16 + hi * 8) * 2;
        const bf16x8 b0 = *(LAS const bf16x8*)(Kr + RSWZ(r32, cb)); const bf16x8 b1 = *(LAS const bf16x8*)(Kr + RSWZ(32 + r32, cb));
        p0 = __builtin_amdgcn_mfma_f32_32x32x16_bf16(b0, qr[8 + d0], p0, 0, 0, 0); p1 = __builtin_amdgcn_mfma_f32_32x32x16_bf16(b1, qr[8 + d0], p1, 0, 0, 0); }
}
__device__ __forceinline__ int v_st(int k, int c) { const int kk = (k & ~0xC) | ((k & 4) << 1) | ((k & 8) >> 1); return ((kk >> 3) * 4 + (c >> 5)) * 512 + ((kk & 7) * 32 + (c & 31)) * 2; }
__device__ __forceinline__ int v_rd_base(int lane) { return ((lane & 3) << 3) | (((lane >> 2) & 3) << 6) | (((lane >> 4) & 1) << 5) | (((lane >> 5) & 1) << 8); }
constexpr int v_rd_off(int d0, int ks, int half) { return d0 * 512 + ks * 4096 + half * 2048; }
template <int OFF> __device__ __forceinline__ s16x4 tr_read(int vb) { s16x4 r; asm volatile("ds_read_b64_tr_b16 %0, %1 offset:%2" : "=&v"(r) : "v"(vb), "i"(OFF) : "memory"); return r; }
template <int D0> __device__ __forceinline__ void pv_one(f32x16& od, int vb, bf16x8 pa0, bf16x8 pa1, bf16x8 pa2, bf16x8 pa3) {
    const s16x4 l0 = tr_read<v_rd_off(D0, 0, 0)>(vb), h0 = tr_read<v_rd_off(D0, 0, 1)>(vb), l1 = tr_read<v_rd_off(D0, 1, 0)>(vb), h1 = tr_read<v_rd_off(D0, 1, 1)>(vb);
    const s16x4 l2 = tr_read<v_rd_off(D0, 2, 0)>(vb), h2 = tr_read<v_rd_off(D0, 2, 1)>(vb), l3 = tr_read<v_rd_off(D0, 3, 0)>(vb), h3 = tr_read<v_rd_off(D0, 3, 1)>(vb);
    asm volatile("s_waitcnt lgkmcnt(0)" ::: "memory"); SBAR();
#define PK(L, H) (bf16x8){L[0], L[1], L[2], L[3], H[0], H[1], H[2], H[3]}
    od = __builtin_amdgcn_mfma_f32_32x32x16_bf16(pa0, PK(l0, h0), od, 0, 0, 0);
    od = __builtin_amdgcn_mfma_f32_32x32x16_bf16(pa1, PK(l1, h1), od, 0, 0, 0);
    od = __builtin_amdgcn_mfma_f32_32x32x16_bf16(pa2, PK(l2, h2), od, 0, 0, 0);
    od = __builtin_amdgcn_mfma_f32_32x32x16_bf16(pa3, PK(l3, h3), od, 0, 0, 0);
#undef PK
}
__device__ __forceinline__ void pv_d0(f32x16* o, int vb, bf16x8 pa0, bf16x8 pa1, bf16x8 pa2, bf16x8 pa3) {
    pv_one<0>(o[0], vb, pa0, pa1, pa2, pa3); pv_one<1>(o[1], vb, pa0, pa1, pa2, pa3); pv_one<2>(o[2], vb, pa0, pa1, pa2, pa3); pv_one<3>(o[3], vb, pa0, pa1, pa2, pa3);
}

__device__ __forceinline__ void unit(int b, int h, int qb, const bf16_t* __restrict__ QCAT, const bf16_t* __restrict__ KCAT, const bf16_t* __restrict__ KRN, const bf16_t* __restrict__ Vb, const bf16_t* __restrict__ SGM, bf16_t* MIX, LAS unsigned char* lds, int wv) {
    int lane = lane_id(); asm volatile("" : "+v"(lane));
    const int wid = wv, tid = (wv << 6) | lane, r32 = lane & 31, hi = lane >> 5;
    const long rowbase = (long)b * SEQ; const int q0 = qb * 256;
    LAS unsigned char* V_lds = lds + L_V; LAS unsigned char* KN_lds = lds + L_KN; LAS unsigned char* KR_lds = lds + L_KR;
    LAS float* wsf = (LAS float*)(lds + L_WS) + wid * 64; LAS float* li_l = wsf; LAS float* al_l = wsf + 32;
    const bf16_t* Kh = KCAT + rowbase * LDK + h * DNOPE; const bf16_t* Vh = Vb + rowbase * LDV + h * DV; const bf16_t* Kr = KRN + rowbase * DROPE;
    float m_reg = -1e30f, l_reg = 0.f; f32x16 o[4]; o[0] = f32x16{}; o[1] = f32x16{}; o[2] = f32x16{}; o[3] = f32x16{};
    bf16x8 qr[12];
    { const bf16_t* Qw = QCAT + (rowbase + q0 + wid * QBLK + r32) * LDQ + h * DQK + hi * 8;
#pragma unroll
      for (int d0 = 0; d0 < 12; ++d0) qr[d0] = *(const bf16x8*)(Qw + d0 * 16); }
    const int cw = 4 * qb + (wid >> 1);
    const int NT = 4 * qb + 4;
    const int sr = tid >> 4, sc = (tid & 15) * 8, vst0 = v_st(sr, sc), vst1 = v_st(32 + sr, sc);
    const int krr = tid >> 3, krc = (tid & 7) * 8;
    const int vb0 = (int)(uintptr_t)V_lds + v_rd_base(lane);
    bf16x8 sv0, sv1, sk0, sk1, skr;
#define SLOAD(k0) do { sv0 = *(const bf16x8*)(Vh + (long)((k0) + sr) * LDV + sc); sv1 = *(const bf16x8*)(Vh + (long)((k0) + 32 + sr) * LDV + sc); \
    sk0 = *(const bf16x8*)(Kh + (long)((k0) + sr) * LDK + sc); sk1 = *(const bf16x8*)(Kh + (long)((k0) + 32 + sr) * LDK + sc); \
    skr = *(const bf16x8*)(Kr + (long)((k0) + krr) * DROPE + krc); } while (0)
#define SWRITE(bb) do { *(LAS bf16x8*)(V_lds + (bb) * SHM_V + vst0) = sv0; *(LAS bf16x8*)(V_lds + (bb) * SHM_V + vst1) = sv1; \
    *(LAS bf16x8*)(KN_lds + (bb) * SHM_KN + KSWZ(sr, sc * 2)) = sk0; *(LAS bf16x8*)(KN_lds + (bb) * SHM_KN + KSWZ(32 + sr, sc * 2)) = sk1; \
    *(LAS bf16x8*)(KR_lds + (bb) * SHM_KR + RSWZ(krr, krc * 2)) = skr; } while (0)
#define RESC(a) do { if (__any((a) < 1.f)) { if (hi == 0) al_l[r32] = (a); asm volatile("s_waitcnt lgkmcnt(0)" ::: "memory"); \
    _Pragma("unroll") for (int d = 0; d < 4; ++d) _Pragma("unroll") for (int r = 0; r < 16; ++r) o[d][r] *= al_l[crow(r, hi)]; } } while (0)
#define QKT(P0, P1, bb, j) do { if ((j) <= cw) qkt(P0, P1, KN_lds + (bb) * SHM_KN, KR_lds + (bb) * SHM_KR, qr, r32, hi); \
    else { _Pragma("unroll") for (int r = 0; r < 16; ++r) { P0[r] = -1e30f; P1[r] = -1e30f; } } } while (0)
#define PV(bb, j) do { if ((j) <= cw) pv_d0(o, vb0 + (bb) * SHM_V, pa0, pa1, pa2, pa3); } while (0)
    f32x16 pA0, pA1, pB0, pB1; float alA, alB; bf16x8 pa0, pa1, pa2, pa3;
    SLOAD(0); SWRITE(0); __syncthreads();
    QKT(pA0, pA1, 0, 0); partialSM(pA0, pA1, m_reg, alA);
    SLOAD(KVBLK); SWRITE(1); __syncthreads();
    for (int j = 1; j + 1 < NT; j += 2) {
        SBAR(); QKT(pB0, pB1, 1, j);
        finishSM(pA0, pA1, alA, l_reg, pa0, pa1, pa2, pa3); SBAR();
        SLOAD((j + 1) * KVBLK); SBAR();
        PV(0, j - 1); partialSM(pB0, pB1, m_reg, alB);
        __syncthreads(); SWRITE(0);
        RESC(alB); __syncthreads();
        SBAR(); QKT(pA0, pA1, 0, j + 1);
        finishSM(pB0, pB1, alB, l_reg, pa0, pa1, pa2, pa3); SBAR();
        SLOAD((j + 2) * KVBLK); SBAR();
        PV(1, j); partialSM(pA0, pA1, m_reg, alA);
        __syncthreads(); SWRITE(1);
        RESC(alA); __syncthreads();
    }
    SBAR(); QKT(pB0, pB1, 1, NT - 1);
    finishSM(pA0, pA1, alA, l_reg, pa0, pa1, pa2, pa3); SBAR();
    PV(0, NT - 2); partialSM(pB0, pB1, m_reg, alB);
    __syncthreads(); RESC(alB);
    finishSM(pB0, pB1, alB, l_reg, pa0, pa1, pa2, pa3); SBAR();
    PV(1, NT - 1);
    if (hi == 0) li_l[r32] = l_reg; asm volatile("s_waitcnt lgkmcnt(0)" ::: "memory");
    float rli[16];
#pragma unroll
    for (int r = 0; r < 16; ++r) rli[r] = __builtin_amdgcn_rcpf(li_l[crow(r, hi)]);
    __syncthreads();
    LAS bf16_t* stg = (LAS bf16_t*)(lds + wid * 8192);
#pragma unroll
    for (int r = 0; r < 16; ++r) { const int orow = crow(r, hi);
#pragma unroll
        for (int d0 = 0; d0 < 4; ++d0) { const float v = o[d0][r] * rli[r]; stg[orow * 128 + d0 * 32 + r32] = (bf16_t)(cvtpk(v, 0.f) & 0xffffu); } }
    asm volatile("s_waitcnt lgkmcnt(0)" ::: "memory");
    const long orow0 = rowbase + q0 + wid * QBLK;
#pragma unroll
    for (int i = 0; i < 8; ++i) { const int row = i * 4 + (lane >> 4), ch = lane & 15; const u32x4 v = *(LAS const u32x4*)(stg + row * 128 + ch * 8);
        const u32x4 gq = *(const u32x4*)(SGM + (orow0 + row) * 1024 + h * DV + ch * 8); u32x4 w;
        w.x = cvtpk(__uint_as_float(v.x << 16) * __uint_as_float(gq.x << 16), __uint_as_float(v.x & 0xffff0000u) * __uint_as_float(gq.x & 0xffff0000u));
        w.y = cvtpk(__uint_as_float(v.y << 16) * __uint_as_float(gq.y << 16), __uint_as_float(v.y & 0xffff0000u) * __uint_as_float(gq.y & 0xffff0000u));
        w.z = cvtpk(__uint_as_float(v.z << 16) * __uint_as_float(gq.z << 16), __uint_as_float(v.z & 0xffff0000u) * __uint_as_float(gq.z & 0xffff0000u));
        w.w = cvtpk(__uint_as_float(v.w << 16) * __uint_as_float(gq.w << 16), __uint_as_float(v.w & 0xffff0000u) * __uint_as_float(gq.w & 0xffff0000u));
        *(u32x4*)(MIX + (orow0 + row) * DM + DPOOL + h * DV + ch * 8) = w; }
    __syncthreads();
#undef SLOAD
#undef SWRITE
#undef RESC
#undef QKT
#undef PV
}
}

namespace sattn {
__device__ __forceinline__ int crow(int r, int hi) { return (r & 3) + 8 * (r >> 2) + 4 * hi; }
__device__ __forceinline__ bf16x8 packf8(const f32x16& a, int base, float s) {
    u32x4 w; w.x = cvtpk(a[base + 0] * s, a[base + 1] * s); w.y = cvtpk(a[base + 2] * s, a[base + 3] * s); w.z = cvtpk(a[base + 4] * s, a[base + 5] * s); w.w = cvtpk(a[base + 6] * s, a[base + 7] * s);
    return __builtin_bit_cast(bf16x8, w);
}
constexpr int NKB = (SKV_S + 31) / 32;
constexpr int WROW = 528;
constexpr int PS_OFF = 69632;
constexpr int QF_OFF = 256 * WROW;
constexpr int CQ_STRIDE = 260;

__device__ __forceinline__ void unit(int b, int h, const bf16_t* __restrict__ CKVB, const bf16_t* __restrict__ KRB, const bf16_t* __restrict__ CKVN, const bf16_t* __restrict__ KRN, const bf16_t* __restrict__ CT,
                                     const bf16_t* __restrict__ Wukv_t, const bf16_t* __restrict__ QCAT, const bf16_t* __restrict__ SGM, bf16_t* MIX, LAS unsigned char* lds, LAS unsigned char* scr, int wv) {
    int lane = lane_id(); asm volatile("" : "+v"(lane));
    const int wid = wv, tid = (wv << 6) | lane, r32 = lane & 31, hh = lane >> 5;
    LAS unsigned char* qf = lds + QF_OFF;
    { const bf16_t* Wsrc = Wukv_t + (size_t)h * 256 * KVRANK;
#pragma unroll 4
      for (int i = 0; i < 8; ++i) { const int gi = tid + 512 * i, row = gi >> 5, c16 = gi & 31; const u32x4 v = *(const u32x4*)(Wsrc + (size_t)gi * 8);
          *(LAS u32x4*)(lds + row * WROW + (c16 << 4)) = v; } }
    { const bf16_t* qp = QCAT + (size_t)(MP + b * DSEQ + (r32 & 15)) * (NHEAD * DQK) + h * DQK;
      for (int f = wid; f < 12; f += 8) { u32x4 v = {0u, 0u, 0u, 0u};
          if (r32 < DSEQ) { if (f < 8) { const bf16_t* p = qp + (f >> 1) * 32 + (f & 1) * 16 + 4 * hh; const u32x2 lo = *(const u32x2*)p, hi2 = *(const u32x2*)(p + 8); v = (u32x4){lo.x, lo.y, hi2.x, hi2.y}; }
                            else v = *(const u32x4*)(qp + DNOPE + (f - 8) * 16 + 8 * hh); }
          *(LAS u32x4*)(qf + f * 1024 + lane * 16) = v; } }
    __syncthreads();
    float m_run = -1e30f, l_run = 0.f; f32x4 ol[16];
#pragma unroll
    for (int i = 0; i < 16; ++i) ol[i] = (f32x4){0.f, 0.f, 0.f, 0.f};
    LAS float* rks = (LAS float*)(lds + MISC_OFF + 256) + wid * 32;
    LAS unsigned char* ps = lds + PS_OFF + wid * 2048;
    LAS const unsigned char* wk = lds + r32 * WROW + hh * 16; LAS const unsigned char* qfl = qf + lane * 16;
    const int q16 = lane & 15, kq = lane >> 4;
    const bf16_t* ctl = CT + (size_t)lane * 8; const bf16_t* cbl = CKVB + (size_t)b * (CKVT_B / 2) + (size_t)lane * 8;
    for (int kb = wid; kb < NKB; kb += 8) {
        int key = kb * 32 + r32; if (key > SKV_S - 1) key = SKV_S - 1;
        const bf16_t* kp = (key < PAST ? KRB + (size_t)(b * PAST + key) * DROPE : KRN + (size_t)(MP + b * DSEQ + key - PAST) * DROPE) + 8 * hh;
        f32x16 z = f32x16{}; float ssq = 0.f;
        bf16x8 rf[4];
#pragma unroll
        for (int s = 0; s < 4; ++s) rf[s] = *(const bf16x8*)(kp + 16 * s);
        {
        bf16x8 cf[16];
#pragma unroll
        for (int s = 0; s < 16; ++s) cf[s] = *(const bf16x8*)(cbl + (size_t)(kb * 16 + s) * 512);
#pragma unroll
        for (int dh = 0; dh < 2; ++dh) {
            f32x16 acc[2];
#pragma unroll
            for (int d2 = 0; d2 < 2; ++d2) { acc[d2] = f32x16{};
#pragma unroll
                for (int s = 0; s < 16; ++s) { const bf16x8 wa = *(LAS const bf16x8*)(wk + (dh * 2 + d2) * 32 * WROW + s * 32);
                    acc[d2] = __builtin_amdgcn_mfma_f32_32x32x16_bf16(wa, cf[s], acc[d2], 0, 0, 0); } }
            SBAR();
            bf16x8 kn[4];
#pragma unroll
            for (int d2 = 0; d2 < 2; ++d2) {
#pragma unroll
                for (int r = 0; r < 16; ++r) ssq += acc[d2][r] * acc[d2][r];
                kn[2 * d2] = packf8(acc[d2], 0, 1.f); kn[2 * d2 + 1] = packf8(acc[d2], 8, 1.f); }
            SBAR();
#pragma unroll
            for (int f = 0; f < 4; ++f) { const bf16x8 qb = *(LAS const bf16x8*)(qfl + (dh * 4 + f) * 1024); z = __builtin_amdgcn_mfma_f32_32x32x16_bf16(kn[f], qb, z, 0, 0, 0); }
            SBAR();
        }
        }
        bf16x8 af[16];
        { const bf16_t* ck = ctl + (size_t)kb * 16 * 512;
#pragma unroll
          for (int lb = 0; lb < 16; ++lb) af[lb] = *(const bf16x8*)(ck + lb * 512); }
        { auto rr = __builtin_amdgcn_permlane32_swap(__float_as_uint(ssq), __float_as_uint(ssq), false, false); ssq = __uint_as_float(rr[0]) + __uint_as_float(rr[1]); }
        rks[lane & 31] = 1.0f / sqrtf(ssq * (1.f / DNOPE) + EPS);
        asm volatile("s_waitcnt lgkmcnt(0)" ::: "memory");
#pragma unroll
        for (int g4 = 0; g4 < 4; ++g4) { const f32x4 rv = *(LAS const f32x4*)(rks + 8 * g4 + 4 * hh);
#pragma unroll
            for (int j = 0; j < 4; ++j) z[4 * g4 + j] *= rv[j]; }
#pragma unroll
        for (int s = 0; s < 4; ++s) { const bf16x8 qb = *(LAS const bf16x8*)(qfl + (8 + s) * 1024); z = __builtin_amdgcn_mfma_f32_32x32x16_bf16(rf[s], qb, z, 0, 0, 0); }
        SBAR();
        if (kb == NKB - 1) {
#pragma unroll
            for (int r = 0; r < 16; ++r) if (kb * 32 + crow(r, hh) >= SKV_S) z[r] = -1e30f;
        }
        float mx = z[0];
#pragma unroll
        for (int r = 1; r < 16; ++r) mx = fmaxf(mx, z[r]);
        { auto rr = __builtin_amdgcn_permlane32_swap(__float_as_uint(mx), __float_as_uint(mx), false, false); mx = fmaxf(__uint_as_float(rr[0]), __uint_as_float(rr[1])); }
        const float mn = fmaxf(m_run, mx), alpha = __builtin_amdgcn_exp2f(m_run - mn); m_run = mn;
        float psum = 0.f;
#pragma unroll
        for (int r = 0; r < 16; ++r) { z[r] = __builtin_amdgcn_exp2f(z[r] - mn); psum += z[r]; }
        l_run = l_run * alpha + psum;
        if (r32 < DSEQ) {
#pragma unroll
            for (int k4 = 0; k4 < 4; ++k4) { u32x2 w; w.x = cvtpk(z[4 * k4], z[4 * k4 + 1]); w.y = cvtpk(z[4 * k4 + 2], z[4 * k4 + 3]); *(LAS u32x2*)(ps + (r32 * 4 + k4) * 16 + 8 * hh) = w; }
            if (hh == 0) *(LAS float*)(ps + 1024 + 4 * r32) = alpha;
        }
        asm volatile("s_waitcnt lgkmcnt(0)" ::: "memory");
        const bf16x8 pf = *(LAS const bf16x8*)(ps + (q16 * 4 + kq) * 16); const float al16 = *(LAS const float*)(ps + 1024 + 4 * q16);
        SBAR();
#pragma unroll
        for (int lb = 0; lb < 16; ++lb) ol[lb] = __builtin_amdgcn_mfma_f32_16x16x32_bf16(af[lb], pf, ol[lb] * al16, 0, 0, 0);
        SBAR();
    }
    { auto rr = __builtin_amdgcn_permlane32_swap(__float_as_uint(l_run), __float_as_uint(l_run), false, false); l_run = __uint_as_float(rr[0]) + __uint_as_float(rr[1]); }
    __syncthreads();
    LAS float* comb = (LAS float*)lds; LAS float* ml = (LAS float*)(lds + QF_OFF);
    const int lane2 = lane_id(), tid2 = (wv << 6) | lane2;
    { const int qq = lane2 & 15, rq = lane2 >> 4;
#pragma unroll
      for (int lb = 0; lb < 16; ++lb) *(LAS f32x4*)(comb + (wid * 16 + qq) * CQ_STRIDE + lb * 16 + 4 * rq) = ol[lb];
      if (lane2 < DSEQ) { ml[wid * 16 + lane2] = m_run; ml[128 + wid * 16 + lane2] = l_run; } }
    __syncthreads();
    { const int q = tid2 >> 5, l0 = (tid2 & 31) * 8; float M = ml[q];
#pragma unroll
      for (int w = 1; w < 8; ++w) M = fmaxf(M, ml[w * 16 + q]);
      float L = 0.f; f32x4 a0 = {0.f, 0.f, 0.f, 0.f}, a1 = {0.f, 0.f, 0.f, 0.f};
#pragma unroll
      for (int w = 0; w < 8; ++w) { const float e = __builtin_amdgcn_exp2f(ml[w * 16 + q] - M); L += ml[128 + w * 16 + q] * e; const LAS float* cp = comb + (w * 16 + q) * CQ_STRIDE + l0;
          a0 += *(LAS const f32x4*)cp * e; a1 += *(LAS const f32x4*)(cp + 4) * e; }
      const float rl = 1.0f / L;
      __syncthreads();
      *(LAS f32x4*)(comb + q * CQ_STRIDE + l0) = a0 * rl; *(LAS f32x4*)(comb + q * CQ_STRIDE + l0 + 4) = a1 * rl; }
    __syncthreads();
    { const int q16b = lane2 & 15, kqb = lane2 >> 4; const bf16_t* wvp = Wukv_t + ((size_t)h * 256 + 128 + wid * 16 + q16b) * KVRANK + 8 * kqb;
      const LAS float* arow = comb + q16b * CQ_STRIDE + 8 * kqb;
      f32x4 od = {0.f, 0.f, 0.f, 0.f};
#pragma unroll
      for (int ks = 0; ks < 8; ++ks) { const f32x4 x0 = *(LAS const f32x4*)(arow + 32 * ks), x1 = *(LAS const f32x4*)(arow + 32 * ks + 4);
          const bf16x8 af2 = __builtin_bit_cast(bf16x8, pack8(x0, x1)); const bf16x8 bf2 = *(const bf16x8*)(wvp + 32 * ks);
          od = __builtin_amdgcn_mfma_f32_16x16x32_bf16(af2, bf2, od, 0, 0, 0); }
      const int dim = wid * 16 + q16b;
#pragma unroll
      for (int r = 0; r < 4; ++r) { const size_t row = (size_t)(MP + b * DSEQ + 4 * kqb + r);
          const float gt = bf2f(SGM[row * 1024 + h * DV + dim]); MIX[row * DM + DPOOL + h * DV + dim] = (bf16_t)(cvtpk(od[r] * gt, 0.f) & 0xffffu); } }
    __syncthreads();
}
}

__device__ __forceinline__ void pool_window_block(int blk, const bf16_t* __restrict__ Z, const bf16_t* __restrict__ SGP, const float* __restrict__ pscale, bf16_t* MIX, int wv) {
    const int tid = TIDX(wv), m0 = blk * 32 + (tid >> 7) * 8, col = (tid & 127) * 8, w = 2 << (col >> 8);
    const bool smp = m0 >= MP; const int sb = (m0 - MP) >> 4;
    const int u0 = smp ? POOLH + ((m0 - MP) & 15) : (m0 & (SEQ - 1));
    const long base_new = smp ? (long)(MP + sb * DSEQ) - POOLH : (long)(m0 - u0);
    const long base_hist = (long)MT + sb * POOLH;
#define ZROW(u) ((smp && (u) < POOLH) ? base_hist + (u) : base_new + (u))
#define LD8(dst, u) do { const u32x4 v_ = *(const u32x4*)(Z + ZROW(u) * DPOOL + col); dst[0] = __uint_as_float(v_.x << 16); dst[1] = __uint_as_float(v_.x & 0xffff0000u); dst[2] = __uint_as_float(v_.y << 16); dst[3] = __uint_as_float(v_.y & 0xffff0000u); \
    dst[4] = __uint_as_float(v_.z << 16); dst[5] = __uint_as_float(v_.z & 0xffff0000u); dst[6] = __uint_as_float(v_.w << 16); dst[7] = __uint_as_float(v_.w & 0xffff0000u); } while (0)
    float S[8];
#pragma unroll
    for (int i = 0; i < 8; ++i) S[i] = 0.f;
    for (int j = 1; j < w; ++j) { const int u = u0 - j; if (u >= 0) { float t[8]; LD8(t, u);
#pragma unroll
        for (int i = 0; i < 8; ++i) S[i] += t[i]; } }
    const f32x4 p0 = *(const f32x4*)(pscale + col), p1 = *(const f32x4*)(pscale + col + 4);
#pragma unroll
    for (int r = 0; r < 8; ++r) { const int u = u0 + r; float zc[8]; LD8(zc, u);
#pragma unroll
        for (int i = 0; i < 8; ++i) S[i] += zc[i];
        const int pos1 = smp ? SEQ : u + 1; const float rc = 1.0f / (float)(pos1 < w ? pos1 : w);
        const u32x4 gq = *(const u32x4*)(SGP + (size_t)(m0 + r) * DPOOL + col);
        const float gv[8] = {__uint_as_float(gq.x << 16), __uint_as_float(gq.x & 0xffff0000u), __uint_as_float(gq.y << 16), __uint_as_float(gq.y & 0xffff0000u),
                             __uint_as_float(gq.z << 16), __uint_as_float(gq.z & 0xffff0000u), __uint_as_float(gq.w << 16), __uint_as_float(gq.w & 0xffff0000u)};
        float ov[8];
#pragma unroll
        for (int i = 0; i < 8; ++i) ov[i] = (S[i] * rc - zc[i]) * (i < 4 ? p0[i] : p1[i - 4]) * gv[i];
        u32x4 wv4; wv4.x = cvtpk(ov[0], ov[1]); wv4.y = cvtpk(ov[2], ov[3]); wv4.z = cvtpk(ov[4], ov[5]); wv4.w = cvtpk(ov[6], ov[7]);
        *(u32x4*)(MIX + (size_t)(m0 + r) * DM + col) = wv4;
        const int ud = u - w + 1; if (ud >= 0) { float t[8]; LD8(t, ud);
#pragma unroll
            for (int i = 0; i < 8; ++i) S[i] -= t[i]; } }
#undef ZROW
#undef LD8
}

#define XB_TMO      128
#define XB_XCNT(j)  (256  + 64 * (j))
#define XB_XSUB(j)  (1280 + 64 * (j))
#define XB_XGEN(j)  (2304 + 64 * (j))
#define XB_TOP      3328
#define XB_TOPGEN   3392
#define XCD_BAR_WORDS 3456
#define XB_SPIN_CAP (1u << 22)
__device__ __forceinline__ unsigned xb_ld(unsigned* p)              { return __hip_atomic_load(p, __ATOMIC_RELAXED, __HIP_MEMORY_SCOPE_AGENT); }
__device__ __forceinline__ unsigned xb_add(unsigned* p, unsigned v) { return __hip_atomic_fetch_add(p, v, __ATOMIC_RELAXED, __HIP_MEMORY_SCOPE_AGENT); }
__device__ __forceinline__ unsigned xb_xcc_id() { return (unsigned)__builtin_amdgcn_s_getreg((3 << 11) | 20) & 0xFu; }
#define XB_SPIN(cond, bar) do { unsigned _sp = 0; while (cond) { __builtin_amdgcn_s_sleep(1); \
    if ((++_sp & 255u) == 0u) { if (xb_ld(&(bar)[XB_TMO])) break; if (_sp > XB_SPIN_CAP) { atomicAdd(&(bar)[XB_TMO], 1u); break; } } } } while (0)
struct XcdBarrier { unsigned* bar; unsigned x; volatile LAS unsigned* st; };
__device__ __forceinline__ XcdBarrier xcd_barrier_post(unsigned* bar, volatile LAS unsigned* st, int wv) {
    XcdBarrier b; b.bar = bar; b.x = xb_xcc_id(); b.st = st;
    if (TIDX(wv) == 0) (void)xb_add(&bar[XB_XCNT(b.x)], 1u);
    return b;
}
__device__ __forceinline__ void xcd_barrier_complete(unsigned* bar, unsigned x, unsigned& nloc, unsigned& nx) {
    const unsigned G = gridDim.x * gridDim.y * gridDim.z;
    unsigned sum, cnt, mine, sp = 0u;
    for (;;) {
        sum = 0u; cnt = 0u; mine = 0u;
#pragma unroll
        for (unsigned j = 0; j < 16; ++j) { const unsigned c = xb_ld(&bar[XB_XCNT(j)]); sum += c; cnt += (c > 0u) ? 1u : 0u; mine = (j == x) ? c : mine; }
        if (sum == G) break;
        __builtin_amdgcn_s_sleep(1);
        if ((++sp & 255u) == 0u) { if (xb_ld(&bar[XB_TMO])) break; if (sp > XB_SPIN_CAP) { atomicAdd(&bar[XB_TMO], 1u); break; } }
    }
    nloc = mine > 0u ? mine : 1u; nx = cnt > 0u ? cnt : 1u;
}
__device__ __forceinline__ void xcd_barrier(const XcdBarrier& b, int wv) {
    asm volatile("s_waitcnt vmcnt(0)" ::: "memory");
    __syncthreads();
    if (TIDX(wv) == 0) {
        unsigned* bar = b.bar;
        __builtin_amdgcn_s_waitcnt(0);
        unsigned nloc = b.st[0], nx = b.st[1];
        if (nloc == 0u) { xcd_barrier_complete(bar, b.x, nloc, nx); b.st[0] = nloc; b.st[1] = nx; }
        const unsigned old = xb_add(&bar[XB_XSUB(b.x)], 1u);
        const unsigned gen = old / nloc;
        if (old + 1u == (gen + 1u) * nloc) {
            __builtin_amdgcn_fence(__ATOMIC_RELEASE, "agent");
            asm volatile("s_waitcnt vmcnt(0)" ::: "memory");
            const unsigned og = xb_add(&bar[XB_TOP], 1u);
            const unsigned tg = og / nx;
            if (og + 1u == (tg + 1u) * nx) xb_add(&bar[XB_TOPGEN], 1u);
            else XB_SPIN(xb_ld(&bar[XB_TOPGEN]) == tg, bar);
            __builtin_amdgcn_fence(__ATOMIC_ACQUIRE, "agent");
            xb_add(&bar[XB_XGEN(b.x)], 1u);
            asm volatile("s_waitcnt vmcnt(0)" ::: "memory");
        } else {
            XB_SPIN(xb_ld(&bar[XB_XGEN(b.x)]) == gen, bar);
            __builtin_amdgcn_fence(__ATOMIC_ACQUIRE, "agent");
            asm volatile("s_waitcnt vmcnt(0)" ::: "memory");
        }
    }
    __syncthreads();
}

constexpr int N_PHASES = 5;
__global__ void __launch_bounds__(512, 2) hymba_fwd(Args a) {
    extern __shared__ __attribute__((aligned(16))) unsigned char lds_raw[];
    LAS unsigned char* lds = (LAS unsigned char*)lds_raw;
    LAS unsigned char* scr = lds + SCR_OFF;
    volatile LAS unsigned* MISC = (volatile LAS unsigned*)(lds + MISC_OFF);
    const int wv = __builtin_amdgcn_readfirstlane((int)threadIdx.x >> 6);
    const int tid = TIDX(wv);
    const int G = gridDim.x; const int bx = blockIdx.x; const int vcu = (G % 8 == 0) ? (bx % 8) * (G / 8) + bx / 8 : bx;
    unsigned char* ws = a.ws; float* out = a.out;
    if (tid < 64) MISC[tid] = 0u;
    __syncthreads();
    XcdBarrier bar; bar.bar = (unsigned*)(ws + WS_CTL) + 1024 + a.li * XCD_BAR_WORDS; bar.x = 0; bar.st = nullptr;
    const bool one_launch = (a.ph_hi - a.ph_lo) > 1;
    if (one_launch) bar = xcd_barrier_post((unsigned*)(ws + WS_CTL) + 1024 + a.li * XCD_BAR_WORDS, MISC + 8, wv);
    const int lo = a.ph_lo, hi = a.ph_hi;
#ifndef PHASE_MASK
#define PHASE_MASK 63
#endif
#define IN(k) (((PHASE_MASK >> (k)) & 1) && lo <= (k) && (k) < hi)
#define SEAM(k) do { if (IN(k) && IN((k) + 1)) xcd_barrier(bar, wv); } while (0)
#define WSP(T, off) ((T*)(ws + (off)))
    if (IN(0)) { p0_prologue(a, lds, vcu, G, wv, 0); __syncthreads(); }
    SEAM(0);
    if (IN(1)) {
        pg8::SchedP1 S{(const char*)ws, bx, G};
        pg8::EpiInProj E{ws, out};
        pg8::gemm_phase(lds, scr, S, E, wv);
        __syncthreads(); p0_prologue(a, lds, vcu, G, wv, 1);
    }
    SEAM(1);
    if (IN(2)) {
        { pg8::SchedP2 S{(const char*)ws, bx, G};
          pg8::EpiP2 E{ws};
          pg8::gemm_phase(lds, scr, S, E, wv); }
        {
            const float* c1 = AIN(I_CCKV);
            unsigned* cctr = (unsigned*)(ws + WS_CTL) + 11520 + 64 * a.li; constexpr int NC = DBATCH * 256 / 8;
            for (;;) {
                if (TIDX(wv) == 0) MISC[22] = __hip_atomic_fetch_add(cctr, 1u, __ATOMIC_RELAXED, __HIP_MEMORY_SCOPE_AGENT);
                __syncthreads();
                const int ch = (int)MISC[22];
                __syncthreads();
                if (ch >= NC) break;
                const int item = ch * 8 + wv, bb = item >> 8, kbk = (item & 255) >> 3, nb = item & 7;
                cache_item(c1 + (size_t)bb * PAST * KVRANK, WSP(bf16_t, WS_CKVB) + (size_t)bb * (CKVT_B / 2), ckvt_base(ws, bb), 64 * kbk, 32 * nb, (LAS float*)(lds + wv * 16384), lane_id(), true, bb >= NBT_A);
            }
            { const bf16_t* CKVN = WSP(bf16_t, WS_CKVN);
              for (int i = vcu * 512 + TIDX(wv); i < DBATCH * 16 * 64; i += G * 512) { const int bb = i >> 10, sb = (i >> 6) & 15, ln = i & 63;
                  const bf16_t* nk = CKVN + (size_t)(MP + bb * DSEQ) * KVRANK; const size_t fo = ((size_t)(64 * 16 + sb) * 64 + ln) * 8;
                  { const int t = ln & 31; u32x4 w = {0u, 0u, 0u, 0u}; if (t < DSEQ) w = *(const u32x4*)(nk + (size_t)t * KVRANK + 16 * sb + 8 * (ln >> 5));
                    *(u32x4*)(WSP(bf16_t, WS_CKVB) + (size_t)bb * (CKVT_B / 2) + fo) = w; }
                  { const int kq = ln >> 4; u32x4 w = {0u, 0u, 0u, 0u};
                    if (kq < 2) { const bf16_t* p = nk + (size_t)(8 * kq) * KVRANK + 16 * sb + (ln & 15);
                        w.x = p[0] | ((unsigned)p[KVRANK] << 16); w.y = p[2 * KVRANK] | ((unsigned)p[3 * KVRANK] << 16); w.z = p[4 * KVRANK] | ((unsigned)p[5 * KVRANK] << 16); w.w = p[6 * KVRANK] | ((unsigned)p[7 * KVRANK] << 16); }
                    *(u32x4*)(ckvt_base(ws, bb) + fo) = w; } } }
        }
    }
    SEAM(2);
    if (IN(3)) {
        const int qx = bx & 7; unsigned* ctr = (unsigned*)(ws + WS_CTL) + 8192 + 1024 * a.li + 64 * qx;
        for (;;) {
            if (TIDX(wv) == 0) MISC[20] = __hip_atomic_fetch_add(ctr, 1u, __ATOMIC_RELAXED, __HIP_MEMORY_SCOPE_AGENT);
            __syncthreads();
            const int it = (int)MISC[20];
            __syncthreads();
            if (it >= 98) break;
            if (it >= 64) { const int blk = (it - 64) * 8 + qx; pool_window_block(blk, WSP(bf16_t, WS_Z), WSP(bf16_t, WS_SGP), AIN(I_PSCALE), WSP(bf16_t, WS_MIX), wv); }
            else if (it >= 8 && it < 40) { const int j = it - 8, sb = qx * 4 + (j >> 3), sh = j & 7;
                sattn::unit(sb, sh, WSP(bf16_t, WS_CKVB), WSP(bf16_t, WS_KRB), WSP(bf16_t, WS_CKVN), WSP(bf16_t, WS_KRN), ckvt_base(ws, sb), WSP(bf16_t, WS_WUKV), WSP(bf16_t, WS_QCAT), WSP(bf16_t, WS_SGM), WSP(bf16_t, WS_MIX), lds, scr, wv); }
            else { const int k = it < 8 ? it : it - 32, qb = 7 - (k >> 2), bh = qx * 4 + (k & 3);
                pattn::unit(bh >> 3, bh & 7, qb, WSP(bf16_t, WS_QCAT), WSP(bf16_t, WS_KCAT), WSP(bf16_t, WS_KRN), WSP(bf16_t, WS_V), WSP(bf16_t, WS_SGM), WSP(bf16_t, WS_MIX), lds, wv); }
        }
    }
    SEAM(3);
    if (IN(4)) {
        unsigned* pcnt = (unsigned*)(ws + WS_CTL) + 13312 + 2560 * a.li;
        pg8::EpiP45 E{ws, out};
        { pg8::SchedP45 S{(const char*)ws, pcnt, bx, G, 1}; pg8::gemm_phase(lds, scr, S, E, wv); }
        { pg8::SchedP45 S{(const char*)ws, pcnt, bx, G, 2}; pg8::gemm_phase(lds, scr, S, E, wv); }
    }
#undef IN
#undef SEAM
}

extern "C" void kernel_launch(void* const* d_in, const int* in_sizes, int n_in, void* d_out, int out_size, void* d_ws, size_t ws_size, hipStream_t stream) {
    static int grid = 0;
    if (grid == 0) {
        if (n_in != 24 || in_sizes[0] != MP * DM || out_size != 21164032 || ws_size < WS_END) {
            fprintf(stderr, "kernel_launch: shape mismatch: n_in %d in0 %d out %d ws %zu (need >= %zu)\n", n_in, n_in > 0 ? in_sizes[0] : -1, out_size, ws_size, (size_t)WS_END); grid = -1; return; }
        int dev = 0, cus = 0, per_cu = 0;
        if (hipGetDevice(&dev) != hipSuccess || hipDeviceGetAttribute(&cus, hipDeviceAttributeMultiprocessorCount, dev) != hipSuccess) { fprintf(stderr, "kernel_launch: device query failed\n"); grid = -1; return; }
        if (hipFuncSetAttribute((const void*)hymba_fwd, hipFuncAttributeMaxDynamicSharedMemorySize, LDS_BYTES) != hipSuccess) { fprintf(stderr, "kernel_launch: hipFuncSetAttribute failed\n"); grid = -1; return; }
        if (hipOccupancyMaxActiveBlocksPerMultiprocessor(&per_cu, (const void*)hymba_fwd, 512, LDS_BYTES) != hipSuccess || per_cu < 1)
            fprintf(stderr, "kernel_launch: note: occupancy query reports %d workgroups per CU\n", per_cu);
        (void)hipGetLastError();
        grid = cus;
    }
    if (grid < 0) return;
    if (hipMemsetAsync((char*)d_ws + WS_CTL, 0, CTL_ZERO_BYTES, stream) != hipSuccess) { fprintf(stderr, "kernel_launch: memset failed\n"); return; }
    Args a{};
    for (int i = 0; i < 24; ++i) a.in[i] = (const float*)d_in[i];
    a.out = (float*)d_out; a.ws = (unsigned char*)d_ws;
#if MK_N_LAUNCHES == 1
    a.ph_lo = 0; a.ph_hi = N_PHASES;
    hipLaunchKernelGGL(hymba_fwd, dim3(grid), dim3(512), LDS_BYTES, stream, a);
#else
    for (int p = 0; p < N_PHASES; ++p) { a.ph_lo = p; a.ph_hi = p + 1; hipLaunchKernelGGL(hymba_fwd, dim3(grid), dim3(512), LDS_BYTES, stream, a); }
#endif
    const hipError_t le = hipPeekAtLastError();
    if (le != hipSuccess) fprintf(stderr, "kernel_launch: launch failed: %s\n", hipGetErrorName(le));
}
```

```cpp
#include <hip/hip_runtime.h>
#include <hip/hip_bf16.h>
#include <cstdio>
#include <cstdint>

#ifndef DUP_PHASE
#define DUP_PHASE -1
#endif
#ifndef MK_N_LAUNCHES
#define MK_N_LAUNCHES 1
#endif

#define LAS __attribute__((address_space(3)))
#define GAS __attribute__((address_space(1)))
typedef unsigned short bf16_t;
typedef short bf16x8 __attribute__((ext_vector_type(8)));
typedef short s16x4 __attribute__((ext_vector_type(4)));
typedef float f32x4 __attribute__((ext_vector_type(4)));
typedef float f32x16 __attribute__((ext_vector_type(16)));
typedef unsigned u32x4 __attribute__((ext_vector_type(4)));
typedef unsigned u32x2 __attribute__((ext_vector_type(2)));
typedef float f32x2_t __attribute__((ext_vector_type(2)));
typedef __bf16 bf16x2_t __attribute__((ext_vector_type(2)));

constexpr int DM = 2048, NBATCH = 4, SEQ = 2048, DBATCH = 32, DSEQ = 16, PAST = 2048;
constexpr int MP = NBATCH * SEQ, MS = DBATCH * DSEQ, MT = MP + MS;
constexpr int DPOOL = 1024, NHEAD = 8, DNOPE = 128, DROPE = 64, DV = 128, QRANK = 512, KVRANK = 256, DPLE = 256;
constexpr int DQK = DNOPE + DROPE;
constexpr int DIN = 3904, DINP = 4096;
constexpr int SKV_S = PAST + DSEQ;
constexpr int POOLH = 15;
constexpr int MZ = 9216;
constexpr float EPS = 1e-6f;
constexpr float C2 = 0.07216878364870322f * 1.4426950408889634f;
constexpr size_t O_Y = 0, O_CKVP = 17825792, O_KRP = 19922944, O_POOLP = 20447232, O_CKVS = 20508672, O_KRS = 20639744, O_POOLS = 20672512;

constexpr size_t MiB = 1u << 20;
constexpr size_t WS_CTL = 0, CTL_ZERO_BYTES = 128 * 1024;
constexpr size_t WS_WIN = 1 * MiB;
constexpr size_t WS_WUQ = 17 * MiB;
constexpr size_t WS_WUKV = 18 * MiB + MiB / 2;
constexpr size_t WS_WPOOL = 19 * MiB + MiB / 2;
constexpr size_t WS_WOUT = 20 * MiB;
constexpr size_t WS_WGATE = 28 * MiB;
constexpr size_t WS_WPLE = 36 * MiB;
constexpr size_t WS_COS = 37 * MiB;
constexpr size_t WS_SIN = 37 * MiB + MiB / 2;
constexpr size_t WS_SSQCQ = 38 * MiB;
constexpr size_t WS_SSQH = 38 * MiB + MiB / 2;
constexpr size_t WS_CKVN = 39 * MiB;
constexpr size_t WS_KRN = 43 * MiB + MiB / 2;
constexpr size_t WS_PBF = 45 * MiB;
constexpr size_t WS_XN = 49 * MiB + MiB / 2;
constexpr size_t WS_CKVB = WS_XN;
constexpr size_t WS_KRB = 227 * MiB;
constexpr int CKVT_LD = 2080; constexpr size_t CKVT_B = (size_t)KVRANK * CKVT_LD * 2; constexpr int NBT_A = 20;
constexpr size_t WS_CKVT_A = 235 * MiB, WS_CKVT_B = WS_WIN;
constexpr int NB_EARLY = 0;
constexpr size_t WS_CKVB2 = WS_CKVT_A;
constexpr size_t WS_UBF = 83 * MiB + MiB / 2;
constexpr size_t WS_CQ = 101 * MiB + MiB / 2;
constexpr size_t WS_MIX = WS_UBF;
constexpr size_t WS_SGP = 117 * MiB + MiB / 2;
constexpr size_t WS_Z = 134 * MiB + MiB / 2;
constexpr size_t WS_PV = WS_SGP;
constexpr size_t WS_SGM = 152 * MiB + MiB / 2;
constexpr size_t WS_QCAT = 169 * MiB + MiB / 2;
constexpr size_t WS_KCAT = 195 * MiB;
constexpr size_t WS_HBF = WS_QCAT;
constexpr size_t WS_V = 211 * MiB;
constexpr size_t WS_END = 256 * MiB;
static_assert(WS_MIX + (size_t)MT * DM * 2 <= WS_SGP && WS_PV + (size_t)MT * DM * 2 <= WS_SGM && WS_HBF + (size_t)MT * DM * 2 <= WS_V && WS_END <= 256 * MiB, "d_ws map");
static_assert(WS_CKVB + (size_t)DBATCH * 1064960 <= WS_UBF && WS_KRB + (size_t)DBATCH * PAST * DROPE * 2 <= WS_CKVT_A && WS_CKVT_A + NBT_A * CKVT_B <= WS_END && (DBATCH - NBT_A) * CKVT_B <= 16 * MiB && WS_V + 16 * MiB <= WS_KRB, "d_ws map (cache copies)");

constexpr int RING_BYTES = 131072;
constexpr int SCR_OFF = RING_BYTES;
constexpr int SCR_BYTES = 16384;
constexpr int MISC_OFF = SCR_OFF + SCR_BYTES;
constexpr int LDS_BYTES = 151552;

#define LDS_WAIT() asm volatile("s_waitcnt lgkmcnt(0)" ::: "memory")
#define VM_WAIT() asm volatile("s_waitcnt vmcnt(0)" ::: "memory")
#define WG_BAR() do { asm volatile("s_waitcnt lgkmcnt(0)" ::: "memory"); __builtin_amdgcn_s_barrier(); asm volatile("" ::: "memory"); } while (0)
#define SBAR() __builtin_amdgcn_sched_barrier(0)
__device__ __forceinline__ unsigned cvtpk(float lo, float hi) { f32x2_t v = {lo, hi}; bf16x2_t b = __builtin_convertvector(v, bf16x2_t); return __builtin_bit_cast(unsigned, b); }
__device__ __forceinline__ u32x4 pack8(f32x4 a, f32x4 b) { u32x4 w; w.x = cvtpk(a[0], a[1]); w.y = cvtpk(a[2], a[3]); w.z = cvtpk(b[0], b[1]); w.w = cvtpk(b[2], b[3]); return w; }
typedef __amdgpu_buffer_rsrc_t rsrc_t;
__device__ __forceinline__ rsrc_t make_rsrc(const void* p, unsigned bytes) { return __builtin_amdgcn_make_buffer_rsrc(const_cast<void*>(p), 0, bytes, 0x00020000); }
__device__ __forceinline__ void st16_wt(rsrc_t r, unsigned byteoff, u32x4 v) { __builtin_amdgcn_raw_buffer_store_b128(v, r, byteoff, 0, 16); }
__device__ __forceinline__ void st16_wt(rsrc_t r, unsigned byteoff, f32x4 v) { __builtin_amdgcn_raw_buffer_store_b128(__builtin_bit_cast(u32x4, v), r, byteoff, 0, 16); }
__device__ __forceinline__ float bf2f(unsigned short h) { return __uint_as_float((unsigned)h << 16); }
__device__ __forceinline__ float silu_f(float v) { return v / (1.f + __expf(-v)); }
__device__ __forceinline__ float sigmoid_f(float v) { return 1.f / (1.f + __expf(-v)); }
__device__ __forceinline__ float wave_sum(float v) {
#pragma unroll
    for (int o = 1; o < 64; o <<= 1) v += __shfl_xor(v, o);
    return v;
}
__device__ __forceinline__ int lane_id() { int l; asm volatile("v_mbcnt_lo_u32_b32 %0, -1, 0\n\tv_mbcnt_hi_u32_b32 %0, -1, %0" : "=v"(l)); return l; }
#define TIDX(wv) (((wv) << 6) | lane_id())
__device__ __forceinline__ int row_pos(int row) { return row < MP ? (row & (SEQ - 1)) : PAST + ((row - MP) & (DSEQ - 1)); }

#define AS4 __attribute__((address_space(4)))
__device__ __forceinline__ const float* arg_in(int k) {
    const char AS4* p = (const char AS4*)__builtin_amdgcn_kernarg_segment_ptr(); int off = k * 8; asm volatile("" : "+s"(off));
    return *(const float* const AS4*)(p + off);
}
#define AIN(k) arg_in(k)

namespace pg8 {
constexpr int BM = 256, BK = 64, HALF = 128, HTB = HALF * BK * 2, STAGE_BYTES = 8 * HTB, NXCD = 8, WGM = 8;
__host__ __device__ __forceinline__ int lds_byte(int r, int c) { const int st = (r >> 4) * 2 + (c >> 5), rr = r & 15, cc = c & 31, ob = rr * 64 + cc * 2; return st * 1024 + (ob ^ (((ob >> 9) & 1) << 5)); }
__host__ __device__ __forceinline__ void stage_rc(int b, int& R, int& C) { const int st = b / 1024, sb = b % 1024, swz = sb ^ (((sb >> 9) & 1) << 5); R = (st >> 1) * 16 + swz / 64; C = (st & 1) * 32 + (swz % 64) / 2; }
__host__ __device__ __forceinline__ int perm32(int rho) { const int n = rho >> 4, i = rho & 15; return 8 * (i >> 2) + 4 * n + (i & 3); }

struct Unit { const char* A; const char* B; int lda, ldb, nt, type, row0, pn, half, slice, uid; };
__device__ __forceinline__ void grid_map(int L, int nM, int nN, int& pm, int& pn) {
    const int nwg = nM * nN; int wgid = L; { const int q = nwg / NXCD, r = nwg % NXCD, xcd = wgid % NXCD, off = wgid / NXCD; wgid = (xcd < r ? xcd * (q + 1) : r * (q + 1) + (xcd - r) * q) + off; }
    const int nig = WGM * nN, gid = wgid / nig, fm = gid * WGM, gsz = (nM - fm) < WGM ? (nM - fm) : WGM;
    pm = fm + ((wgid % nig) % gsz); pn = (wgid % nig) / gsz;
}

template <class Sched, class Epi>
__device__ __forceinline__ void gemm_phase(LAS unsigned char* lds, LAS unsigned char* scr, const Sched& S, const Epi& E, int wv) {
    const int wid = wv, lane = lane_id(), tid = (wv << 6) | lane, wr = wid >> 2, wc = wid & 3, fr = lane & 15, fq = lane >> 4;
    Unit cur, nxt; int ui = 0;
    if (!S.get(0, cur)) return;
    int RA[2], RB[2], CC[2];
#pragma unroll
    for (int i = 0; i < 2; ++i) { int R, C; stage_rc(tid * 16 + i * 8192, R, C); RA[i] = R * 2; RB[i] = ((R & ~31) + perm32(R & 31)) * 2; CC[i] = C * 2; }
    unsigned voffA[2], voffB[2], nvA[2], nvB[2];
#pragma unroll
    for (int i = 0; i < 2; ++i) { voffA[i] = (unsigned)(RA[i] * cur.lda + CC[i]); voffB[i] = (unsigned)(RB[i] * cur.ldb + CC[i]); }
    const size_t kstep = (size_t)(BK * 2);
    unsigned hA = cur.half ? 0u : (unsigned)(HALF * cur.lda * 2), hB = (unsigned)(HALF * cur.ldb * 2);
    const unsigned ldsw = (unsigned)wid * 1024u;
    const int aoff = lds_byte(wr * 64 + fr, fq * 8), boff = lds_byte(wc * 32 + fr, fq * 8);
#define PG8_SA(b, h) (((b) * 2 + (h)) * HTB)
#define PG8_SB(b, h) ((4 + (b) * 2 + (h)) * HTB)
#define PG8_STAGE(bufoff, gbase, voff) do { _Pragma("unroll") for (int _i = 0; _i < 2; ++_i) \
        __builtin_amdgcn_global_load_lds((const unsigned*)((const char*)(gbase) + (voff)[_i]), (LAS unsigned*)(lds + (bufoff) + ldsw + _i * 8192), 16, 0, 0); } while (0)
#define PG8_LDA(dst, b, h) do { _Pragma("unroll") for (int m = 0; m < 4; ++m) _Pragma("unroll") for (int k = 0; k < 2; ++k) dst[m][k] = *(const LAS bf16x8*)(lds + PG8_SA(b, h) + aoff + m * 2048 + k * 1024); } while (0)
#define PG8_LDB(dst, b, h) do { _Pragma("unroll") for (int n = 0; n < 2; ++n) _Pragma("unroll") for (int k = 0; k < 2; ++k) dst[n][k] = *(const LAS bf16x8*)(lds + PG8_SB(b, h) + boff + n * 2048 + k * 1024); } while (0)
#define PG8_MMA(ai, bj, At, Bt) do { __builtin_amdgcn_s_setprio(1); _Pragma("unroll") for (int m = 0; m < 4; ++m) _Pragma("unroll") for (int n = 0; n < 2; ++n) _Pragma("unroll") for (int k = 0; k < 2; ++k) \
        acc[ai][bj][m][n] = __builtin_amdgcn_mfma_f32_16x16x32_bf16(Bt[n][k], At[m][k], acc[ai][bj][m][n], 0, 0, 0); __builtin_amdgcn_s_setprio(0); } while (0)
#define PG8_WAIT_V(n) asm volatile("s_waitcnt vmcnt(" #n ")" ::: "memory")
#define PG8_WAIT_L(n) asm volatile("s_waitcnt lgkmcnt(" #n ")" ::: "memory")
#define PG8_BAR __builtin_amdgcn_s_barrier()
#define PG8_SCHED __builtin_amdgcn_sched_barrier(0)
    f32x4 acc[2][2][4][2];
    { int fr_e = fr, fq_e = fq; asm volatile("" : "+v"(fr_e), "+v"(fq_e)); E.init(acc, cur, wr, wc, fr_e, fq_e); }
    bf16x8 At[4][2], B0[2][2], B1[2][2];
    const char* cA = cur.A; const char* cB = cur.B;
    int rot = ((S.c & 7) * cur.nt) >> 3, nrot = 0;
    S.a_ready(cur, wid);
    { const size_t k0 = (size_t)rot * kstep, k1 = (size_t)((rot + 1) & (cur.nt - 1)) * kstep;
    PG8_STAGE(PG8_SB(0, 0), cB + k0, voffB); PG8_STAGE(PG8_SB(0, 1), cB + hB + k0, voffB); PG8_STAGE(PG8_SA(0, 0), cA + k0, voffA); PG8_STAGE(PG8_SA(0, 1), cA + hA + k0, voffA);
    if (wr == 1) PG8_BAR;
    PG8_WAIT_V(2); PG8_BAR;
    PG8_STAGE(PG8_SB(1, 0), cB + k1, voffB); PG8_STAGE(PG8_SA(1, 0), cA + k1, voffA); PG8_STAGE(PG8_SB(1, 1), cB + hB + k1, voffB); }
    PG8_WAIT_V(6); PG8_BAR;
    for (;;) {
        const bool has_next = S.get(ui + 1, nxt);
        if (!has_next) nxt = cur;
#pragma unroll
        for (int i = 0; i < 2; ++i) { nvA[i] = (unsigned)(RA[i] * nxt.lda + CC[i]); nvB[i] = (unsigned)(RB[i] * nxt.ldb + CC[i]); }
        const unsigned nhA = nxt.half ? 0u : (unsigned)(HALF * nxt.lda * 2), nhB = (unsigned)(HALF * nxt.ldb * 2);
        const char* nA = nxt.A; const char* nB = nxt.B; nrot = ((S.c & 7) * nxt.nt) >> 3; const int nmask = nxt.nt - 1;
        int nt = __builtin_amdgcn_readfirstlane(cur.nt); asm volatile("" : "+s"(nt));
        const bool full = !cur.half;
        for (int t = 0; t < nt; t += 2) {
            const bool last = (t == nt - 2);
            if (last && has_next) S.a_ready(nxt, wid);
            const size_t o1 = (size_t)((t + 1 + rot) & (nt - 1)) * kstep;
            const size_t o2 = (size_t)(last ? (nrot & nmask) : ((t + 2 + rot) & (nt - 1))) * kstep, o3 = (size_t)(last ? ((nrot + 1) & nmask) : ((t + 3 + rot) & (nt - 1))) * kstep;
            const char* a1 = cA + o1;
            const char* a2 = (last ? nA : cA) + o2; const char* b2 = (last ? nB : cB) + o2;
            const char* a3 = (last ? nA : cA) + o3; const char* b3 = (last ? nB : cB) + o3;
            const unsigned hA2 = last ? nhA : hA, hB2 = last ? nhB : hB;
            unsigned vA2[2], vB2[2];
#pragma unroll
            for (int i = 0; i < 2; ++i) { vA2[i] = last ? nvA[i] : voffA[i]; vB2[i] = last ? nvB[i] : voffB[i]; }
            PG8_LDB(B0, 0, 0); PG8_LDB(B1, 0, 1); PG8_SCHED; PG8_LDA(At, 0, 0); PG8_STAGE(PG8_SA(1, 1), a1 + hA, voffA);
            PG8_WAIT_V(8); PG8_WAIT_L(0); PG8_BAR; PG8_MMA(0, 0, At, B0); PG8_MMA(0, 1, At, B1); PG8_BAR; PG8_SCHED;
            if (full) PG8_LDA(At, 0, 1);
            PG8_STAGE(PG8_SB(0, 0), b2, vB2); PG8_STAGE(PG8_SB(0, 1), b2 + hB2, vB2); PG8_STAGE(PG8_SA(0, 0), a2, vA2);
            PG8_WAIT_V(8); PG8_WAIT_L(0); PG8_BAR; if (full) { PG8_MMA(1, 0, At, B0); PG8_MMA(1, 1, At, B1); } PG8_BAR; PG8_SCHED;
            PG8_LDB(B0, 1, 0); PG8_LDB(B1, 1, 1); PG8_SCHED; PG8_LDA(At, 1, 0); PG8_STAGE(PG8_SA(0, 1), a2 + hA2, vA2);
            PG8_WAIT_V(8); PG8_WAIT_L(0); PG8_BAR; PG8_MMA(0, 0, At, B0); PG8_MMA(0, 1, At, B1); PG8_BAR; PG8_SCHED;
            if (full) PG8_LDA(At, 1, 1);
            PG8_STAGE(PG8_SB(1, 0), b3, vB2); PG8_STAGE(PG8_SB(1, 1), b3 + hB2, vB2); PG8_STAGE(PG8_SA(1, 0), a3, vA2);
            PG8_WAIT_V(8); PG8_WAIT_L(0); PG8_BAR; if (full) { PG8_MMA(1, 0, At, B0); PG8_MMA(1, 1, At, B1); } PG8_BAR; PG8_SCHED;
        }
        if (wr == 0) PG8_BAR;
        bool run_epi = true;
        if constexpr (Sched::SPLITK) {
            if (cur.slice >= 0) {
                constexpr int NSLICE = 4; constexpr unsigned SLABB = HALF * BM * 4;
                float* sl = S.slab(cur); const rsrc_t rs = make_rsrc(sl, NSLICE * SLABB); const unsigned lo = (unsigned)(wid * 16 * 64 + lane) * 16u;
#pragma unroll
                for (int bj = 0; bj < 2; ++bj)
#pragma unroll
                    for (int m = 0; m < 4; ++m)
#pragma unroll
                        for (int n = 0; n < 2; ++n) st16_wt(rs, (unsigned)cur.slice * SLABB + lo + (unsigned)(bj * 8 + m * 2 + n) * 1024u, acc[0][bj][m][n]);
                asm volatile("s_waitcnt vmcnt(0)" ::: "memory");
                PG8_BAR; asm volatile("" ::: "memory");
                volatile LAS unsigned* TK = (volatile LAS unsigned*)(lds + MISC_OFF) + 27;
                if (wid == 0 && lane == 0) { const unsigned old = __hip_atomic_fetch_add(S.ticket(cur), 1u, __ATOMIC_RELAXED, __HIP_MEMORY_SCOPE_AGENT);
                    if (old == NSLICE - 1) { __builtin_amdgcn_fence(__ATOMIC_ACQUIRE, "agent"); asm volatile("s_waitcnt vmcnt(0)" ::: "memory"); }
                    *TK = old; }
                asm volatile("s_waitcnt lgkmcnt(0)" ::: "memory"); PG8_BAR; asm volatile("" ::: "memory");
                run_epi = (*TK == NSLICE - 1);
                if (run_epi) {
#pragma unroll
                    for (int sp = 0; sp < NSLICE; ++sp) if (sp != cur.slice) { const char* ob = (const char*)sl + (size_t)sp * SLABB + lo;
#pragma unroll
                        for (int bj = 0; bj < 2; ++bj)
#pragma unroll
                            for (int m = 0; m < 4; ++m)
#pragma unroll
                                for (int n = 0; n < 2; ++n) acc[0][bj][m][n] += *(const f32x4*)(ob + (bj * 8 + m * 2 + n) * 1024); }
                }
                asm volatile("s_waitcnt lgkmcnt(0)" ::: "memory"); PG8_BAR; asm volatile("" ::: "memory");
            }
        }
        if (run_epi) {
        { int fr_e = fr, fq_e = fq; asm volatile("" : "+v"(fr_e), "+v"(fq_e));
          E(acc, cur, wr, wc, fr_e, fq_e, scr); }
        S.done(cur, wid);
        }
        if (!has_next) break;
        { int fr_e = fr, fq_e = fq; asm volatile("" : "+v"(fr_e), "+v"(fq_e)); E.init(acc, nxt, wr, wc, fr_e, fq_e); }
        cur = nxt; cA = nA; cB = nB; hA = nhA; hB = nhB; rot = nrot; ++ui;
#pragma unroll
        for (int i = 0; i < 2; ++i) { voffA[i] = nvA[i]; voffB[i] = nvB[i]; }
        if (wr == 1) PG8_BAR;
    }
    PG8_WAIT_V(0);
    PG8_BAR;
#undef PG8_SA
#undef PG8_SB
#undef PG8_STAGE
#undef PG8_LDA
#undef PG8_LDB
#undef PG8_MMA
#undef PG8_WAIT_V
#undef PG8_WAIT_L
#undef PG8_BAR
#undef PG8_SCHED
}

typedef f32x4 Acc[2][2][4][2];
__device__ __forceinline__ void acc_zero(Acc& acc) {
#pragma unroll
    for (int a = 0; a < 2; ++a)
#pragma unroll
        for (int b = 0; b < 2; ++b)
#pragma unroll
            for (int m = 0; m < 4; ++m)
#pragma unroll
                for (int n = 0; n < 2; ++n) acc[a][b][m][n] = (f32x4){0.f, 0.f, 0.f, 0.f};
}
#define EPI_INIT_ZERO __device__ __forceinline__ void init(Acc& acc, const Unit&, int, int, int, int) const { acc_zero(acc); }
template <int NG>
__device__ __forceinline__ void xwave_rowsum(float (&p)[NG][2][4], LAS unsigned char* scr, int wr, int wc, int fr, int fq) {
    LAS float* red = (LAS float*)scr;
    if (fq == 0) {
#pragma unroll
        for (int gq = 0; gq < NG; ++gq)
#pragma unroll
            for (int ai = 0; ai < 2; ++ai)
#pragma unroll
                for (int m = 0; m < 4; ++m) red[gq * 1024 + (ai * HALF + wr * 64 + m * 16 + fr) * 4 + wc] = p[gq][ai][m];
    }
    WG_BAR();
#pragma unroll
    for (int gq = 0; gq < NG; ++gq)
#pragma unroll
        for (int ai = 0; ai < 2; ++ai)
#pragma unroll
            for (int m = 0; m < 4; ++m) { const f32x4 v = *(const LAS f32x4*)(red + gq * 1024 + (ai * HALF + wr * 64 + m * 16 + fr) * 4); p[gq][ai][m] = (v[0] + v[1]) + (v[2] + v[3]); }
    WG_BAR();
}
__device__ __forceinline__ float sq4(f32x4 v) { return (v[0] * v[0] + v[1] * v[1]) + (v[2] * v[2] + v[3] * v[3]); }
__device__ __forceinline__ float fq_sum(float s) { s += __shfl_xor(s, 16); s += __shfl_xor(s, 32); return s; }

struct EpiBf16 {
    EPI_INIT_ZERO
    bf16_t* O; int ldc; int wt;
    __device__ __forceinline__ void operator()(Acc& acc, const Unit& u, int wr, int wc, int fr, int fq, LAS unsigned char*) const {
        const int row0 = u.row0 + wr * 64 + fr, col0 = u.pn * BM + wc * 32 + 8 * fq;
        if (wt) { const rsrc_t rO = make_rsrc(O, (unsigned)MT * DM * 2);
#pragma unroll
            for (int ai = 0; ai < 2; ++ai) if (ai == 0 || !u.half)
#pragma unroll
                for (int m = 0; m < 4; ++m) { const unsigned off = (unsigned)((row0 + ai * HALF + m * 16) * ldc + col0) * 2u;
#pragma unroll
                    for (int bj = 0; bj < 2; ++bj) st16_wt(rO, off + bj * HALF * 2, pack8(acc[ai][bj][m][0], acc[ai][bj][m][1])); }
            return; }
#pragma unroll
        for (int ai = 0; ai < 2; ++ai) if (ai == 0 || !u.half)
#pragma unroll
            for (int m = 0; m < 4; ++m) { bf16_t* rp = O + (size_t)(row0 + ai * HALF + m * 16) * ldc + col0;
#pragma unroll
                for (int bj = 0; bj < 2; ++bj) *(u32x4*)(rp + bj * HALF) = pack8(acc[ai][bj][m][0], acc[ai][bj][m][1]); }
    }
};

struct EpiInProj {
    EPI_INIT_ZERO
    unsigned char* ws; float* out;
    __device__ __forceinline__ void operator()(Acc& acc, const Unit& u, int wr, int wc, int fr, int fq, LAS unsigned char* scr) const {
        const float* kvg = arg_in(11); const float* krg = arg_in(16);
        bf16_t* UBF = (bf16_t*)(ws + WS_UBF); bf16_t* SGP = (bf16_t*)(ws + WS_SGP); bf16_t* CQ = (bf16_t*)(ws + WS_CQ); bf16_t* CKVN = (bf16_t*)(ws + WS_CKVN); bf16_t* SGM = (bf16_t*)(ws + WS_SGM); bf16_t* KRN = (bf16_t*)(ws + WS_KRN);
        float* SSQCQ = (float*)(ws + WS_SSQCQ); const float* COS = (const float*)(ws + WS_COS); const float* SIN = (const float*)(ws + WS_SIN);
        const int row0 = u.row0 + wr * 64 + fr, cl = wc * 32 + 8 * fq, pn = u.pn;
        if (pn < 4) {
            const bool tail = (((u.row0 >> 8) & 7) == 7) || (u.row0 >= MP);
#pragma unroll
            for (int ai = 0; ai < 2; ++ai) if (ai == 0 || !u.half)
#pragma unroll
                for (int m = 0; m < 4; ++m) { const int row = row0 + ai * HALF + m * 16; bf16_t* rp = UBF + (size_t)row * DPOOL + pn * BM + cl;
#pragma unroll
                    for (int bj = 0; bj < 2; ++bj) *(u32x4*)(rp + bj * HALF) = pack8(acc[ai][bj][m][0], acc[ai][bj][m][1]);
                    if (tail) { float* dst = nullptr;
                        if (row < MP) { const int t = row & (SEQ - 1), b = row >> 11; if (t >= SEQ - POOLH) dst = out + O_POOLP + (size_t)(b * POOLH + t - (SEQ - POOLH)) * DPOOL; }
                        else { const int s = row - MP, b = s >> 4, t = s & 15; if (t >= 1) dst = out + O_POOLS + (size_t)(b * POOLH + t - 1) * DPOOL; }
                        if (dst) { dst += pn * BM + cl;
#pragma unroll
                            for (int bj = 0; bj < 2; ++bj) { *(f32x4*)(dst + bj * HALF) = acc[ai][bj][m][0]; *(f32x4*)(dst + bj * HALF + 4) = acc[ai][bj][m][1]; } } } }
        } else if (pn < 8 || (pn >= 11 && pn < 15)) {
            bf16_t* G0 = pn < 8 ? SGP + (pn - 4) * BM : SGM + (pn - 11) * BM;
#pragma unroll
            for (int ai = 0; ai < 2; ++ai) if (ai == 0 || !u.half)
#pragma unroll
                for (int m = 0; m < 4; ++m) { bf16_t* rp = G0 + (size_t)(row0 + ai * HALF + m * 16) * 1024 + cl;
#pragma unroll
                    for (int bj = 0; bj < 2; ++bj) { f32x4 a = acc[ai][bj][m][0], b = acc[ai][bj][m][1];
#pragma unroll
                        for (int j = 0; j < 4; ++j) { a[j] = silu_f(a[j]); b[j] = silu_f(b[j]); }
                        *(u32x4*)(rp + bj * HALF) = pack8(a, b); } }
        } else if (pn < 10) {
#pragma unroll
            for (int ai = 0; ai < 2; ++ai) if (ai == 0 || !u.half)
#pragma unroll
                for (int m = 0; m < 4; ++m) { const int row = row0 + ai * HALF + m * 16; bf16_t* rp = CQ + (size_t)row * QRANK + (pn - 8) * BM + cl; float s = 0.f;
#pragma unroll
                    for (int bj = 0; bj < 2; ++bj) { *(u32x4*)(rp + bj * HALF) = pack8(acc[ai][bj][m][0], acc[ai][bj][m][1]); s += sq4(acc[ai][bj][m][0]) + sq4(acc[ai][bj][m][1]); }
                    s = fq_sum(s);
                    if (fq == 0) SSQCQ[(size_t)row * 8 + (pn - 8) * 4 + wc] = s; }
        } else if (pn == 10) {
            float p[1][2][4];
#pragma unroll
            for (int ai = 0; ai < 2; ++ai) if (ai == 0 || !u.half)
#pragma unroll
                for (int m = 0; m < 4; ++m) { float s = 0.f;
#pragma unroll
                    for (int bj = 0; bj < 2; ++bj) s += sq4(acc[ai][bj][m][0]) + sq4(acc[ai][bj][m][1]);
                    p[0][ai][m] = fq_sum(s); }
            xwave_rowsum<1>(p, scr, wr, wc, fr, fq);
            f32x4 gv[2][2];
#pragma unroll
            for (int bj = 0; bj < 2; ++bj) { gv[bj][0] = *(const f32x4*)(kvg + bj * HALF + cl); gv[bj][1] = *(const f32x4*)(kvg + bj * HALF + cl + 4); }
#pragma unroll
            for (int ai = 0; ai < 2; ++ai) if (ai == 0 || !u.half)
#pragma unroll
                for (int m = 0; m < 4; ++m) { const int row = row0 + ai * HALF + m * 16; const float r = 1.0f / sqrtf(p[0][ai][m] * (1.f / KVRANK) + EPS);
                    float* dst = (row < MP ? out + O_CKVP + (size_t)row * KVRANK : out + O_CKVS + (size_t)(row - MP) * KVRANK) + cl; bf16_t* rp = CKVN + (size_t)row * KVRANK + cl;
#pragma unroll
                    for (int bj = 0; bj < 2; ++bj) { const f32x4 a = acc[ai][bj][m][0] * r * gv[bj][0], b = acc[ai][bj][m][1] * r * gv[bj][1];
                        *(f32x4*)(dst + bj * HALF) = a; *(f32x4*)(dst + bj * HALF + 4) = b; *(u32x4*)(rp + bj * HALF) = pack8(a, b); } }
        } else {
            if (wc == 0) {
                f32x4 g1[2], g2[2];
#pragma unroll
                for (int n = 0; n < 2; ++n) { g1[n] = *(const f32x4*)(krg + 8 * fq + 4 * n); g2[n] = *(const f32x4*)(krg + 32 + 8 * fq + 4 * n); }
#pragma unroll
                for (int ai = 0; ai < 2; ++ai) if (ai == 0 || !u.half)
#pragma unroll
                    for (int m = 0; m < 4; ++m) { const int row = row0 + ai * HALF + m * 16; float s = 0.f;
#pragma unroll
                        for (int n = 0; n < 2; ++n) s += sq4(acc[ai][0][m][n]) + sq4(acc[ai][1][m][n]);
                        s = fq_sum(s); const float r = 1.0f / sqrtf(s * (1.f / DROPE) + EPS); const int pos = row_pos(row);
                        float* dst = (row < MP ? out + O_KRP + (size_t)row * DROPE : out + O_KRS + (size_t)(row - MP) * DROPE) + 8 * fq; bf16_t* rp = KRN + (size_t)row * DROPE + 8 * fq;
                        f32x4 o1[2], o2[2];
#pragma unroll
                        for (int n = 0; n < 2; ++n) { const f32x4 cs = *(const f32x4*)(COS + pos * 32 + 8 * fq + 4 * n), sn = *(const f32x4*)(SIN + pos * 32 + 8 * fq + 4 * n);
                            const f32x4 y1 = acc[ai][0][m][n] * r * g1[n], y2 = acc[ai][1][m][n] * r * g2[n]; o1[n] = y1 * cs - y2 * sn; o2[n] = y2 * cs + y1 * sn; }
                        *(f32x4*)(dst) = o1[0]; *(f32x4*)(dst + 4) = o1[1]; *(f32x4*)(dst + 32) = o2[0]; *(f32x4*)(dst + 36) = o2[1];
                        *(u32x4*)(rp) = pack8(o1[0], o1[1]); *(u32x4*)(rp + 32) = pack8(o2[0], o2[1]); }
            }
        }
    }
};

struct EpiQ {
    EPI_INIT_ZERO
    unsigned char* ws; const float* gqn; const float* gkn; const float* gqr;
    __device__ __forceinline__ void operator()(Acc& acc, const Unit& u, int wr, int wc, int fr, int fq, LAS unsigned char* scr) const {
        bf16_t* QCAT = (bf16_t*)(ws + WS_QCAT); const float* SSQCQ = (const float*)(ws + WS_SSQCQ); const float* COS = (const float*)(ws + WS_COS); const float* SIN = (const float*)(ws + WS_SIN);
        const int row0 = u.row0 + wr * 64 + fr, pn = u.pn;
#pragma unroll
        for (int ai = 0; ai < 2; ++ai) if (ai == 0 || !u.half)
#pragma unroll
            for (int m = 0; m < 4; ++m) { const int row = row0 + ai * HALF + m * 16; const f32x4 a = *(const f32x4*)(SSQCQ + (size_t)row * 8), b = *(const f32x4*)(SSQCQ + (size_t)row * 8 + 4);
                const float rq = 1.0f / sqrtf((((a[0] + a[1]) + (a[2] + a[3])) + ((b[0] + b[1]) + (b[2] + b[3]))) * (1.f / QRANK) + EPS);
#pragma unroll
                for (int bj = 0; bj < 2; ++bj)
#pragma unroll
                    for (int n = 0; n < 2; ++n) acc[ai][bj][m][n] *= rq;
                if (m & 1) asm volatile("" ::: "memory"); }
        if (pn < 4) {
            float p[2][2][4];
#pragma unroll
            for (int bj = 0; bj < 2; ++bj)
#pragma unroll
                for (int ai = 0; ai < 2; ++ai) if (ai == 0 || !u.half)
#pragma unroll
                    for (int m = 0; m < 4; ++m) p[bj][ai][m] = fq_sum(sq4(acc[ai][bj][m][0]) + sq4(acc[ai][bj][m][1]));
            xwave_rowsum<2>(p, scr, wr, wc, fr, fq);
            const int d0 = wc * 32 + 8 * fq; f32x4 gg[2];
#pragma unroll
            for (int n = 0; n < 2; ++n) gg[n] = *(const f32x4*)(gqn + d0 + 4 * n) * *(const f32x4*)(gkn + d0 + 4 * n) * C2;
#pragma unroll
            for (int ai = 0; ai < 2; ++ai) if (ai == 0 || !u.half)
#pragma unroll
                for (int m = 0; m < 4; ++m) { const int row = row0 + ai * HALF + m * 16;
#pragma unroll
                    for (int bj = 0; bj < 2; ++bj) { const float rn = 1.0f / sqrtf(p[bj][ai][m] * (1.f / DNOPE) + EPS);
                        *(u32x4*)(QCAT + (size_t)row * (NHEAD * DQK) + (2 * pn + bj) * DQK + d0) = pack8(acc[ai][bj][m][0] * rn * gg[0], acc[ai][bj][m][1] * rn * gg[1]); } }
        } else {
            const int hd = 4 * (pn - 4) + wc; f32x4 g1[2], g2[2];
#pragma unroll
            for (int n = 0; n < 2; ++n) { g1[n] = *(const f32x4*)(gqr + 8 * fq + 4 * n) * C2; g2[n] = *(const f32x4*)(gqr + 32 + 8 * fq + 4 * n) * C2; }
#pragma unroll
            for (int ai = 0; ai < 2; ++ai) if (ai == 0 || !u.half)
#pragma unroll
                for (int m = 0; m < 4; ++m) { const int row = row0 + ai * HALF + m * 16; float s = 0.f;
#pragma unroll
                    for (int n = 0; n < 2; ++n) s += sq4(acc[ai][0][m][n]) + sq4(acc[ai][1][m][n]);
                    s = fq_sum(s); const float r = 1.0f / sqrtf(s * (1.f / DROPE) + EPS); const int pos = row_pos(row);
                    f32x4 o1[2], o2[2];
#pragma unroll
                    for (int n = 0; n < 2; ++n) { const f32x4 cs = *(const f32x4*)(COS + pos * 32 + 8 * fq + 4 * n), sn = *(const f32x4*)(SIN + pos * 32 + 8 * fq + 4 * n);
                        const f32x4 y1 = acc[ai][0][m][n] * r * g1[n], y2 = acc[ai][1][m][n] * r * g2[n]; o1[n] = y1 * cs - y2 * sn; o2[n] = y2 * cs + y1 * sn; }
                    bf16_t* rp = QCAT + (size_t)row * (NHEAD * DQK) + hd * DQK + DNOPE + 8 * fq;
                    *(u32x4*)(rp) = pack8(o1[0], o1[1]); *(u32x4*)(rp + 32) = pack8(o2[0], o2[1]); }
        }
    }
};

struct EpiKV {
    EPI_INIT_ZERO
    unsigned char* ws;
    __device__ __forceinline__ void operator()(Acc& acc, const Unit& u, int wr, int wc, int fr, int fq, LAS unsigned char* scr) const {
        bf16_t* KCAT = (bf16_t*)(ws + WS_KCAT); bf16_t* V = (bf16_t*)(ws + WS_V);
        const int row0 = u.row0 + wr * 64 + fr, d0 = wc * 32 + 8 * fq, hd = u.pn;
        float p[1][2][4];
#pragma unroll
        for (int ai = 0; ai < 2; ++ai) if (ai == 0 || !u.half)
#pragma unroll
            for (int m = 0; m < 4; ++m) p[0][ai][m] = fq_sum(sq4(acc[ai][0][m][0]) + sq4(acc[ai][0][m][1]));
        xwave_rowsum<1>(p, scr, wr, wc, fr, fq);
#pragma unroll
        for (int ai = 0; ai < 2; ++ai) if (ai == 0 || !u.half)
#pragma unroll
            for (int m = 0; m < 4; ++m) { const int row = row0 + ai * HALF + m * 16; const float rk = 1.0f / sqrtf(p[0][ai][m] * (1.f / DNOPE) + EPS);
                *(u32x4*)(KCAT + (size_t)row * (NHEAD * DNOPE) + hd * DNOPE + d0) = pack8(acc[ai][0][m][0] * rk, acc[ai][0][m][1] * rk);
                *(u32x4*)(V + (size_t)row * (NHEAD * DV) + hd * DV + d0) = pack8(acc[ai][1][m][0], acc[ai][1][m][1]); }
    }
};

struct EpiOut {
    const float* xp; const float* xs; float* Y; unsigned char* ws;
    __device__ __forceinline__ void init(Acc& acc, const Unit& u, int wr, int wc, int fr, int fq) const {
        const int row0 = u.row0 + wr * 64 + fr, col0 = u.pn * BM + wc * 32 + 8 * fq;
#pragma unroll
        for (int ai = 0; ai < 2; ++ai)
#pragma unroll
            for (int m = 0; m < 4; ++m) { const int row = row0 + ai * HALF + m * 16; const float* xr = (row < MP ? xp + (size_t)row * DM : xs + (size_t)(row - MP) * DM) + col0;
#pragma unroll
                for (int bj = 0; bj < 2; ++bj) { if (ai == 0 || !u.half) { acc[ai][bj][m][0] = *(const f32x4*)(xr + bj * HALF); acc[ai][bj][m][1] = *(const f32x4*)(xr + bj * HALF + 4); }
                                                 else { acc[ai][bj][m][0] = (f32x4){0.f, 0.f, 0.f, 0.f}; acc[ai][bj][m][1] = (f32x4){0.f, 0.f, 0.f, 0.f}; } } }
    }
    __device__ __forceinline__ void operator()(Acc& acc, const Unit& u, int wr, int wc, int fr, int fq, LAS unsigned char* scr) const {
        float* SSQH = (float*)(ws + WS_SSQH); const rsrc_t rH = make_rsrc(ws + WS_HBF, (unsigned)MT * DM * 2);
        const int row0 = u.row0 + wr * 64 + fr, col0 = u.pn * BM + wc * 32 + 8 * fq;
        float p[1][2][4];
#pragma unroll
        for (int ai = 0; ai < 2; ++ai) if (ai == 0 || !u.half)
#pragma unroll
            for (int m = 0; m < 4; ++m) { const int row = row0 + ai * HALF + m * 16; float s = 0.f;
#pragma unroll
                for (int bj = 0; bj < 2; ++bj) { const f32x4 a = acc[ai][bj][m][0], b = acc[ai][bj][m][1];
                    const unsigned eo = (unsigned)(row * DM + col0 + bj * HALF);
                    st16_wt(rH, eo * 2u, pack8(a, b)); s += sq4(a) + sq4(b); }
                p[0][ai][m] = fq_sum(s); }
        xwave_rowsum<1>(p, scr, wr, wc, fr, fq);
        if (wc == 0 && fq == 0) {
#pragma unroll
            for (int ai = 0; ai < 2; ++ai) if (ai == 0 || !u.half)
#pragma unroll
                for (int m = 0; m < 4; ++m) __hip_atomic_store(SSQH + (size_t)(row0 + ai * HALF + m * 16) * 8 + u.pn, p[0][ai][m], __ATOMIC_RELAXED, __HIP_MEMORY_SCOPE_AGENT);
        }
    }
};

struct EpiGate {
    EPI_INIT_ZERO
    float* Y; unsigned char* ws; const float* bias;
    __device__ __forceinline__ void operator()(Acc& acc, const Unit& u, int wr, int wc, int fr, int fq, LAS unsigned char*) const {
        const bf16_t* PV = (const bf16_t*)(ws + WS_PV); const bf16_t* HB = (const bf16_t*)(ws + WS_HBF); const float* SSQH = (const float*)(ws + WS_SSQH);
        const int row0 = u.row0 + wr * 64 + fr, col0 = u.pn * BM + wc * 32 + 8 * fq;
        f32x4 bv[2][2];
#pragma unroll
        for (int bj = 0; bj < 2; ++bj) { bv[bj][0] = *(const f32x4*)(bias + col0 + bj * HALF); bv[bj][1] = *(const f32x4*)(bias + col0 + bj * HALF + 4); }
#pragma unroll
        for (int ai = 0; ai < 2; ++ai) if (ai == 0 || !u.half)
#pragma unroll
            for (int m = 0; m < 4; ++m) { const int row = row0 + ai * HALF + m * 16; const f32x4 sa = *(const f32x4*)(SSQH + (size_t)row * 8), sb = *(const f32x4*)(SSQH + (size_t)row * 8 + 4);
                const float rh = 1.0f / sqrtf((((sa[0] + sa[1]) + (sa[2] + sa[3])) + ((sb[0] + sb[1]) + (sb[2] + sb[3]))) * (1.f / DM) + EPS);
#pragma unroll
                for (int bj = 0; bj < 2; ++bj) { float* yp = Y + (size_t)row * DM + col0 + bj * HALF; const u32x4 pw = *(const u32x4*)(PV + (size_t)row * DM + col0 + bj * HALF);
                    const u32x4 hw = *(const u32x4*)(HB + (size_t)row * DM + col0 + bj * HALF);
                    f32x4 h0 = {__uint_as_float(hw.x << 16), __uint_as_float(hw.x & 0xffff0000u), __uint_as_float(hw.y << 16), __uint_as_float(hw.y & 0xffff0000u)};
                    f32x4 h1 = {__uint_as_float(hw.z << 16), __uint_as_float(hw.z & 0xffff0000u), __uint_as_float(hw.w << 16), __uint_as_float(hw.w & 0xffff0000u)}; const f32x4 g0 = acc[ai][bj][m][0] * rh + bv[bj][0], g1 = acc[ai][bj][m][1] * rh + bv[bj][1];
                    h0[0] += sigmoid_f(g0[0]) * __uint_as_float(pw.x << 16); h0[1] += sigmoid_f(g0[1]) * __uint_as_float(pw.x & 0xffff0000u);
                    h0[2] += sigmoid_f(g0[2]) * __uint_as_float(pw.y << 16); h0[3] += sigmoid_f(g0[3]) * __uint_as_float(pw.y & 0xffff0000u);
                    h1[0] += sigmoid_f(g1[0]) * __uint_as_float(pw.z << 16); h1[1] += sigmoid_f(g1[1]) * __uint_as_float(pw.z & 0xffff0000u);
                    h1[2] += sigmoid_f(g1[2]) * __uint_as_float(pw.w << 16); h1[3] += sigmoid_f(g1[3]) * __uint_as_float(pw.w & 0xffff0000u);
                    *(f32x4*)yp = h0; *(f32x4*)(yp + 4) = h1; }
                if (m & 1) asm volatile("" ::: "memory"); }
    }
};

struct SchedP1 { const char* ws; int c, G;
    static constexpr bool SPLITK = false;
    __device__ __forceinline__ float* slab(const Unit&) const { return nullptr; }
    __device__ __forceinline__ unsigned* ticket(const Unit&) const { return nullptr; }
    __device__ __forceinline__ void a_ready(const Unit&, int) const {}
    __device__ __forceinline__ void done(const Unit&, int) const {}
    __device__ __forceinline__ bool get(int i, Unit& u) const {
        constexpr int NF = 32 * 16, NH = 4 * 16; int nf = (NF - c + G - 1) / G; nf = nf < 0 ? 0 : nf;
        u.lda = DM; u.ldb = DM; u.nt = DM / BK; u.type = 0; u.slice = -1; u.uid = 0;
        if (i < nf) { int pm, pn; grid_map(c + i * G, 32, 16, pm, pn); u.row0 = pm * BM; u.pn = pn; u.half = 0; }
        else { const int t = c + (i - nf) * G; if (t >= NH) return false; u.row0 = MP + (t >> 4) * HALF; u.pn = t & 15; u.half = 1; }
        u.A = ws + WS_XN + (size_t)u.row0 * DM * 2; u.B = ws + WS_WIN + (size_t)u.pn * BM * DM * 2; return true; }
};
struct SchedP2 { const char* ws; int c, G;
    static constexpr bool SPLITK = false;
    __device__ __forceinline__ float* slab(const Unit&) const { return nullptr; }
    __device__ __forceinline__ unsigned* ticket(const Unit&) const { return nullptr; }
    __device__ __forceinline__ void a_ready(const Unit&, int) const {}
    __device__ __forceinline__ void done(const Unit&, int) const {}
    __device__ __forceinline__ bool get(int i, Unit& u) const {
        int L = c + i * G, pm, pn; u.half = 0; u.slice = -1; u.uid = 0;
        if (L < 204) { grid_map(L, 34, 6, pm, pn); u.type = 0; u.lda = QRANK; u.ldb = QRANK; u.nt = QRANK / BK; u.row0 = pm * BM; u.pn = pn;
            u.A = ws + WS_CQ + (size_t)u.row0 * QRANK * 2; u.B = ws + WS_WUQ + (size_t)pn * BM * QRANK * 2; return true; }
        L -= 204;
        if (L < 256) { grid_map(L, 32, 8, pm, pn); u.type = 1; u.lda = KVRANK; u.ldb = KVRANK; u.nt = KVRANK / BK; u.row0 = pm * BM; u.pn = pn;
            u.A = ws + WS_CKVN + (size_t)u.row0 * KVRANK * 2; u.B = ws + WS_WUKV + (size_t)pn * BM * KVRANK * 2; return true; }
        L -= 256;
        if (L < 144) { grid_map(L, 36, 4, pm, pn); u.type = 2; u.lda = DPOOL; u.ldb = 256; u.nt = 4; u.row0 = pm * BM; u.pn = pn;
            u.A = ws + WS_UBF + ((size_t)u.row0 * DPOOL + pn * 256) * 2; u.B = ws + WS_WPOOL + (size_t)pn * BM * 256 * 2; return true; }
        return false; }
};
struct EpiP2 { unsigned char* ws;
    EPI_INIT_ZERO
    __device__ __forceinline__ void operator()(Acc& acc, const Unit& u, int wr, int wc, int fr, int fq, LAS unsigned char* scr) const {
        if (u.type == 0) { const EpiQ q{ws, arg_in(13), arg_in(15), arg_in(14)}; q(acc, u, wr, wc, fr, fq, scr); }
        else if (u.type == 1) { const EpiKV kv{ws}; kv(acc, u, wr, wc, fr, fq, scr); }
        else { const EpiBf16 z{(bf16_t*)(ws + WS_Z), DPOOL, 0}; z(acc, u, wr, wc, fr, fq, scr); } }
};

struct SchedP45 { const char* ws; unsigned* cnt; int c, G, stream;
    static constexpr bool SPLITK = true;
    __device__ __forceinline__ bool warm(const Unit&) const { return false; }
    __device__ __forceinline__ int panel_of(const Unit& u) const { return u.row0 < MP ? (u.row0 >> 8) : 32 + ((u.row0 - MP) >> 7); }
    __device__ __forceinline__ float* slab(const Unit& u) const { return (float*)(ws + (u.type == 0 ? WS_SGM : WS_V)) + (size_t)u.uid * (4 * HALF * BM); }
    __device__ __forceinline__ unsigned* ticket(const Unit& u) const { return cnt + 64 * ((u.type == 0 ? 38 : 70) + u.uid); }
    __device__ __forceinline__ bool get(int i, Unit& u) const {
        constexpr int NF = 32 * 8, NS = 32 * 4, NH = 32; int pm = 0, pn = 0, type, row0, half = 0, slice = -1, uid = 0; bool ok = true;
        int nf = (NF - c + G - 1) / G; nf = nf < 0 ? 0 : nf; int ns = (NS - c + G - 1) / G; ns = ns < 0 ? 0 : ns;
        const int c2 = (c + G - (128 % G)) % G; int ns2 = (NS - c2 + G - 1) / G; ns2 = ns2 < 0 ? 0 : ns2;
        if (stream == 1) {
            if (i < 2 * nf) { grid_map(c + (i >> 1) * G, 32, 8, pm, pn); type = (i & 1) ? 1 : 0; row0 = pm * BM; }
            else if (i - 2 * nf < ns) { const int j = c + (i - 2 * nf) * G; type = 0; uid = j >> 2; slice = j & 3; row0 = MP + (uid >> 3) * HALF; pn = uid & 7; half = 1; }
            else { const int t = c2 + (i - 2 * nf - ns) * G; ok = t < NH; type = 1; row0 = MP + ((t >> 3) & 3) * HALF; pn = t & 7; half = 1; }
        } else {
            type = 2;
            if (i < nf) { grid_map(c + i * G, 32, 8, pm, pn); row0 = pm * BM; }
            else { const int j = c2 + (i - nf) * G; ok = j < NS; uid = (j >> 2) & 31; slice = j & 3; row0 = MP + (uid >> 3) * HALF; pn = uid & 7; half = 1; }
        }
        const bool ple = type == 1; const int ld = ple ? DPLE : DM; const int nt = slice >= 0 ? 8 : ld / BK; const size_t koff = slice >= 0 ? (size_t)slice * 8 * BK * 2 : 0;
        u.type = type; u.row0 = row0; u.pn = pn; u.half = half; u.slice = slice; u.uid = uid; u.lda = ld; u.ldb = ld; u.nt = nt;
        u.A = ws + (ple ? WS_PBF : (type == 0 ? WS_MIX : WS_HBF)) + (size_t)row0 * ld * 2 + koff;
        u.B = ws + (ple ? WS_WPLE : (type == 0 ? WS_WOUT : WS_WGATE)) + (size_t)pn * BM * ld * 2 + koff;
        return ok; }
    __device__ __forceinline__ void a_ready(const Unit& u, int wid) const {
        if (u.type != 2) return;
        if (wid == 0) {
            unsigned* p1 = cnt + 64 * panel_of(u); unsigned* p2 = cnt + 64 * 37; const unsigned need2 = u.half ? 32u : 0u; unsigned sp = 0;
            while ((unsigned)__builtin_amdgcn_readfirstlane(__hip_atomic_load(p1, __ATOMIC_RELAXED, __HIP_MEMORY_SCOPE_AGENT)) < 8u ||
                   (unsigned)__builtin_amdgcn_readfirstlane(__hip_atomic_load(p2, __ATOMIC_RELAXED, __HIP_MEMORY_SCOPE_AGENT)) < need2) { __builtin_amdgcn_s_sleep(2); if (++sp > (1u << 24)) break; }
            __builtin_amdgcn_fence(__ATOMIC_ACQUIRE, "agent");
            asm volatile("s_waitcnt vmcnt(0)" ::: "memory");
        }
        asm volatile("" ::: "memory"); __builtin_amdgcn_s_barrier(); asm volatile("" ::: "memory");
    }
    __device__ __forceinline__ void done(const Unit& u, int wid) const {
        if (u.type == 2 || (u.type == 1 && !u.half)) return;
        asm volatile("s_waitcnt vmcnt(0)" ::: "memory");
        __builtin_amdgcn_s_barrier(); asm volatile("" ::: "memory");
        if (wid == 0 && lane_id() == 0) __hip_atomic_fetch_add(cnt + 64 * (u.type == 1 ? 37 : panel_of(u)), 1u, __ATOMIC_RELAXED, __HIP_MEMORY_SCOPE_AGENT);
    }
};
struct EpiP45 { unsigned char* ws; float* out;
    __device__ __forceinline__ void init(Acc& acc, const Unit& u, int wr, int wc, int fr, int fq) const {
        if (u.type == 0 && u.slice <= 0) { const EpiOut o{arg_in(0), arg_in(1), out + O_Y, ws}; o.init(acc, u, wr, wc, fr, fq); } else acc_zero(acc); }
    __device__ __forceinline__ void operator()(Acc& acc, const Unit& u, int wr, int wc, int fr, int fq, LAS unsigned char* scr) const {
        if (u.type == 0) { const EpiOut o{nullptr, nullptr, out + O_Y, ws}; o(acc, u, wr, wc, fr, fq, scr); }
        else if (u.type == 1) { const EpiBf16 e{(bf16_t*)(ws + WS_PV), DM, u.half}; e(acc, u, wr, wc, fr, fq, scr); }
        else { const EpiGate g{out + O_Y, ws, arg_in(22)}; g(acc, u, wr, wc, fr, fq, scr); } }
};
}

struct Args { const float* in[24]; float* out; unsigned char* ws; int ph_lo, ph_hi, li, pad; };
enum { I_XP = 0, I_XS, I_CCKV, I_CKR, I_SPOOL, I_PP, I_PS, I_NORMG, I_WIN, I_QNG, I_WUQ, I_KVNG, I_WUKV, I_QNOPEG, I_QROPEG, I_KNOPEG, I_KROPEG, I_WPOOL, I_PSCALE, I_WOUT, I_PLENG, I_WGATE, I_BGATE, I_WPLE };


__device__ __forceinline__ void cache_item(const float* W, bf16_t* CB, bf16_t* CT, int k0, int n0, LAS float* scr, int lane, bool doB, bool doT) {
    float tv[32];
#pragma unroll
    for (int i = 0; i < 32; ++i) tv[i] = W[(size_t)(k0 + 2 * i + (lane >> 5)) * KVRANK + n0 + (lane & 31)];
#pragma unroll
    for (int i = 0; i < 32; ++i) scr[(2 * i + (lane >> 5)) * 33 + (lane & 31)] = tv[i];
    LDS_WAIT(); asm volatile("" ::: "memory");
    const int kb0 = k0 >> 5, s0 = n0 >> 4;
#pragma unroll
    for (int c = 0; c < 4; ++c) { const int kbl = c >> 1, sl = c & 1;
        if (doB) { const LAS float* p = scr + (kbl * 32 + (lane & 31)) * 33 + sl * 16 + 8 * (lane >> 5);
          u32x4 o; o.x = cvtpk(p[0], p[1]); o.y = cvtpk(p[2], p[3]); o.z = cvtpk(p[4], p[5]); o.w = cvtpk(p[6], p[7]);
          *(u32x4*)(CB + ((size_t)((kb0 + kbl) * 16 + s0 + sl) * 64 + lane) * 8) = o; }
        if (doT) { const LAS float* p = scr + (kbl * 32 + 8 * (lane >> 4)) * 33 + sl * 16 + (lane & 15);
          u32x4 o; o.x = cvtpk(p[0 * 33], p[1 * 33]); o.y = cvtpk(p[2 * 33], p[3 * 33]); o.z = cvtpk(p[4 * 33], p[5 * 33]); o.w = cvtpk(p[6 * 33], p[7 * 33]);
          *(u32x4*)(CT + ((size_t)((kb0 + kbl) * 16 + s0 + sl) * 64 + lane) * 8) = o; } }
    LDS_WAIT(); asm volatile("" ::: "memory");
}
__device__ __forceinline__ bf16_t* ckvt_base(unsigned char* ws, int b) { return (bf16_t*)(ws + (b < NBT_A ? WS_CKVT_A + (size_t)b * CKVT_B : WS_CKVT_B + (size_t)(b - NBT_A) * CKVT_B)); }

__device__ __forceinline__ void transpose_item(const float* W, int N, bf16_t* WT, int ldt, int k0, int n0, int drow0, const float* kgain, LAS float* scr, int lane) {
    float tv[32];
#pragma unroll
    for (int i = 0; i < 32; ++i) tv[i] = W[(size_t)(k0 + 2 * i + (lane >> 5)) * N + n0 + (lane & 31)];
    if (kgain) {
#pragma unroll
        for (int i = 0; i < 32; ++i) tv[i] *= kgain[k0 + 2 * i + (lane >> 5)]; }
#pragma unroll
    for (int i = 0; i < 32; ++i) scr[(2 * i + (lane >> 5)) * 33 + (lane & 31)] = tv[i];
    LDS_WAIT(); asm volatile("" ::: "memory");
    const int c = lane & 7;
#pragma unroll
    for (int j = 0; j < 4; ++j) { const int n = (lane >> 3) + 8 * j; const LAS float* s = scr + (8 * c) * 33 + n;
        u32x4 o; o.x = cvtpk(s[0 * 33], s[1 * 33]); o.y = cvtpk(s[2 * 33], s[3 * 33]); o.z = cvtpk(s[4 * 33], s[5 * 33]); o.w = cvtpk(s[6 * 33], s[7 * 33]);
        *(u32x4*)(WT + (size_t)(drow0 + n) * ldt + k0 + 8 * c) = o; }
    LDS_WAIT(); asm volatile("" ::: "memory");
}

__device__ __forceinline__ void p0_prologue(const Args& a, LAS unsigned char* lds, int vcu, int G, int wv, int part) {
    const int lane = lane_id(), wave = wv, tid = (wv << 6) | lane;
    LAS float* scr = (LAS float*)(lds + wave * 16384);
    const int gw = vcu * 8 + wave, NGW = G * 8;
    unsigned char* ws = a.ws;
    bf16_t* Win_t = (bf16_t*)(ws + WS_WIN);
    const int gt = vcu * 512 + tid, NGT = G * 512;
    if (part == 0) {
        constexpr int I_IN = 32 * 122;
        { const float* W = AIN(I_WIN);
          for (int r = gw; r < I_IN; r += NGW) { const int kb = r / 122, nb = r % 122, n0 = 32 * nb; const int d = n0 < 2816 ? n0 : (n0 == 2816 ? 3840 : (n0 == 2848 ? 3968 : n0 - 64));
              transpose_item(W, DIN, Win_t, DM, 64 * kb, n0, d, nullptr, scr, lane); } }
        {
            bf16_t* XN = (bf16_t*)(ws + WS_XN); const float* gp = AIN(I_NORMG); const float* xp = AIN(I_XP); const float* xs = AIN(I_XS);
            for (int m = gw; m < MT; m += NGW) {
                const float* xr = (m < MP ? xp + (size_t)m * DM : xs + (size_t)(m - MP) * DM) + 4 * lane;
                f32x4 v[8]; float sm = 0.f;
#pragma unroll
                for (int j = 0; j < 8; ++j) { v[j] = *(const f32x4*)(xr + 256 * j); sm += pg8::sq4(v[j]); }
                const float r = 1.0f / sqrtf(wave_sum(sm) * (1.f / DM) + EPS);
#pragma unroll
                for (int j = 0; j < 8; ++j) { const f32x4 gv = *(const f32x4*)(gp + 4 * lane + 256 * j); const f32x4 o = v[j] * r * gv;
                    u32x2 w; w.x = cvtpk(o[0], o[1]); w.y = cvtpk(o[2], o[3]); *(u32x2*)(XN + (size_t)m * DM + 4 * lane + 256 * j) = w; }
            }
        }
        {
            float* COS = (float*)(ws + WS_COS); float* SIN = (float*)(ws + WS_SIN);
            for (int i = tid * G + vcu; i < SKV_S * 32; i += 512 * G) { const int pos = i >> 5, fi = i & 31; const float inv = (float)exp(-(double)fi * (1.0 / 32.0) * 9.210340371976184); const float ang = (float)pos * inv;
                float sv, cv; sincosf(ang, &sv, &cv); COS[i] = cv; SIN[i] = sv; }
        }
        {
            for (int i = gt; i < 192 * (DM / 8); i += NGT) { const int rr = i >> 8, c = (i & 255) * 8; const int row = 3840 + (rr < 96 ? 32 + rr : 160 + (rr - 96));
                *(u32x4*)(Win_t + (size_t)row * DM + c) = (u32x4){0u, 0u, 0u, 0u}; }
        }
        return;
    }
    bf16_t* Wuq_t = (bf16_t*)(ws + WS_WUQ); bf16_t* Wukv_t = (bf16_t*)(ws + WS_WUKV); bf16_t* Wpool_t = (bf16_t*)(ws + WS_WPOOL);
    bf16_t* Wout_t = (bf16_t*)(ws + WS_WOUT); bf16_t* Wgate_t = (bf16_t*)(ws + WS_WGATE); bf16_t* Wple_t = (bf16_t*)(ws + WS_WPLE);
    constexpr int I_UQ = 8 * 48, I_UKV = 4 * 64, I_POOL = 4 * 4 * 8, I_OUT = 32 * 64, I_GATE = 32 * 64, I_PLE = 4 * 64;
    constexpr int NITEMS = I_UQ + I_UKV + I_POOL + I_OUT + I_GATE + I_PLE;
    static_assert(NITEMS == 5120, "chunk map");
    unsigned* cctr = (unsigned*)(ws + WS_CTL) + 11776 + 64 * a.li;
    volatile LAS unsigned* MISCp = (volatile LAS unsigned*)(lds + MISC_OFF);
    for (;;) {
        if (tid == 0) MISCp[23] = __hip_atomic_fetch_add(cctr, 1u, __ATOMIC_RELAXED, __HIP_MEMORY_SCOPE_AGENT);
        __syncthreads();
        const int ch = (int)MISCp[23];
        __syncthreads();
        if (ch >= 852 + NBT_A * 32) break;
        if (ch >= 852) { const int item = (ch - 852) * 8 + wave, bb = item >> 8, kbk = (item & 255) >> 3, nb = item & 7;
            cache_item(AIN(I_CCKV) + (size_t)bb * PAST * KVRANK, nullptr, ckvt_base(ws, bb), 64 * kbk, 32 * nb, scr, lane, false, true); continue; }
        if (ch < 640) {
            int r = ch * 8 + wave;
            if (r < I_UQ) { const int kb = r / 48, nb = r % 48, n0 = 32 * nb, h = n0 / DQK, j0 = n0 % DQK;
                const int d = j0 < 128 ? h * 128 + j0 : 1024 + 256 * (h >> 2) + 32 * (h & 3) + (j0 == 160 ? 128 : 0);
                transpose_item(AIN(I_WUQ), NHEAD * DQK, Wuq_t, QRANK, 64 * kb, n0, d, AIN(I_QNG), scr, lane); continue; } r -= I_UQ;
            if (r < I_UKV) { const int kb = r / 64, nb = r % 64; transpose_item(AIN(I_WUKV), 2048, Wukv_t, KVRANK, 64 * kb, 32 * nb, 32 * nb, nullptr, scr, lane); continue; } r -= I_UKV;
            if (r < I_POOL) { const int gq = r / 32, kb = (r % 32) / 8, nb = r % 8; transpose_item(AIN(I_WPOOL) + (size_t)gq * 65536, 256, Wpool_t, 256, 64 * kb, 32 * nb, gq * 256 + 32 * nb, nullptr, scr, lane); continue; } r -= I_POOL;
            if (r < I_OUT) { const int kb = r / 64, nb = r % 64; transpose_item(AIN(I_WOUT), DM, Wout_t, DM, 64 * kb, 32 * nb, 32 * nb, nullptr, scr, lane); continue; } r -= I_OUT;
            if (r < I_GATE) { const int kb = r / 64, nb = r % 64; transpose_item(AIN(I_WGATE), DM, Wgate_t, DM, 64 * kb, 32 * nb, 32 * nb, AIN(I_PLENG), scr, lane); continue; } r -= I_GATE;
            { const int kb = r / 64, nb = r % 64; transpose_item(AIN(I_WPLE), DM, Wple_t, DPLE, 64 * kb, 32 * nb, 32 * nb, nullptr, scr, lane); }
        } else if (ch < 708) {
            bf16_t* PBF = (bf16_t*)(ws + WS_PBF); const float* pp = AIN(I_PP); const float* ps = AIN(I_PS);
#pragma unroll
            for (int k = 0; k < 8; ++k) { const int i = (ch - 640) * 4096 + tid + k * 512, m = i >> 5, c = (i & 31) * 8; const float* src = (m < MP ? pp + (size_t)m * DPLE : ps + (size_t)(m - MP) * DPLE) + c;
                *(u32x4*)(PBF + (size_t)m * DPLE + c) = pack8(*(const f32x4*)src, *(const f32x4*)(src + 4)); }
        } else if (ch < 724) {
            bf16_t* UBF = (bf16_t*)(ws + WS_UBF); const float* sp = AIN(I_SPOOL);
#pragma unroll
            for (int k = 0; k < 8; ++k) { const int i = (ch - 708) * 4096 + tid + k * 512, rr = i >> 7, c = (i & 127) * 8; u32x4 w = {0u, 0u, 0u, 0u};
                if (rr < DBATCH * POOLH) { const float* src = sp + (size_t)rr * DPOOL + c; w = pack8(*(const f32x4*)src, *(const f32x4*)(src + 4)); }
                *(u32x4*)(UBF + (size_t)(MT + rr) * DPOOL + c) = w; }
        } else {
            const float* src = AIN(I_CKR) + (size_t)(ch - 724) * 32768; bf16_t* dst = (bf16_t*)(ws + WS_KRB) + (size_t)(ch - 724) * 32768;
#pragma unroll
            for (int k = 0; k < 8; ++k) { const int o = tid * 8 + k * 4096; *(u32x4*)(dst + o) = pack8(*(const f32x4*)(src + o), *(const f32x4*)(src + o + 4)); }
        }
    }
}

namespace pattn {
constexpr int KVBLK = 64, NW = 8, QBLK = 32;
constexpr int SHM_V = 16384, SHM_KN = 16384, SHM_KR = 8192;
constexpr int L_V = 0, L_KN = 2 * SHM_V, L_KR = L_KN + 2 * SHM_KN, L_WS = L_KR + 2 * SHM_KR, L_END = L_WS + NW * 64 * 4;
constexpr int LDQ = NHEAD * DQK, LDK = NHEAD * DNOPE, LDV = NHEAD * DV;
constexpr float THR = 4.0f;
#define KSWZ(row, colB) ((row) * 256 + ((colB) ^ (((row) & 7) << 4)))
#define RSWZ(row, colB) ((row) * 128 + ((colB) ^ (((row) & 7) << 4)))
__device__ __forceinline__ int crow(int r, int hi) { return (r & 3) + 8 * (r >> 2) + 4 * hi; }

__device__ __forceinline__ void partialSM(f32x16& p0, f32x16& p1, float& m_reg, float& alpha) {
    float pmax = p0[0];
#pragma unroll
    for (int r = 1; r < 16; ++r) pmax = fmaxf(pmax, p0[r]);
#pragma unroll
    for (int r = 0; r < 16; ++r) pmax = fmaxf(pmax, p1[r]);
    { auto rr = __builtin_amdgcn_permlane32_swap(__float_as_uint(pmax), __float_as_uint(pmax), false, false); pmax = fmaxf(__uint_as_float(rr[0]), __uint_as_float(rr[1])); }
    float mn;
    if (__builtin_expect(__all(pmax - m_reg <= THR), 1)) { mn = m_reg; alpha = 1.f; }
    else { mn = fmaxf(m_reg, pmax); alpha = __builtin_amdgcn_exp2f(m_reg - mn); m_reg = mn; }
#pragma unroll
    for (int r = 0; r < 16; ++r) p0[r] = p0[r] - mn;
#pragma unroll
    for (int r = 0; r < 16; ++r) p1[r] = p1[r] - mn;
#pragma unroll
    for (int r = 0; r < 16; ++r) p0[r] = __builtin_amdgcn_exp2f(p0[r]);
}
__device__ __forceinline__ void finishSM(f32x16& p0, f32x16& p1, float alpha, float& l_reg, bf16x8& pa0, bf16x8& pa1, bf16x8& pa2, bf16x8& pa3) {
#pragma unroll
    for (int r = 0; r < 16; ++r) p1[r] = __builtin_amdgcn_exp2f(p1[r]);
    float ps = 0;
#pragma unroll
    for (int r = 0; r < 16; ++r) ps += p0[r];
#pragma unroll
    for (int r = 0; r < 16; ++r) ps += p1[r];
    { auto rr = __builtin_amdgcn_permlane32_swap(__float_as_uint(ps), __float_as_uint(ps), false, false); ps = __uint_as_float(rr[0]) + __uint_as_float(rr[1]); }
    l_reg = l_reg * alpha + ps;
#define PK4(P, BASE, OUT) do { unsigned a0 = cvtpk(P[BASE + 0], P[BASE + 1]), a1 = cvtpk(P[BASE + 2], P[BASE + 3]);   \
    unsigned b0 = cvtpk(P[BASE + 4], P[BASE + 5]), b1 = cvtpk(P[BASE + 6], P[BASE + 7]);                              \
    auto r0 = __builtin_amdgcn_permlane32_swap(a0, b0, false, false); auto r1 = __builtin_amdgcn_permlane32_swap(a1, b1, false, false); \
    u32x4 w = {r0[0], r1[0], r0[1], r1[1]}; OUT = __builtin_bit_cast(bf16x8, w); } while (0)
    PK4(p0, 0, pa0); PK4(p0, 8, pa1); PK4(p1, 0, pa2); PK4(p1, 8, pa3);
#undef PK4
}
__device__ __forceinline__ void qkt(f32x16& p0, f32x16& p1, LAS const unsigned char* Kn, LAS const unsigned char* Kr, const bf16x8* qr, int r32, int hi) {
    p0 = f32x16{}; p1 = f32x16{};
#pragma unroll
    for (int d0 = 0; d0 < 8; ++d0) { const int cb = (d0 * 16 + hi * 8) * 2;
        const bf16x8 b0 = *(LAS const bf16x8*)(Kn + KSWZ(r32, cb)); const bf16x8 b1 = *(LAS const bf16x8*)(Kn + KSWZ(32 + r32, cb));
        p0 = __builtin_amdgcn_mfma_f32_32x32x16_bf16(b0, qr[d0], p0, 0, 0, 0); p1 = __builtin_amdgcn_mfma_f32_32x32x16_bf16(b1, qr[d0], p1, 0, 0, 0); }
#pragma unroll
    for (int d0 = 0; d0 < 4; ++d0) { const int cb = (d0 * 16 + hi * 8) * 2;
        const bf16x8 b0 = *(LAS const bf16x8*)(Kr + RSWZ(r32, cb)); const bf16x8 b1 = *(LAS const bf16x8*)(Kr + RSWZ(32 + r32, cb));
        p0 = __builtin_amdgcn_mfma_f32_32x32x16_bf16(b0, qr[8 + d0], p0, 0, 0, 0); p1 = __builtin_amdgcn_mfma_f32_32x32x16_bf16(b1, qr[8 + d0], p1, 0, 0, 0); }
}
__device__ __forceinline__ int v_st(int k, int c) { const int kk = (k & ~0xC) | ((k & 4) << 1) | ((k & 8) >> 1); return ((kk >> 3) * 4 + (c >> 5)) * 512 + ((kk & 7) * 32 + (c & 31)) * 2; }
__device__ __forceinline__ int v_rd_base(int lane) { return ((lane & 3) << 3) | (((lane >> 2) & 3) << 6) | (((lane >> 4) & 1) << 5) | (((lane >> 5) & 1) << 8); }
constexpr int v_rd_off(int d0, int ks, int half) { return d0 * 512 + ks * 4096 + half * 2048; }
template <int OFF> __device__ __forceinline__ s16x4 tr_read(int vb) { s16x4 r; asm volatile("ds_read_b64_tr_b16 %0, %1 offset:%2" : "=&v"(r) : "v"(vb), "i"(OFF) : "memory"); return r; }
template <int D0> __device__ __forceinline__ void pv_one(f32x16& od, int vb, bf16x8 pa0, bf16x8 pa1, bf16x8 pa2, bf16x8 pa3) {
    const s16x4 l0 = tr_read<v_rd_off(D0, 0, 0)>(vb), h0 = tr_read<v_rd_off(D0, 0, 1)>(vb), l1 = tr_read<v_rd_off(D0, 1, 0)>(vb), h1 = tr_read<v_rd_off(D0, 1, 1)>(vb);
    const s16x4 l2 = tr_read<v_rd_off(D0, 2, 0)>(vb), h2 = tr_read<v_rd_off(D0, 2, 1)>(vb), l3 = tr_read<v_rd_off(D0, 3, 0)>(vb), h3 = tr_read<v_rd_off(D0, 3, 1)>(vb);
    asm volatile("s_waitcnt lgkmcnt(0)" ::: "memory"); SBAR();
#define PK(L, H) (bf16x8){L[0], L[1], L[2], L[3], H[0], H[1], H[2], H[3]}
    od = __builtin_amdgcn_mfma_f32_32x32x16_bf16(pa0, PK(l0, h0), od, 0, 0, 0);
    od = __builtin_amdgcn_mfma_f32_32x32x16_bf16(pa1, PK(l1, h1), od, 0, 0, 0);
    od = __builtin_amdgcn_mfma_f32_32x32x16_bf16(pa2, PK(l2, h2), od, 0, 0, 0);
    od = __builtin_amdgcn_mfma_f32_32x32x16_bf16(pa3, PK(l3, h3), od, 0, 0, 0);
#undef PK
}
__device__ __forceinline__ void pv_d0(f32x16* o, int vb, bf16x8 pa0, bf16x8 pa1, bf16x8 pa2, bf16x8 pa3) {
    pv_one<0>(o[0], vb, pa0, pa1, pa2, pa3); pv_one<1>(o[1], vb, pa0, pa1, pa2, pa3); pv_one<2>(o[2], vb, pa0, pa1, pa2, pa3); pv_one<3>(o[3], vb, pa0, pa1, pa2, pa3);
}

__device__ __forceinline__ void unit(int b, int h, int qb, const bf16_t* __restrict__ QCAT, const bf16_t* __restrict__ KCAT, const bf16_t* __restrict__ KRN, const bf16_t* __restrict__ Vb, const bf16_t* __restrict__ SGM, bf16_t* MIX, LAS unsigned char* lds, int wv) {
    int lane = lane_id(); asm volatile("" : "+v"(lane));
    const int wid = wv, tid = (wv << 6) | lane, r32 = lane & 31, hi = lane >> 5;
    const long rowbase = (long)b * SEQ; const int q0 = qb * 256;
    LAS unsigned char* V_lds = lds + L_V; LAS unsigned char* KN_lds = lds + L_KN; LAS unsigned char* KR_lds = lds + L_KR;
    LAS float* wsf = (LAS float*)(lds + L_WS) + wid * 64; LAS float* li_l = wsf; LAS float* al_l = wsf + 32;
    const bf16_t* Kh = KCAT + rowbase * LDK + h * DNOPE; const bf16_t* Vh = Vb + rowbase * LDV + h * DV; const bf16_t* Kr = KRN + rowbase * DROPE;
    float m_reg = -1e30f, l_reg = 0.f; f32x16 o[4]; o[0] = f32x16{}; o[1] = f32x16{}; o[2] = f32x16{}; o[3] = f32x16{};
    bf16x8 qr[12];
    { const bf16_t* Qw = QCAT + (rowbase + q0 + wid * QBLK + r32) * LDQ + h * DQK + hi * 8;
#pragma unroll
      for (int d0 = 0; d0 < 12; ++d0) qr[d0] = *(const bf16x8*)(Qw + d0 * 16); }
    const int cw = 4 * qb + (wid >> 1);
    const int NT = 4 * qb + 4;
    const int sr = tid >> 4, sc = (tid & 15) * 8, vst0 = v_st(sr, sc), vst1 = v_st(32 + sr, sc);
    const int krr = tid >> 3, krc = (tid & 7) * 8;
    const int vb0 = (int)(uintptr_t)V_lds + v_rd_base(lane);
    bf16x8 sv0, sv1, sk0, sk1, skr;
#define SLOAD(k0) do { sv0 = *(const bf16x8*)(Vh + (long)((k0) + sr) * LDV + sc); sv1 = *(const bf16x8*)(Vh + (long)((k0) + 32 + sr) * LDV + sc); \
    sk0 = *(const bf16x8*)(Kh + (long)((k0) + sr) * LDK + sc); sk1 = *(const bf16x8*)(Kh + (long)((k0) + 32 + sr) * LDK + sc); \
    skr = *(const bf16x8*)(Kr + (long)((k0) + krr) * DROPE + krc); } while (0)
#define SWRITE(bb) do { *(LAS bf16x8*)(V_lds + (bb) * SHM_V + vst0) = sv0; *(LAS bf16x8*)(V_lds + (bb) * SHM_V + vst1) = sv1; \
    *(LAS bf16x8*)(KN_lds + (bb) * SHM_KN + KSWZ(sr, sc * 2)) = sk0; *(LAS bf16x8*)(KN_lds + (bb) * SHM_KN + KSWZ(32 + sr, sc * 2)) = sk1; \
    *(LAS bf16x8*)(KR_lds + (bb) * SHM_KR + RSWZ(krr, krc * 2)) = skr; } while (0)
#define RESC(a) do { if (__any((a) < 1.f)) { if (hi == 0) al_l[r32] = (a); asm volatile("s_waitcnt lgkmcnt(0)" ::: "memory"); \
    _Pragma("unroll") for (int d = 0; d < 4; ++d) _Pragma("unroll") for (int r = 0; r < 16; ++r) o[d][r] *= al_l[crow(r, hi)]; } } while (0)
#define QKT(P0, P1, bb, j) do { if ((j) <= cw) qkt(P0, P1, KN_lds + (bb) * SHM_KN, KR_lds + (bb) * SHM_KR, qr, r32, hi); \
    else { _Pragma("unroll") for (int r = 0; r < 16; ++r) { P0[r] = -1e30f; P1[r] = -1e30f; } } } while (0)
#define PV(bb, j) do { if ((j) <= cw) pv_d0(o, vb0 + (bb) * SHM_V, pa0, pa1, pa2, pa3); } while (0)
    f32x16 pA0, pA1, pB0, pB1; float alA, alB; bf16x8 pa0, pa1, pa2, pa3;
    SLOAD(0); SWRITE(0); __syncthreads();
    QKT(pA0, pA1, 0, 0); partialSM(pA0, pA1, m_reg, alA);
    SLOAD(KVBLK); SWRITE(1); __syncthreads();
    for (int j = 1; j + 1 < NT; j += 2) {
        SBAR(); QKT(pB0, pB1, 1, j);
        finishSM(pA0, pA1, alA, l_reg, pa0, pa1, pa2, pa3); SBAR();
        SLOAD((j + 1) * KVBLK); SBAR();
        PV(0, j - 1); partialSM(pB0, pB1, m_reg, alB);
        __syncthreads(); SWRITE(0);
        RESC(alB); __syncthreads();
        SBAR(); QKT(pA0, pA1, 0, j + 1);
        finishSM(pB0, pB1, alB, l_reg, pa0, pa1, pa2, pa3); SBAR();
        SLOAD((j + 2) * KVBLK); SBAR();
        PV(1, j); partialSM(pA0, pA1, m_reg, alA);
        __syncthreads(); SWRITE(1);
        RESC(alA); __syncthreads();
    }
    SBAR(); QKT(pB0, pB1, 1, NT - 1);
    finishSM(pA0, pA1, alA, l_reg, pa0, pa1, pa2, pa3); SBAR();
    PV(0, NT - 2); partialSM(pB0, pB1, m_reg, alB);
    __syncthreads(); RESC(alB);
    finishSM(pB0, pB1, alB, l_reg, pa0, pa1, pa2, pa3); SBAR();
    PV(1, NT - 1);
    if (hi == 0) li_l[r32] = l_reg; asm volatile("s_waitcnt lgkmcnt(0)" ::: "memory");
    float rli[16];
#pragma unroll
    for (int r = 0; r < 16; ++r) rli[r] = __builtin_amdgcn_rcpf(li_l[crow(r, hi)]);
    __syncthreads();
    LAS bf16_t* stg = (LAS bf16_t*)(lds + wid * 8192);
#pragma unroll
    for (int r = 0; r < 16; ++r) { const int orow = crow(r, hi);
#pragma unroll
        for (int d0 = 0; d0 < 4; ++d0) { const float v = o[d0][r] * rli[r]; stg[orow * 128 + d0 * 32 + r32] = (bf16_t)(cvtpk(v, 0.f) & 0xffffu); } }
    asm volatile("s_waitcnt lgkmcnt(0)" ::: "memory");
    const long orow0 = rowbase + q0 + wid * QBLK;
#pragma unroll
    for (int i = 0; i < 8; ++i) { const int row = i * 4 + (lane >> 4), ch = lane & 15; const u32x4 v = *(LAS const u32x4*)(stg + row * 128 + ch * 8);
        const u32x4 gq = *(const u32x4*)(SGM + (orow0 + row) * 1024 + h * DV + ch * 8); u32x4 w;
        w.x = cvtpk(__uint_as_float(v.x << 16) * __uint_as_float(gq.x << 16), __uint_as_float(v.x & 0xffff0000u) * __uint_as_float(gq.x & 0xffff0000u));
        w.y = cvtpk(__uint_as_float(v.y << 16) * __uint_as_float(gq.y << 16), __uint_as_float(v.y & 0xffff0000u) * __uint_as_float(gq.y & 0xffff0000u));
        w.z = cvtpk(__uint_as_float(v.z << 16) * __uint_as_float(gq.z << 16), __uint_as_float(v.z & 0xffff0000u) * __uint_as_float(gq.z & 0xffff0000u));
        w.w = cvtpk(__uint_as_float(v.w << 16) * __uint_as_float(gq.w << 16), __uint_as_float(v.w & 0xffff0000u) * __uint_as_float(gq.w & 0xffff0000u));
        *(u32x4*)(MIX + (orow0 + row) * DM + DPOOL + h * DV + ch * 8) = w; }
    __syncthreads();
#undef SLOAD
#undef SWRITE
#undef RESC
#undef QKT
#undef PV
}
}

namespace sattn {
__device__ __forceinline__ int crow(int r, int hi) { return (r & 3) + 8 * (r >> 2) + 4 * hi; }
__device__ __forceinline__ bf16x8 packf8(const f32x16& a, int base, float s) {
    u32x4 w; w.x = cvtpk(a[base + 0] * s, a[base + 1] * s); w.y = cvtpk(a[base + 2] * s, a[base + 3] * s); w.z = cvtpk(a[base + 4] * s, a[base + 5] * s); w.w = cvtpk(a[base + 6] * s, a[base + 7] * s);
    return __builtin_bit_cast(bf16x8, w);
}
constexpr int NKB = (SKV_S + 31) / 32;
constexpr int WROW = 528;
constexpr int PS_OFF = 69632;
constexpr int QF_OFF = 256 * WROW;
constexpr int CQ_STRIDE = 260;

__device__ __forceinline__ void unit(int b, int h, const bf16_t* __restrict__ CKVB, const bf16_t* __restrict__ KRB, const bf16_t* __restrict__ CKVN, const bf16_t* __restrict__ KRN, const bf16_t* __restrict__ CT,
                                     const bf16_t* __restrict__ Wukv_t, const bf16_t* __restrict__ QCAT, const bf16_t* __restrict__ SGM, bf16_t* MIX, LAS unsigned char* lds, LAS unsigned char* scr, int wv) {
    int lane = lane_id(); asm volatile("" : "+v"(lane));
    const int wid = wv, tid = (wv << 6) | lane, r32 = lane & 31, hh = lane >> 5;
    LAS unsigned char* qf = lds + QF_OFF;
    { const bf16_t* Wsrc = Wukv_t + (size_t)h * 256 * KVRANK;
#pragma unroll 4
      for (int i = 0; i < 8; ++i) { const int gi = tid + 512 * i, row = gi >> 5, c16 = gi & 31; const u32x4 v = *(const u32x4*)(Wsrc + (size_t)gi * 8);
          *(LAS u32x4*)(lds + row * WROW + (c16 << 4)) = v; } }
    { const bf16_t* qp = QCAT + (size_t)(MP + b * DSEQ + (r32 & 15)) * (NHEAD * DQK) + h * DQK;
      for (int f = wid; f < 12; f += 8) { u32x4 v = {0u, 0u, 0u, 0u};
          if (r32 < DSEQ) { if (f < 8) { const bf16_t* p = qp + (f >> 1) * 32 + (f & 1) * 16 + 4 * hh; const u32x2 lo = *(const u32x2*)p, hi2 = *(const u32x2*)(p + 8); v = (u32x4){lo.x, lo.y, hi2.x, hi2.y}; }
                            else v = *(const u32x4*)(qp + DNOPE + (f - 8) * 16 + 8 * hh); }
          *(LAS u32x4*)(qf + f * 1024 + lane * 16) = v; } }
    __syncthreads();
    float m_run = -1e30f, l_run = 0.f; f32x4 ol[16];
#pragma unroll
    for (int i = 0; i < 16; ++i) ol[i] = (f32x4){0.f, 0.f, 0.f, 0.f};
    LAS float* rks = (LAS float*)(lds + MISC_OFF + 256) + wid * 32;
    LAS unsigned char* ps = lds + PS_OFF + wid * 2048;
    LAS const unsigned char* wk = lds + r32 * WROW + hh * 16; LAS const unsigned char* qfl = qf + lane * 16;
    const int q16 = lane & 15, kq = lane >> 4;
    const bf16_t* ctl = CT + (size_t)lane * 8; const bf16_t* cbl = CKVB + (size_t)b * (CKVT_B / 2) + (size_t)lane * 8;
    for (int kb = wid; kb < NKB; kb += 8) {
        int key = kb * 32 + r32; if (key > SKV_S - 1) key = SKV_S - 1;
        const bf16_t* kp = (key < PAST ? KRB + (size_t)(b * PAST + key) * DROPE : KRN + (size_t)(MP + b * DSEQ + key - PAST) * DROPE) + 8 * hh;
        f32x16 z = f32x16{}; float ssq = 0.f;
        bf16x8 rf[4];
#pragma unroll
        for (int s = 0; s < 4; ++s) rf[s] = *(const bf16x8*)(kp + 16 * s);
        {
        bf16x8 cf[16];
#pragma unroll
        for (int s = 0; s < 16; ++s) cf[s] = *(const bf16x8*)(cbl + (size_t)(kb * 16 + s) * 512);
#pragma unroll
        for (int dh = 0; dh < 2; ++dh) {
            f32x16 acc[2];
#pragma unroll
            for (int d2 = 0; d2 < 2; ++d2) { acc[d2] = f32x16{};
#pragma unroll
                for (int s = 0; s < 16; ++s) { const bf16x8 wa = *(LAS const bf16x8*)(wk + (dh * 2 + d2) * 32 * WROW + s * 32);
                    acc[d2] = __builtin_amdgcn_mfma_f32_32x32x16_bf16(wa, cf[s], acc[d2], 0, 0, 0); } }
            SBAR();
            bf16x8 kn[4];
#pragma unroll
            for (int d2 = 0; d2 < 2; ++d2) {
#pragma unroll
                for (int r = 0; r < 16; ++r) ssq += acc[d2][r] * acc[d2][r];
                kn[2 * d2] = packf8(acc[d2], 0, 1.f); kn[2 * d2 + 1] = packf8(acc[d2], 8, 1.f); }
            SBAR();
#pragma unroll
            for (int f = 0; f < 4; ++f) { const bf16x8 qb = *(LAS const bf16x8*)(qfl + (dh * 4 + f) * 1024); z = __builtin_amdgcn_mfma_f32_32x32x16_bf16(kn[f], qb, z, 0, 0, 0); }
            SBAR();
        }
        }
        bf16x8 af[16];
        { const bf16_t* ck = ctl + (size_t)kb * 16 * 512;
#pragma unroll
          for (int lb = 0; lb < 16; ++lb) af[lb] = *(const bf16x8*)(ck + lb * 512); }
        { auto rr = __builtin_amdgcn_permlane32_swap(__float_as_uint(ssq), __float_as_uint(ssq), false, false); ssq = __uint_as_float(rr[0]) + __uint_as_float(rr[1]); }
        rks[lane & 31] = 1.0f / sqrtf(ssq * (1.f / DNOPE) + EPS);
        asm volatile("s_waitcnt lgkmcnt(0)" ::: "memory");
#pragma unroll
        for (int g4 = 0; g4 < 4; ++g4) { const f32x4 rv = *(LAS const f32x4*)(rks + 8 * g4 + 4 * hh);
#pragma unroll
            for (int j = 0; j < 4; ++j) z[4 * g4 + j] *= rv[j]; }
#pragma unroll
        for (int s = 0; s < 4; ++s) { const bf16x8 qb = *(LAS const bf16x8*)(qfl + (8 + s) * 1024); z = __builtin_amdgcn_mfma_f32_32x32x16_bf16(rf[s], qb, z, 0, 0, 0); }
        SBAR();
        if (kb == NKB - 1) {
#pragma unroll
            for (int r = 0; r < 16; ++r) if (kb * 32 + crow(r, hh) >= SKV_S) z[r] = -1e30f;
        }
        float mx = z[0];
#pragma unroll
        for (int r = 1; r < 16; ++r) mx = fmaxf(mx, z[r]);
        { auto rr = __builtin_amdgcn_permlane32_swap(__float_as_uint(mx), __float_as_uint(mx), false, false); mx = fmaxf(__uint_as_float(rr[0]), __uint_as_float(rr[1])); }
        const float mn = fmaxf(m_run, mx), alpha = __builtin_amdgcn_exp2f(m_run - mn); m_run = mn;
        float psum = 0.f;
#pragma unroll
        for (int r = 0; r < 16; ++r) { z[r] = __builtin_amdgcn_exp2f(z[r] - mn); psum += z[r]; }
        l_run = l_run * alpha + psum;
        if (r32 < DSEQ) {
#pragma unroll
            for (int k4 = 0; k4 < 4; ++k4) { u32x2 w; w.x = cvtpk(z[4 * k4], z[4 * k4 + 1]); w.y = cvtpk(z[4 * k4 + 2], z[4 * k4 + 3]); *(LAS u32x2*)(ps + (r32 * 4 + k4) * 16 + 8 * hh) = w; }
            if (hh == 0) *(LAS float*)(ps + 1024 + 4 * r32) = alpha;
        }
        asm volatile("s_waitcnt lgkmcnt(0)" ::: "memory");
        const bf16x8 pf = *(LAS const bf16x8*)(ps + (q16 * 4 + kq) * 16); const float al16 = *(LAS const float*)(ps + 1024 + 4 * q16);
        SBAR();
#pragma unroll
        for (int lb = 0; lb < 16; ++lb) ol[lb] = __builtin_amdgcn_mfma_f32_16x16x32_bf16(af[lb], pf, ol[lb] * al16, 0, 0, 0);
        SBAR();
    }
    { auto rr = __builtin_amdgcn_permlane32_swap(__float_as_uint(l_run), __float_as_uint(l_run), false, false); l_run = __uint_as_float(rr[0]) + __uint_as_float(rr[1]); }
    __syncthreads();
    LAS float* comb = (LAS float*)lds; LAS float* ml = (LAS float*)(lds + QF_OFF);
    const int lane2 = lane_id(), tid2 = (wv << 6) | lane2;
    { const int qq = lane2 & 15, rq = lane2 >> 4;
#pragma unroll
      for (int lb = 0; lb < 16; ++lb) *(LAS f32x4*)(comb + (wid * 16 + qq) * CQ_STRIDE + lb * 16 + 4 * rq) = ol[lb];
      if (lane2 < DSEQ) { ml[wid * 16 + lane2] = m_run; ml[128 + wid * 16 + lane2] = l_run; } }
    __syncthreads();
    { const int q = tid2 >> 5, l0 = (tid2 & 31) * 8; float M = ml[q];
#pragma unroll
      for (int w = 1; w < 8; ++w) M = fmaxf(M, ml[w * 16 + q]);
      float L = 0.f; f32x4 a0 = {0.f, 0.f, 0.f, 0.f}, a1 = {0.f, 0.f, 0.f, 0.f};
#pragma unroll
      for (int w = 0; w < 8; ++w) { const float e = __builtin_amdgcn_exp2f(ml[w * 16 + q] - M); L += ml[128 + w * 16 + q] * e; const LAS float* cp = comb + (w * 16 + q) * CQ_STRIDE + l0;
          a0 += *(LAS const f32x4*)cp * e; a1 += *(LAS const f32x4*)(cp + 4) * e; }
      const float rl = 1.0f / L;
      __syncthreads();
      *(LAS f32x4*)(comb + q * CQ_STRIDE + l0) = a0 * rl; *(LAS f32x4*)(comb + q * CQ_STRIDE + l0 + 4) = a1 * rl; }
    __syncthreads();
    { const int q16b = lane2 & 15, kqb = lane2 >> 4; const bf16_t* wvp = Wukv_t + ((size_t)h * 256 + 128 + wid * 16 + q16b) * KVRANK + 8 * kqb;
      const LAS float* arow = comb + q16b * CQ_STRIDE + 8 * kqb;
      f32x4 od = {0.f, 0.f, 0.f, 0.f};
#pragma unroll
      for (int ks = 0; ks < 8; ++ks) { const f32x4 x0 = *(LAS const f32x4*)(arow + 32 * ks), x1 = *(LAS const f32x4*)(arow + 32 * ks + 4);
          const bf16x8 af2 = __builtin_bit_cast(bf16x8, pack8(x0, x1)); const bf16x8 bf2 = *(const bf16x8*)(wvp + 32 * ks);
          od = __builtin_amdgcn_mfma_f32_16x16x32_bf16(af2, bf2, od, 0, 0, 0); }
      const int dim = wid * 16 + q16b;
#pragma unroll
      for (int r = 0; r < 4; ++r) { const size_t row = (size_t)(MP + b * DSEQ + 4 * kqb + r);
          const float gt = bf2f(SGM[row * 1024 + h * DV + dim]); MIX[row * DM + DPOOL + h * DV + dim] = (bf16_t)(cvtpk(od[r] * gt, 0.f) & 0xffffu); } }
    __syncthreads();
}
}

__device__ __forceinline__ void bf8_to_f(const u32x4 v, float (&d)[8]) {
    d[0] = __uint_as_float(v.x << 16); d[1] = __uint_as_float(v.x & 0xffff0000u); d[2] = __uint_as_float(v.y << 16); d[3] = __uint_as_float(v.y & 0xffff0000u);
    d[4] = __uint_as_float(v.z << 16); d[5] = __uint_as_float(v.z & 0xffff0000u); d[6] = __uint_as_float(v.w << 16); d[7] = __uint_as_float(v.w & 0xffff0000u); }
template <int W>
__device__ __forceinline__ void pool_window_run(int m0, int col, const bf16_t* __restrict__ Z, const bf16_t* __restrict__ SGP, const float* __restrict__ pscale, bf16_t* MIX) {
    const bool smp = m0 >= MP; const int sb = (m0 - MP) >> 4;
    const int u0 = smp ? POOLH + ((m0 - MP) & 15) : (m0 & (SEQ - 1));
    const long base_new = smp ? (long)(MP + sb * DSEQ) - POOLH : (long)(m0 - u0);
    const long base_hist = (long)MT + sb * POOLH;
    u32x4 zr[W + 7], gq[8];
#pragma unroll
    for (int i = 0; i < W + 7; ++i) { const int u = u0 - (W - 1) + i; zr[i] = (u32x4){0u, 0u, 0u, 0u};
        if (u >= 0) zr[i] = *(const u32x4*)(Z + ((smp && u < POOLH) ? base_hist + u : base_new + u) * DPOOL + col); }
#pragma unroll
    for (int r = 0; r < 8; ++r) gq[r] = *(const u32x4*)(SGP + (size_t)(m0 + r) * DPOOL + col);
    const f32x4 p0 = *(const f32x4*)(pscale + col), p1 = *(const f32x4*)(pscale + col + 4);
    float S[8];
#pragma unroll
    for (int i = 0; i < 8; ++i) S[i] = 0.f;
#pragma unroll
    for (int k = 0; k < W - 1; ++k) { float t[8]; bf8_to_f(zr[k], t);
#pragma unroll
        for (int i = 0; i < 8; ++i) S[i] += t[i]; }
#pragma unroll
    for (int r = 0; r < 8; ++r) { const int u = u0 + r; float zc[8], gv[8], td[8], ov[8]; bf8_to_f(zr[W - 1 + r], zc); bf8_to_f(gq[r], gv); bf8_to_f(zr[r], td);
#pragma unroll
        for (int i = 0; i < 8; ++i) S[i] += zc[i];
        const int pos1 = smp ? SEQ : u + 1; const float rc = 1.0f / (float)(pos1 < W ? pos1 : W);
#pragma unroll
        for (int i = 0; i < 8; ++i) ov[i] = (S[i] * rc - zc[i]) * (i < 4 ? p0[i] : p1[i - 4]) * gv[i];
        u32x4 wv4; wv4.x = cvtpk(ov[0], ov[1]); wv4.y = cvtpk(ov[2], ov[3]); wv4.z = cvtpk(ov[4], ov[5]); wv4.w = cvtpk(ov[6], ov[7]);
        *(u32x4*)(MIX + (size_t)(m0 + r) * DM + col) = wv4;
#pragma unroll
        for (int i = 0; i < 8; ++i) S[i] -= td[i]; }
}
__device__ __forceinline__ void pool_window_block(int blk, const bf16_t* __restrict__ Z, const bf16_t* __restrict__ SGP, const float* __restrict__ pscale, bf16_t* MIX, int wv) {
    const int lane = lane_id(), g = wv & 3, m0 = blk * 32 + ((lane >> 5) + 2 * (wv >> 2)) * 8, col = g * 256 + (lane & 31) * 8;
    if (g == 0) pool_window_run<2>(m0, col, Z, SGP, pscale, MIX);
    else if (g == 1) pool_window_run<4>(m0, col, Z, SGP, pscale, MIX);
    else if (g == 2) pool_window_run<8>(m0, col, Z, SGP, pscale, MIX);
    else pool_window_run<16>(m0, col, Z, SGP, pscale, MIX);
}

#define XB_TMO      128
#define XB_XCNT(j)  (256  + 64 * (j))
#define XB_XSUB(j)  (1280 + 64 * (j))
#define XB_XGEN(j)  (2304 + 64 * (j))
#define XB_TOP      3328
#define XB_TOPGEN   3392
#define XCD_BAR_WORDS 3456
#define XB_SPIN_CAP (1u << 22)
__device__ __forceinline__ unsigned xb_ld(unsigned* p)              { return __hip_atomic_load(p, __ATOMIC_RELAXED, __HIP_MEMORY_SCOPE_AGENT); }
__device__ __forceinline__ unsigned xb_add(unsigned* p, unsigned v) { return __hip_atomic_fetch_add(p, v, __ATOMIC_RELAXED, __HIP_MEMORY_SCOPE_AGENT); }
__device__ __forceinline__ unsigned xb_xcc_id() { return (unsigned)__builtin_amdgcn_s_getreg((3 << 11) | 20) & 0xFu; }
#define XB_SPIN(cond, bar) do { unsigned _sp = 0; while (cond) { __builtin_amdgcn_s_sleep(1); \
    if ((++_sp & 255u) == 0u) { if (xb_ld(&(bar)[XB_TMO])) break; if (_sp > XB_SPIN_CAP) { atomicAdd(&(bar)[XB_TMO], 1u); break; } } } } while (0)
struct XcdBarrier { unsigned* bar; unsigned x; volatile LAS unsigned* st; };
__device__ __forceinline__ XcdBarrier xcd_barrier_post(unsigned* bar, volatile LAS unsigned* st, int wv) {
    XcdBarrier b; b.bar = bar; b.x = xb_xcc_id(); b.st = st;
    if (TIDX(wv) == 0) (void)xb_add(&bar[XB_XCNT(b.x)], 1u);
    return b;
}
__device__ __forceinline__ void xcd_barrier_complete(unsigned* bar, unsigned x, unsigned& nloc, unsigned& nx) {
    const unsigned G = gridDim.x * gridDim.y * gridDim.z;
    unsigned sum, cnt, mine, sp = 0u;
    for (;;) {
        sum = 0u; cnt = 0u; mine = 0u;
#pragma unroll
        for (unsigned j = 0; j < 16; ++j) { const unsigned c = xb_ld(&bar[XB_XCNT(j)]); sum += c; cnt += (c > 0u) ? 1u : 0u; mine = (j == x) ? c : mine; }
        if (sum == G) break;
        __builtin_amdgcn_s_sleep(1);
        if ((++sp & 255u) == 0u) { if (xb_ld(&bar[XB_TMO])) break; if (sp > XB_SPIN_CAP) { atomicAdd(&bar[XB_TMO], 1u); break; } }
    }
    nloc = mine > 0u ? mine : 1u; nx = cnt > 0u ? cnt : 1u;
}
__device__ __forceinline__ void xcd_barrier(const XcdBarrier& b, int wv) {
    asm volatile("s_waitcnt vmcnt(0)" ::: "memory");
    __syncthreads();
    if (TIDX(wv) == 0) {
        unsigned* bar = b.bar;
        __builtin_amdgcn_s_waitcnt(0);
        unsigned nloc = b.st[0], nx = b.st[1];
        if (nloc == 0u) { xcd_barrier_complete(bar, b.x, nloc, nx); b.st[0] = nloc; b.st[1] = nx; }
        const unsigned old = xb_add(&bar[XB_XSUB(b.x)], 1u);
        const unsigned gen = old / nloc;
        if (old + 1u == (gen + 1u) * nloc) {
            __builtin_amdgcn_fence(__ATOMIC_RELEASE, "agent");
            asm volatile("s_waitcnt vmcnt(0)" ::: "memory");
            const unsigned og = xb_add(&bar[XB_TOP], 1u);
            const unsigned tg = og / nx;
            if (og + 1u == (tg + 1u) * nx) xb_add(&bar[XB_TOPGEN], 1u);
            else XB_SPIN(xb_ld(&bar[XB_TOPGEN]) == tg, bar);
            __builtin_amdgcn_fence(__ATOMIC_ACQUIRE, "agent");
            xb_add(&bar[XB_XGEN(b.x)], 1u);
            asm volatile("s_waitcnt vmcnt(0)" ::: "memory");
        } else {
            XB_SPIN(xb_ld(&bar[XB_XGEN(b.x)]) == gen, bar);
            __builtin_amdgcn_fence(__ATOMIC_ACQUIRE, "agent");
            asm volatile("s_waitcnt vmcnt(0)" ::: "memory");
        }
    }
    __syncthreads();
}

constexpr int N_PHASES = 5;
__global__ void __launch_bounds__(512, 2) hymba_fwd(Args a) {
    extern __shared__ __attribute__((aligned(16))) unsigned char lds_raw[];
    LAS unsigned char* lds = (LAS unsigned char*)lds_raw;
    LAS unsigned char* scr = lds + SCR_OFF;
    volatile LAS unsigned* MISC = (volatile LAS unsigned*)(lds + MISC_OFF);
    const int wv = __builtin_amdgcn_readfirstlane((int)threadIdx.x >> 6);
    const int tid = TIDX(wv);
    const int G = gridDim.x; const int bx = blockIdx.x; const int vcu = (G % 8 == 0) ? (bx % 8) * (G / 8) + bx / 8 : bx;
    unsigned char* ws = a.ws; float* out = a.out;
    if (tid < 64) MISC[tid] = 0u;
    __syncthreads();
    XcdBarrier bar; bar.bar = (unsigned*)(ws + WS_CTL) + 1024 + a.li * XCD_BAR_WORDS; bar.x = 0; bar.st = nullptr;
    const bool one_launch = (a.ph_hi - a.ph_lo) > 1;
    if (one_launch) bar = xcd_barrier_post((unsigned*)(ws + WS_CTL) + 1024 + a.li * XCD_BAR_WORDS, MISC + 8, wv);
    const int lo = a.ph_lo, hi = a.ph_hi;
#ifndef PHASE_MASK
#define PHASE_MASK 63
#endif
#define IN(k) (((PHASE_MASK >> (k)) & 1) && lo <= (k) && (k) < hi)
#define SEAM(k) do { if (IN(k) && IN((k) + 1)) xcd_barrier(bar, wv); } while (0)
#define WSP(T, off) ((T*)(ws + (off)))
    if (IN(0)) { p0_prologue(a, lds, vcu, G, wv, 0); __syncthreads(); }
    SEAM(0);
    if (IN(1)) {
        pg8::SchedP1 S{(const char*)ws, bx, G};
        pg8::EpiInProj E{ws, out};
        pg8::gemm_phase(lds, scr, S, E, wv);
        __syncthreads(); p0_prologue(a, lds, vcu, G, wv, 1);
    }
    SEAM(1);
    if (IN(2)) {
        { pg8::SchedP2 S{(const char*)ws, bx, G};
          pg8::EpiP2 E{ws};
          pg8::gemm_phase(lds, scr, S, E, wv); }
        {
            const float* c1 = AIN(I_CCKV);
            unsigned* cctr = (unsigned*)(ws + WS_CTL) + 11520 + 64 * a.li; constexpr int NC = DBATCH * 256 / 8;
            for (;;) {
                if (TIDX(wv) == 0) MISC[22] = __hip_atomic_fetch_add(cctr, 1u, __ATOMIC_RELAXED, __HIP_MEMORY_SCOPE_AGENT);
                __syncthreads();
                const int ch = (int)MISC[22];
                __syncthreads();
                if (ch >= NC) break;
                const int item = ch * 8 + wv, bb = item >> 8, kbk = (item & 255) >> 3, nb = item & 7;
                cache_item(c1 + (size_t)bb * PAST * KVRANK, WSP(bf16_t, WS_CKVB) + (size_t)bb * (CKVT_B / 2), ckvt_base(ws, bb), 64 * kbk, 32 * nb, (LAS float*)(lds + wv * 16384), lane_id(), true, bb >= NBT_A);
            }
            { const bf16_t* CKVN = WSP(bf16_t, WS_CKVN);
              for (int i = vcu * 512 + TIDX(wv); i < DBATCH * 16 * 64; i += G * 512) { const int bb = i >> 10, sb = (i >> 6) & 15, ln = i & 63;
                  const bf16_t* nk = CKVN + (size_t)(MP + bb * DSEQ) * KVRANK; const size_t fo = ((size_t)(64 * 16 + sb) * 64 + ln) * 8;
                  { const int t = ln & 31; u32x4 w = {0u, 0u, 0u, 0u}; if (t < DSEQ) w = *(const u32x4*)(nk + (size_t)t * KVRANK + 16 * sb + 8 * (ln >> 5));
                    *(u32x4*)(WSP(bf16_t, WS_CKVB) + (size_t)bb * (CKVT_B / 2) + fo) = w; }
                  { const int kq = ln >> 4; u32x4 w = {0u, 0u, 0u, 0u};
                    if (kq < 2) { const bf16_t* p = nk + (size_t)(8 * kq) * KVRANK + 16 * sb + (ln & 15);
                        w.x = p[0] | ((unsigned)p[KVRANK] << 16); w.y = p[2 * KVRANK] | ((unsigned)p[3 * KVRANK] << 16); w.z = p[4 * KVRANK] | ((unsigned)p[5 * KVRANK] << 16); w.w = p[6 * KVRANK] | ((unsigned)p[7 * KVRANK] << 16); }
                    *(u32x4*)(ckvt_base(ws, bb) + fo) = w; } } }
        }
    }
    SEAM(2);
    if (IN(3)) {
        const int qx = bx & 7; unsigned* ctr = (unsigned*)(ws + WS_CTL) + 8192 + 1024 * a.li + 64 * qx;
        for (;;) {
            if (TIDX(wv) == 0) MISC[20] = __hip_atomic_fetch_add(ctr, 1u, __ATOMIC_RELAXED, __HIP_MEMORY_SCOPE_AGENT);
            __syncthreads();
            const int it = (int)MISC[20];
            __syncthreads();
            if (it >= 98) break;
            if (it >= 64) { const int blk = (it - 64) * 8 + qx; pool_window_block(blk, WSP(bf16_t, WS_Z), WSP(bf16_t, WS_SGP), AIN(I_PSCALE), WSP(bf16_t, WS_MIX), wv); }
            else if (it >= 8 && it < 40) { const int j = it - 8, sb = qx * 4 + (j >> 3), sh = j & 7;
                sattn::unit(sb, sh, WSP(bf16_t, WS_CKVB), WSP(bf16_t, WS_KRB), WSP(bf16_t, WS_CKVN), WSP(bf16_t, WS_KRN), ckvt_base(ws, sb), WSP(bf16_t, WS_WUKV), WSP(bf16_t, WS_QCAT), WSP(bf16_t, WS_SGM), WSP(bf16_t, WS_MIX), lds, scr, wv); }
            else { const int k = it < 8 ? it : it - 32, qb = 7 - (k >> 2), bh = qx * 4 + (k & 3);
                pattn::unit(bh >> 3, bh & 7, qb, WSP(bf16_t, WS_QCAT), WSP(bf16_t, WS_KCAT), WSP(bf16_t, WS_KRN), WSP(bf16_t, WS_V), WSP(bf16_t, WS_SGM), WSP(bf16_t, WS_MIX), lds, wv); }
        }
    }
    SEAM(3);
    if (IN(4)) {
        unsigned* pcnt = (unsigned*)(ws + WS_CTL) + 13312 + 2560 * a.li;
        pg8::EpiP45 E{ws, out};
        { pg8::SchedP45 S{(const char*)ws, pcnt, bx, G, 1}; pg8::gemm_phase(lds, scr, S, E, wv); }
        { pg8::SchedP45 S{(const char*)ws, pcnt, bx, G, 2}; pg8::gemm_phase(lds, scr, S, E, wv); }
    }
#undef IN
#undef SEAM
}

extern "C" void kernel_launch(void* const* d_in, const int* in_sizes, int n_in, void* d_out, int out_size, void* d_ws, size_t ws_size, hipStream_t stream) {
    static int grid = 0;
    if (grid == 0) {
        if (n_in != 24 || in_sizes[0] != MP * DM || out_size != 21164032 || ws_size < WS_END) {
            fprintf(stderr, "kernel_launch: shape mismatch: n_in %d in0 %d out %d ws %zu (need >= %zu)\n", n_in, n_in > 0 ? in_sizes[0] : -1, out_size, ws_size, (size_t)WS_END); grid = -1; return; }
        int dev = 0, cus = 0, per_cu = 0;
        if (hipGetDevice(&dev) != hipSuccess || hipDeviceGetAttribute(&cus, hipDeviceAttributeMultiprocessorCount, dev) != hipSuccess) { fprintf(stderr, "kernel_launch: device query failed\n"); grid = -1; return; }
        if (hipFuncSetAttribute((const void*)hymba_fwd, hipFuncAttributeMaxDynamicSharedMemorySize, LDS_BYTES) != hipSuccess) { fprintf(stderr, "kernel_launch: hipFuncSetAttribute failed\n"); grid = -1; return; }
        if (hipOccupancyMaxActiveBlocksPerMultiprocessor(&per_cu, (const void*)hymba_fwd, 512, LDS_BYTES) != hipSuccess || per_cu < 1)
            fprintf(stderr, "kernel_launch: note: occupancy query reports %d workgroups per CU\n", per_cu);
        (void)hipGetLastError();
        grid = cus;
    }
    if (grid < 0) return;
    if (hipMemsetAsync((char*)d_ws + WS_CTL, 0, CTL_ZERO_BYTES, stream) != hipSuccess) { fprintf(stderr, "kernel_launch: memset failed\n"); return; }
    Args a{};
    for (int i = 0; i < 24; ++i) a.in[i] = (const float*)d_in[i];
    a.out = (float*)d_out; a.ws = (unsigned char*)d_ws;
#if MK_N_LAUNCHES == 1
    a.ph_lo = 0; a.ph_hi = N_PHASES;
    hipLaunchKernelGGL(hymba_fwd, dim3(grid), dim3(512), LDS_BYTES, stream, a);
#else
    for (int p = 0; p < N_PHASES; ++p) { a.ph_lo = p; a.ph_hi = p + 1; hipLaunchKernelGGL(hymba_fwd, dim3(grid), dim3(512), LDS_BYTES, stream, a); }
#endif
    const hipError_t le = hipPeekAtLastError();
    if (le != hipSuccess) fprintf(stderr, "kernel_launch: launch failed: %s\n", hipGetErrorName(le));
}
```

```cpp
#include <hip/hip_runtime.h>
#include <hip/hip_bf16.h>
#include <cstdio>
#include <cstdint>

#ifndef DUP_PHASE
#define DUP_PHASE -1
#endif
#ifndef MK_N_LAUNCHES
#define MK_N_LAUNCHES 1
#endif

#define LAS __attribute__((address_space(3)))
#define GAS __attribute__((address_space(1)))
typedef unsigned short bf16_t;
typedef short bf16x8 __attribute__((ext_vector_type(8)));
typedef short s16x4 __attribute__((ext_vector_type(4)));
typedef float f32x4 __attribute__((ext_vector_type(4)));
typedef float f32x16 __attribute__((ext_vector_type(16)));
typedef unsigned u32x4 __attribute__((ext_vector_type(4)));
typedef unsigned u32x2 __attribute__((ext_vector_type(2)));
typedef float f32x2_t __attribute__((ext_vector_type(2)));
typedef __bf16 bf16x2_t __attribute__((ext_vector_type(2)));

constexpr int DM = 2048, NBATCH = 4, SEQ = 2048, DBATCH = 32, DSEQ = 16, PAST = 2048;
constexpr int MP = NBATCH * SEQ, MS = DBATCH * DSEQ, MT = MP + MS;
constexpr int DPOOL = 1024, NHEAD = 8, DNOPE = 128, DROPE = 64, DV = 128, QRANK = 512, KVRANK = 256, DPLE = 256;
constexpr int DQK = DNOPE + DROPE;
constexpr int DIN = 3904, DINP = 4096;
constexpr int SKV_S = PAST + DSEQ;
constexpr int POOLH = 15;
constexpr int MZ = 9216;
constexpr float EPS = 1e-6f;
constexpr float C2 = 0.07216878364870322f * 1.4426950408889634f;
constexpr size_t O_Y = 0, O_CKVP = 17825792, O_KRP = 19922944, O_POOLP = 20447232, O_CKVS = 20508672, O_KRS = 20639744, O_POOLS = 20672512;

constexpr size_t MiB = 1u << 20;
constexpr size_t WS_CTL = 0, CTL_ZERO_BYTES = 128 * 1024;
constexpr size_t WS_WIN = 1 * MiB;
constexpr size_t WS_WUQ = 17 * MiB;
constexpr size_t WS_WUKV = 18 * MiB + MiB / 2;
constexpr size_t WS_WPOOL = 19 * MiB + MiB / 2;
constexpr size_t WS_WOUT = 20 * MiB;
constexpr size_t WS_WGATE = 28 * MiB;
constexpr size_t WS_WPLE = 36 * MiB;
constexpr size_t WS_COS = 37 * MiB;
constexpr size_t WS_SIN = 37 * MiB + MiB / 2;
constexpr size_t WS_SSQCQ = 38 * MiB;
constexpr size_t WS_SSQH = 38 * MiB + MiB / 2;
constexpr size_t WS_CKVN = 39 * MiB;
constexpr size_t WS_KRN = 43 * MiB + MiB / 2;
constexpr size_t WS_PBF = 45 * MiB;
constexpr size_t WS_XN = 49 * MiB + MiB / 2;
constexpr size_t WS_CKVB = WS_XN;
constexpr size_t WS_KRB = 227 * MiB;
constexpr int CKVT_LD = 2080; constexpr size_t CKVT_B = (size_t)KVRANK * CKVT_LD * 2; constexpr int NBT_A = 20;
constexpr size_t WS_CKVT_A = 235 * MiB, WS_CKVT_B = WS_WIN;
constexpr int NB_EARLY = 0;
constexpr size_t WS_CKVB2 = WS_CKVT_A;
constexpr size_t WS_UBF = 83 * MiB + MiB / 2;
constexpr size_t WS_CQ = 101 * MiB + MiB / 2;
constexpr size_t WS_MIX = WS_UBF;
constexpr size_t WS_SGP = 117 * MiB + MiB / 2;
constexpr size_t WS_Z = 134 * MiB + MiB / 2;
constexpr size_t WS_PV = WS_SGP;
constexpr size_t WS_SGM = 152 * MiB + MiB / 2;
constexpr size_t WS_QCAT = 169 * MiB + MiB / 2;
constexpr size_t WS_KCAT = 195 * MiB;
constexpr size_t WS_HBF = WS_QCAT;
constexpr size_t WS_V = 211 * MiB;
constexpr size_t WS_END = 256 * MiB;
static_assert(WS_MIX + (size_t)MT * DM * 2 <= WS_SGP && WS_PV + (size_t)MT * DM * 2 <= WS_SGM && WS_HBF + (size_t)MT * DM * 2 <= WS_V && WS_END <= 256 * MiB, "d_ws map");
static_assert(WS_CKVB + (size_t)DBATCH * 1064960 <= WS_UBF && WS_KRB + (size_t)DBATCH * PAST * DROPE * 2 <= WS_CKVT_A && WS_CKVT_A + NBT_A * CKVT_B <= WS_END && (DBATCH - NBT_A) * CKVT_B <= 16 * MiB && WS_V + 16 * MiB <= WS_KRB, "d_ws map (cache copies)");

constexpr int RING_BYTES = 131072;
constexpr int SCR_OFF = RING_BYTES;
constexpr int SCR_BYTES = 16384;
constexpr int MISC_OFF = SCR_OFF + SCR_BYTES;
constexpr int LDS_BYTES = 151552;

#define LDS_WAIT() asm volatile("s_waitcnt lgkmcnt(0)" ::: "memory")
#define VM_WAIT() asm volatile("s_waitcnt vmcnt(0)" ::: "memory")
#define WG_BAR() do { asm volatile("s_waitcnt lgkmcnt(0)" ::: "memory"); __builtin_amdgcn_s_barrier(); asm volatile("" ::: "memory"); } while (0)
#define SBAR() __builtin_amdgcn_sched_barrier(0)
__device__ __forceinline__ unsigned cvtpk(float lo, float hi) { f32x2_t v = {lo, hi}; bf16x2_t b = __builtin_convertvector(v, bf16x2_t); return __builtin_bit_cast(unsigned, b); }
__device__ __forceinline__ u32x4 pack8(f32x4 a, f32x4 b) { u32x4 w; w.x = cvtpk(a[0], a[1]); w.y = cvtpk(a[2], a[3]); w.z = cvtpk(b[0], b[1]); w.w = cvtpk(b[2], b[3]); return w; }
typedef __amdgpu_buffer_rsrc_t rsrc_t;
__device__ __forceinline__ rsrc_t make_rsrc(const void* p, unsigned bytes) { return __builtin_amdgcn_make_buffer_rsrc(const_cast<void*>(p), 0, bytes, 0x00020000); }
__device__ __forceinline__ void st16_wt(rsrc_t r, unsigned byteoff, u32x4 v) { __builtin_amdgcn_raw_buffer_store_b128(v, r, byteoff, 0, 16); }
__device__ __forceinline__ void st16_wt(rsrc_t r, unsigned byteoff, f32x4 v) { __builtin_amdgcn_raw_buffer_store_b128(__builtin_bit_cast(u32x4, v), r, byteoff, 0, 16); }
__device__ __forceinline__ float bf2f(unsigned short h) { return __uint_as_float((unsigned)h << 16); }
__device__ __forceinline__ float silu_f(float v) { return v / (1.f + __expf(-v)); }
__device__ __forceinline__ float sigmoid_f(float v) { return 1.f / (1.f + __expf(-v)); }
__device__ __forceinline__ float wave_sum(float v) {
#pragma unroll
    for (int o = 1; o < 64; o <<= 1) v += __shfl_xor(v, o);
    return v;
}
__device__ __forceinline__ int lane_id() { int l; asm volatile("v_mbcnt_lo_u32_b32 %0, -1, 0\n\tv_mbcnt_hi_u32_b32 %0, -1, %0" : "=v"(l)); return l; }
#define TIDX(wv) (((wv) << 6) | lane_id())
__device__ __forceinline__ int row_pos(int row) { return row < MP ? (row & (SEQ - 1)) : PAST + ((row - MP) & (DSEQ - 1)); }

#define AS4 __attribute__((address_space(4)))
__device__ __forceinline__ const float* arg_in(int k) {
    const char AS4* p = (const char AS4*)__builtin_amdgcn_kernarg_segment_ptr(); int off = k * 8; asm volatile("" : "+s"(off));
    return *(const float* const AS4*)(p + off);
}
#define AIN(k) arg_in(k)

namespace pg8 {
constexpr int BM = 256, BK = 64, HALF = 128, HTB = HALF * BK * 2, STAGE_BYTES = 8 * HTB, NXCD = 8, WGM = 8;
__host__ __device__ __forceinline__ int lds_byte(int r, int c) { const int st = (r >> 4) * 2 + (c >> 5), rr = r & 15, cc = c & 31, ob = rr * 64 + cc * 2; return st * 1024 + (ob ^ (((ob >> 9) & 1) << 5)); }
__host__ __device__ __forceinline__ void stage_rc(int b, int& R, int& C) { const int st = b / 1024, sb = b % 1024, swz = sb ^ (((sb >> 9) & 1) << 5); R = (st >> 1) * 16 + swz / 64; C = (st & 1) * 32 + (swz % 64) / 2; }
__host__ __device__ __forceinline__ int perm32(int rho) { const int n = rho >> 4, i = rho & 15; return 8 * (i >> 2) + 4 * n + (i & 3); }

struct Unit { const char* A; const char* B; int lda, ldb, nt, type, row0, pn, half, slice, uid; };
__device__ __forceinline__ void grid_map(int L, int nM, int nN, int& pm, int& pn) {
    const int nwg = nM * nN; int wgid = L; { const int q = nwg / NXCD, r = nwg % NXCD, xcd = wgid % NXCD, off = wgid / NXCD; wgid = (xcd < r ? xcd * (q + 1) : r * (q + 1) + (xcd - r) * q) + off; }
    const int nig = WGM * nN, gid = wgid / nig, fm = gid * WGM, gsz = (nM - fm) < WGM ? (nM - fm) : WGM;
    pm = fm + ((wgid % nig) % gsz); pn = (wgid % nig) / gsz;
}

template <class Sched, class Epi>
__device__ __forceinline__ void gemm_phase(LAS unsigned char* lds, LAS unsigned char* scr, const Sched& S, const Epi& E, int wv) {
    const int wid = wv, lane = lane_id(), tid = (wv << 6) | lane, wr = wid >> 2, wc = wid & 3, fr = lane & 15, fq = lane >> 4;
    Unit cur, nxt; int ui = 0;
    if (!S.get(0, cur)) return;
    int RA[2], RB[2], CC[2];
#pragma unroll
    for (int i = 0; i < 2; ++i) { int R, C; stage_rc(tid * 16 + i * 8192, R, C); RA[i] = R * 2; RB[i] = ((R & ~31) + perm32(R & 31)) * 2; CC[i] = C * 2; }
    unsigned voffA[2], voffB[2], nvA[2], nvB[2];
#pragma unroll
    for (int i = 0; i < 2; ++i) { voffA[i] = (unsigned)(RA[i] * cur.lda + CC[i]); voffB[i] = (unsigned)(RB[i] * cur.ldb + CC[i]); }
    const size_t kstep = (size_t)(BK * 2);
    unsigned hA = cur.half ? 0u : (unsigned)(HALF * cur.lda * 2), hB = (unsigned)(HALF * cur.ldb * 2);
    const unsigned ldsw = (unsigned)wid * 1024u;
    const int aoff = lds_byte(wr * 64 + fr, fq * 8), boff = lds_byte(wc * 32 + fr, fq * 8);
#define PG8_SA(b, h) (((b) * 2 + (h)) * HTB)
#define PG8_SB(b, h) ((4 + (b) * 2 + (h)) * HTB)
#define PG8_STAGE(bufoff, gbase, voff) do { _Pragma("unroll") for (int _i = 0; _i < 2; ++_i) \
        __builtin_amdgcn_global_load_lds((const unsigned*)((const char*)(gbase) + (voff)[_i]), (LAS unsigned*)(lds + (bufoff) + ldsw + _i * 8192), 16, 0, 0); } while (0)
#define PG8_LDA(dst, b, h) do { _Pragma("unroll") for (int m = 0; m < 4; ++m) _Pragma("unroll") for (int k = 0; k < 2; ++k) dst[m][k] = *(const LAS bf16x8*)(lds + PG8_SA(b, h) + aoff + m * 2048 + k * 1024); } while (0)
#define PG8_LDB(dst, b, h) do { _Pragma("unroll") for (int n = 0; n < 2; ++n) _Pragma("unroll") for (int k = 0; k < 2; ++k) dst[n][k] = *(const LAS bf16x8*)(lds + PG8_SB(b, h) + boff + n * 2048 + k * 1024); } while (0)
#define PG8_MMA(ai, bj, At, Bt) do { __builtin_amdgcn_s_setprio(1); _Pragma("unroll") for (int m = 0; m < 4; ++m) _Pragma("unroll") for (int n = 0; n < 2; ++n) _Pragma("unroll") for (int k = 0; k < 2; ++k) \
        acc[ai][bj][m][n] = __builtin_amdgcn_mfma_f32_16x16x32_bf16(Bt[n][k], At[m][k], acc[ai][bj][m][n], 0, 0, 0); __builtin_amdgcn_s_setprio(0); } while (0)
#define PG8_WAIT_V(n) asm volatile("s_waitcnt vmcnt(" #n ")" ::: "memory")
#define PG8_WAIT_L(n) asm volatile("s_waitcnt lgkmcnt(" #n ")" ::: "memory")
#define PG8_BAR __builtin_amdgcn_s_barrier()
#define PG8_SCHED __builtin_amdgcn_sched_barrier(0)
    f32x4 acc[2][2][4][2];
    { int fr_e = fr, fq_e = fq; asm volatile("" : "+v"(fr_e), "+v"(fq_e)); E.init(acc, cur, wr, wc, fr_e, fq_e); }
    bf16x8 At[4][2], B0[2][2], B1[2][2];
    const char* cA = cur.A; const char* cB = cur.B;
    int rot = ((S.c & 7) * cur.nt) >> 3, nrot = 0;
    S.a_ready(cur, wid);
    { const size_t k0 = (size_t)rot * kstep, k1 = (size_t)((rot + 1) & (cur.nt - 1)) * kstep;
    PG8_STAGE(PG8_SB(0, 0), cB + k0, voffB); PG8_STAGE(PG8_SB(0, 1), cB + hB + k0, voffB); PG8_STAGE(PG8_SA(0, 0), cA + k0, voffA); PG8_STAGE(PG8_SA(0, 1), cA + hA + k0, voffA);
    if (wr == 1) PG8_BAR;
    PG8_WAIT_V(2); PG8_BAR;
    PG8_STAGE(PG8_SB(1, 0), cB + k1, voffB); PG8_STAGE(PG8_SA(1, 0), cA + k1, voffA); PG8_STAGE(PG8_SB(1, 1), cB + hB + k1, voffB); }
    PG8_WAIT_V(6); PG8_BAR;
    for (;;) {
        const bool has_next = S.get(ui + 1, nxt);
        if (!has_next) nxt = cur;
#pragma unroll
        for (int i = 0; i < 2; ++i) { nvA[i] = (unsigned)(RA[i] * nxt.lda + CC[i]); nvB[i] = (unsigned)(RB[i] * nxt.ldb + CC[i]); }
        const unsigned nhA = nxt.half ? 0u : (unsigned)(HALF * nxt.lda * 2), nhB = (unsigned)(HALF * nxt.ldb * 2);
        const char* nA = nxt.A; const char* nB = nxt.B; nrot = ((S.c & 7) * nxt.nt) >> 3; const int nmask = nxt.nt - 1;
        int nt = __builtin_amdgcn_readfirstlane(cur.nt); asm volatile("" : "+s"(nt));
        const bool full = !cur.half;
        for (int t = 0; t < nt; t += 2) {
            const bool last = (t == nt - 2);
            if (last && has_next) S.a_ready(nxt, wid);
            const size_t o1 = (size_t)((t + 1 + rot) & (nt - 1)) * kstep;
            const size_t o2 = (size_t)(last ? (nrot & nmask) : ((t + 2 + rot) & (nt - 1))) * kstep, o3 = (size_t)(last ? ((nrot + 1) & nmask) : ((t + 3 + rot) & (nt - 1))) * kstep;
            const char* a1 = cA + o1;
            const char* a2 = (last ? nA : cA) + o2; const char* b2 = (last ? nB : cB) + o2;
            const char* a3 = (last ? nA : cA) + o3; const char* b3 = (last ? nB : cB) + o3;
            const unsigned hA2 = last ? nhA : hA, hB2 = last ? nhB : hB;
            unsigned vA2[2], vB2[2];
#pragma unroll
            for (int i = 0; i < 2; ++i) { vA2[i] = last ? nvA[i] : voffA[i]; vB2[i] = last ? nvB[i] : voffB[i]; }
            PG8_LDB(B0, 0, 0); PG8_LDB(B1, 0, 1); PG8_SCHED; PG8_LDA(At, 0, 0); PG8_STAGE(PG8_SA(1, 1), a1 + hA, voffA);
            PG8_WAIT_V(8); PG8_WAIT_L(0); PG8_BAR; PG8_MMA(0, 0, At, B0); PG8_MMA(0, 1, At, B1); PG8_BAR; PG8_SCHED;
            if (full) PG8_LDA(At, 0, 1);
            PG8_STAGE(PG8_SB(0, 0), b2, vB2); PG8_STAGE(PG8_SB(0, 1), b2 + hB2, vB2); PG8_STAGE(PG8_SA(0, 0), a2, vA2);
            PG8_WAIT_V(8); PG8_WAIT_L(0); PG8_BAR; if (full) { PG8_MMA(1, 0, At, B0); PG8_MMA(1, 1, At, B1); } PG8_BAR; PG8_SCHED;
            PG8_LDB(B0, 1, 0); PG8_LDB(B1, 1, 1); PG8_SCHED; PG8_LDA(At, 1, 0); PG8_STAGE(PG8_SA(0, 1), a2 + hA2, vA2);
            PG8_WAIT_V(8); PG8_WAIT_L(0); PG8_BAR; PG8_MMA(0, 0, At, B0); PG8_MMA(0, 1, At, B1); PG8_BAR; PG8_SCHED;
            if (full) PG8_LDA(At, 1, 1);
            PG8_STAGE(PG8_SB(1, 0), b3, vB2); PG8_STAGE(PG8_SB(1, 1), b3 + hB2, vB2); PG8_STAGE(PG8_SA(1, 0), a3, vA2);
            PG8_WAIT_V(8); PG8_WAIT_L(0); PG8_BAR; if (full) { PG8_MMA(1, 0, At, B0); PG8_MMA(1, 1, At, B1); } PG8_BAR; PG8_SCHED;
        }
        if (wr == 0) PG8_BAR;
        bool run_epi = true;
        if constexpr (Sched::SPLITK) {
            if (cur.slice >= 0) {
                constexpr int NSLICE = 4; constexpr unsigned SLABB = HALF * BM * 4;
                float* sl = S.slab(cur); const rsrc_t rs = make_rsrc(sl, NSLICE * SLABB); const unsigned lo = (unsigned)(wid * 16 * 64 + lane) * 16u;
#pragma unroll
                for (int bj = 0; bj < 2; ++bj)
#pragma unroll
                    for (int m = 0; m < 4; ++m)
#pragma unroll
                        for (int n = 0; n < 2; ++n) st16_wt(rs, (unsigned)cur.slice * SLABB + lo + (unsigned)(bj * 8 + m * 2 + n) * 1024u, acc[0][bj][m][n]);
                asm volatile("s_waitcnt vmcnt(0)" ::: "memory");
                PG8_BAR; asm volatile("" ::: "memory");
                volatile LAS unsigned* TK = (volatile LAS unsigned*)(lds + MISC_OFF) + 27;
                if (wid == 0 && lane == 0) { const unsigned old = __hip_atomic_fetch_add(S.ticket(cur), 1u, __ATOMIC_RELAXED, __HIP_MEMORY_SCOPE_AGENT);
                    if (old == NSLICE - 1) { __builtin_amdgcn_fence(__ATOMIC_ACQUIRE, "agent"); asm volatile("s_waitcnt vmcnt(0)" ::: "memory"); }
                    *TK = old; }
                asm volatile("s_waitcnt lgkmcnt(0)" ::: "memory"); PG8_BAR; asm volatile("" ::: "memory");
                run_epi = (*TK == NSLICE - 1);
                if (run_epi) {
#pragma unroll
                    for (int sp = 0; sp < NSLICE; ++sp) if (sp != cur.slice) { const char* ob = (const char*)sl + (size_t)sp * SLABB + lo;
#pragma unroll
                        for (int bj = 0; bj < 2; ++bj)
#pragma unroll
                            for (int m = 0; m < 4; ++m)
#pragma unroll
                                for (int n = 0; n < 2; ++n) acc[0][bj][m][n] += *(const f32x4*)(ob + (bj * 8 + m * 2 + n) * 1024); }
                }
                asm volatile("s_waitcnt lgkmcnt(0)" ::: "memory"); PG8_BAR; asm volatile("" ::: "memory");
            }
        }
        if (run_epi) {
        { int fr_e = fr, fq_e = fq; asm volatile("" : "+v"(fr_e), "+v"(fq_e));
          E(acc, cur, wr, wc, fr_e, fq_e, scr); }
        S.done(cur, wid);
        }
        if (!has_next) break;
        { int fr_e = fr, fq_e = fq; asm volatile("" : "+v"(fr_e), "+v"(fq_e)); E.init(acc, nxt, wr, wc, fr_e, fq_e); }
        cur = nxt; cA = nA; cB = nB; hA = nhA; hB = nhB; rot = nrot; ++ui;
#pragma unroll
        for (int i = 0; i < 2; ++i) { voffA[i] = nvA[i]; voffB[i] = nvB[i]; }
        if (wr == 1) PG8_BAR;
    }
    PG8_WAIT_V(0);
    PG8_BAR;
#undef PG8_SA
#undef PG8_SB
#undef PG8_STAGE
#undef PG8_LDA
#undef PG8_LDB
#undef PG8_MMA
#undef PG8_WAIT_V
#undef PG8_WAIT_L
#undef PG8_BAR
#undef PG8_SCHED
}

typedef f32x4 Acc[2][2][4][2];
__device__ __forceinline__ void acc_zero(Acc& acc) {
#pragma unroll
    for (int a = 0; a < 2; ++a)
#pragma unroll
        for (int b = 0; b < 2; ++b)
#pragma unroll
            for (int m = 0; m < 4; ++m)
#pragma unroll
                for (int n = 0; n < 2; ++n) acc[a][b][m][n] = (f32x4){0.f, 0.f, 0.f, 0.f};
}
#define EPI_INIT_ZERO __device__ __forceinline__ void init(Acc& acc, const Unit&, int, int, int, int) const { acc_zero(acc); }
template <int NG>
__device__ __forceinline__ void xwave_rowsum(float (&p)[NG][2][4], LAS unsigned char* scr, int wr, int wc, int fr, int fq) {
    LAS float* red = (LAS float*)scr;
    if (fq == 0) {
#pragma unroll
        for (int gq = 0; gq < NG; ++gq)
#pragma unroll
            for (int ai = 0; ai < 2; ++ai)
#pragma unroll
                for (int m = 0; m < 4; ++m) red[gq * 1024 + (ai * HALF + wr * 64 + m * 16 + fr) * 4 + wc] = p[gq][ai][m];
    }
    WG_BAR();
#pragma unroll
    for (int gq = 0; gq < NG; ++gq)
#pragma unroll
        for (int ai = 0; ai < 2; ++ai)
#pragma unroll
            for (int m = 0; m < 4; ++m) { const f32x4 v = *(const LAS f32x4*)(red + gq * 1024 + (ai * HALF + wr * 64 + m * 16 + fr) * 4); p[gq][ai][m] = (v[0] + v[1]) + (v[2] + v[3]); }
    WG_BAR();
}
__device__ __forceinline__ float sq4(f32x4 v) { return (v[0] * v[0] + v[1] * v[1]) + (v[2] * v[2] + v[3] * v[3]); }
__device__ __forceinline__ float fq_sum(float s) { s += __shfl_xor(s, 16); s += __shfl_xor(s, 32); return s; }

struct EpiBf16 {
    EPI_INIT_ZERO
    bf16_t* O; int ldc; int wt;
    __device__ __forceinline__ void operator()(Acc& acc, const Unit& u, int wr, int wc, int fr, int fq, LAS unsigned char*) const {
        const int row0 = u.row0 + wr * 64 + fr, col0 = u.pn * BM + wc * 32 + 8 * fq;
        if (wt) { const rsrc_t rO = make_rsrc(O, (unsigned)MT * DM * 2);
#pragma unroll
            for (int ai = 0; ai < 2; ++ai) if (ai == 0 || !u.half)
#pragma unroll
                for (int m = 0; m < 4; ++m) { const unsigned off = (unsigned)((row0 + ai * HALF + m * 16) * ldc + col0) * 2u;
#pragma unroll
                    for (int bj = 0; bj < 2; ++bj) st16_wt(rO, off + bj * HALF * 2, pack8(acc[ai][bj][m][0], acc[ai][bj][m][1])); }
            return; }
#pragma unroll
        for (int ai = 0; ai < 2; ++ai) if (ai == 0 || !u.half)
#pragma unroll
            for (int m = 0; m < 4; ++m) { bf16_t* rp = O + (size_t)(row0 + ai * HALF + m * 16) * ldc + col0;
#pragma unroll
                for (int bj = 0; bj < 2; ++bj) *(u32x4*)(rp + bj * HALF) = pack8(acc[ai][bj][m][0], acc[ai][bj][m][1]); }
    }
};

struct EpiInProj {
    EPI_INIT_ZERO
    unsigned char* ws; float* out;
    __device__ __forceinline__ void operator()(Acc& acc, const Unit& u, int wr, int wc, int fr, int fq, LAS unsigned char* scr) const {
        const float* kvg = arg_in(11); const float* krg = arg_in(16);
        bf16_t* UBF = (bf16_t*)(ws + WS_UBF); bf16_t* SGP = (bf16_t*)(ws + WS_SGP); bf16_t* CQ = (bf16_t*)(ws + WS_CQ); bf16_t* CKVN = (bf16_t*)(ws + WS_CKVN); bf16_t* SGM = (bf16_t*)(ws + WS_SGM); bf16_t* KRN = (bf16_t*)(ws + WS_KRN);
        float* SSQCQ = (float*)(ws + WS_SSQCQ); const float* COS = (const float*)(ws + WS_COS); const float* SIN = (const float*)(ws + WS_SIN);
        const int row0 = u.row0 + wr * 64 + fr, cl = wc * 32 + 8 * fq, pn = u.pn;
        if (pn < 4) {
            const bool tail = (((u.row0 >> 8) & 7) == 7) || (u.row0 >= MP);
#pragma unroll
            for (int ai = 0; ai < 2; ++ai) if (ai == 0 || !u.half)
#pragma unroll
                for (int m = 0; m < 4; ++m) { const int row = row0 + ai * HALF + m * 16; bf16_t* rp = UBF + (size_t)row * DPOOL + pn * BM + cl;
#pragma unroll
                    for (int bj = 0; bj < 2; ++bj) *(u32x4*)(rp + bj * HALF) = pack8(acc[ai][bj][m][0], acc[ai][bj][m][1]);
                    if (tail) { float* dst = nullptr;
                        if (row < MP) { const int t = row & (SEQ - 1), b = row >> 11; if (t >= SEQ - POOLH) dst = out + O_POOLP + (size_t)(b * POOLH + t - (SEQ - POOLH)) * DPOOL; }
                        else { const int s = row - MP, b = s >> 4, t = s & 15; if (t >= 1) dst = out + O_POOLS + (size_t)(b * POOLH + t - 1) * DPOOL; }
                        if (dst) { dst += pn * BM + cl;
#pragma unroll
                            for (int bj = 0; bj < 2; ++bj) { *(f32x4*)(dst + bj * HALF) = acc[ai][bj][m][0]; *(f32x4*)(dst + bj * HALF + 4) = acc[ai][bj][m][1]; } } } }
        } else if (pn < 8 || (pn >= 11 && pn < 15)) {
            bf16_t* G0 = pn < 8 ? SGP + (pn - 4) * BM : SGM + (pn - 11) * BM;
#pragma unroll
            for (int ai = 0; ai < 2; ++ai) if (ai == 0 || !u.half)
#pragma unroll
                for (int m = 0; m < 4; ++m) { bf16_t* rp = G0 + (size_t)(row0 + ai * HALF + m * 16) * 1024 + cl;
#pragma unroll
                    for (int bj = 0; bj < 2; ++bj) { f32x4 a = acc[ai][bj][m][0], b = acc[ai][bj][m][1];
#pragma unroll
                        for (int j = 0; j < 4; ++j) { a[j] = silu_f(a[j]); b[j] = silu_f(b[j]); }
                        *(u32x4*)(rp + bj * HALF) = pack8(a, b); } }
        } else if (pn < 10) {
#pragma unroll
            for (int ai = 0; ai < 2; ++ai) if (ai == 0 || !u.half)
#pragma unroll
                for (int m = 0; m < 4; ++m) { const int row = row0 + ai * HALF + m * 16; bf16_t* rp = CQ + (size_t)row * QRANK + (pn - 8) * BM + cl; float s = 0.f;
#pragma unroll
                    for (int bj = 0; bj < 2; ++bj) { *(u32x4*)(rp + bj * HALF) = pack8(acc[ai][bj][m][0], acc[ai][bj][m][1]); s += sq4(acc[ai][bj][m][0]) + sq4(acc[ai][bj][m][1]); }
                    s = fq_sum(s);
                    if (fq == 0) SSQCQ[(size_t)row * 8 + (pn - 8) * 4 + wc] = s; }
        } else if (pn == 10) {
            float p[1][2][4];
#pragma unroll
            for (int ai = 0; ai < 2; ++ai) if (ai == 0 || !u.half)
#pragma unroll
                for (int m = 0; m < 4; ++m) { float s = 0.f;
#pragma unroll
                    for (int bj = 0; bj < 2; ++bj) s += sq4(acc[ai][bj][m][0]) + sq4(acc[ai][bj][m][1]);
                    p[0][ai][m] = fq_sum(s); }
            xwave_rowsum<1>(p, scr, wr, wc, fr, fq);
            f32x4 gv[2][2];
#pragma unroll
            for (int bj = 0; bj < 2; ++bj) { gv[bj][0] = *(const f32x4*)(kvg + bj * HALF + cl); gv[bj][1] = *(const f32x4*)(kvg + bj * HALF + cl + 4); }
#pragma unroll
            for (int ai = 0; ai < 2; ++ai) if (ai == 0 || !u.half)
#pragma unroll
                for (int m = 0; m < 4; ++m) { const int row = row0 + ai * HALF + m * 16; const float r = 1.0f / sqrtf(p[0][ai][m] * (1.f / KVRANK) + EPS);
                    float* dst = (row < MP ? out + O_CKVP + (size_t)row * KVRANK : out + O_CKVS + (size_t)(row - MP) * KVRANK) + cl; bf16_t* rp = CKVN + (size_t)row * KVRANK + cl;
#pragma unroll
                    for (int bj = 0; bj < 2; ++bj) { const f32x4 a = acc[ai][bj][m][0] * r * gv[bj][0], b = acc[ai][bj][m][1] * r * gv[bj][1];
                        *(f32x4*)(dst + bj * HALF) = a; *(f32x4*)(dst + bj * HALF + 4) = b; *(u32x4*)(rp + bj * HALF) = pack8(a, b); } }
        } else {
            if (wc == 0) {
                f32x4 g1[2], g2[2];
#pragma unroll
                for (int n = 0; n < 2; ++n) { g1[n] = *(const f32x4*)(krg + 8 * fq + 4 * n); g2[n] = *(const f32x4*)(krg + 32 + 8 * fq + 4 * n); }
#pragma unroll
                for (int ai = 0; ai < 2; ++ai) if (ai == 0 || !u.half)
#pragma unroll
                    for (int m = 0; m < 4; ++m) { const int row = row0 + ai * HALF + m * 16; float s = 0.f;
#pragma unroll
                        for (int n = 0; n < 2; ++n) s += sq4(acc[ai][0][m][n]) + sq4(acc[ai][1][m][n]);
                        s = fq_sum(s); const float r = 1.0f / sqrtf(s * (1.f / DROPE) + EPS); const int pos = row_pos(row);
                        float* dst = (row < MP ? out + O_KRP + (size_t)row * DROPE : out + O_KRS + (size_t)(row - MP) * DROPE) + 8 * fq; bf16_t* rp = KRN + (size_t)row * DROPE + 8 * fq;
                        f32x4 o1[2], o2[2];
#pragma unroll
                        for (int n = 0; n < 2; ++n) { const f32x4 cs = *(const f32x4*)(COS + pos * 32 + 8 * fq + 4 * n), sn = *(const f32x4*)(SIN + pos * 32 + 8 * fq + 4 * n);
                            const f32x4 y1 = acc[ai][0][m][n] * r * g1[n], y2 = acc[ai][1][m][n] * r * g2[n]; o1[n] = y1 * cs - y2 * sn; o2[n] = y2 * cs + y1 * sn; }
                        *(f32x4*)(dst) = o1[0]; *(f32x4*)(dst + 4) = o1[1]; *(f32x4*)(dst + 32) = o2[0]; *(f32x4*)(dst + 36) = o2[1];
                        *(u32x4*)(rp) = pack8(o1[0], o1[1]); *(u32x4*)(rp + 32) = pack8(o2[0], o2[1]); }
            }
        }
    }
};

struct EpiQ {
    EPI_INIT_ZERO
    unsigned char* ws; const float* gqn; const float* gkn; const float* gqr;
    __device__ __forceinline__ void operator()(Acc& acc, const Unit& u, int wr, int wc, int fr, int fq, LAS unsigned char* scr) const {
        bf16_t* QCAT = (bf16_t*)(ws + WS_QCAT); const float* SSQCQ = (const float*)(ws + WS_SSQCQ); const float* COS = (const float*)(ws + WS_COS); const float* SIN = (const float*)(ws + WS_SIN);
        const int row0 = u.row0 + wr * 64 + fr, pn = u.pn;
        { f32x4 sa[2][4], sb[2][4];
#pragma unroll
          for (int ai = 0; ai < 2; ++ai) if (ai == 0 || !u.half)
#pragma unroll
              for (int m = 0; m < 4; ++m) { const float* sp = SSQCQ + (size_t)(row0 + ai * HALF + m * 16) * 8; sa[ai][m] = *(const f32x4*)sp; sb[ai][m] = *(const f32x4*)(sp + 4); }
#pragma unroll
          for (int ai = 0; ai < 2; ++ai) if (ai == 0 || !u.half)
#pragma unroll
              for (int m = 0; m < 4; ++m) { const f32x4 a = sa[ai][m], b = sb[ai][m];
                const float rq = 1.0f / sqrtf((((a[0] + a[1]) + (a[2] + a[3])) + ((b[0] + b[1]) + (b[2] + b[3]))) * (1.f / QRANK) + EPS);
#pragma unroll
                for (int bj = 0; bj < 2; ++bj)
#pragma unroll
                    for (int n = 0; n < 2; ++n) acc[ai][bj][m][n] *= rq; }
          asm volatile("" ::: "memory"); }
        if (pn < 4) {
            float p[2][2][4];
#pragma unroll
            for (int bj = 0; bj < 2; ++bj)
#pragma unroll
                for (int ai = 0; ai < 2; ++ai) if (ai == 0 || !u.half)
#pragma unroll
                    for (int m = 0; m < 4; ++m) p[bj][ai][m] = fq_sum(sq4(acc[ai][bj][m][0]) + sq4(acc[ai][bj][m][1]));
            xwave_rowsum<2>(p, scr, wr, wc, fr, fq);
            const int d0 = wc * 32 + 8 * fq; f32x4 gg[2];
#pragma unroll
            for (int n = 0; n < 2; ++n) gg[n] = *(const f32x4*)(gqn + d0 + 4 * n) * *(const f32x4*)(gkn + d0 + 4 * n) * C2;
#pragma unroll
            for (int ai = 0; ai < 2; ++ai) if (ai == 0 || !u.half)
#pragma unroll
                for (int m = 0; m < 4; ++m) { const int row = row0 + ai * HALF + m * 16;
#pragma unroll
                    for (int bj = 0; bj < 2; ++bj) { const float rn = 1.0f / sqrtf(p[bj][ai][m] * (1.f / DNOPE) + EPS);
                        *(u32x4*)(QCAT + (size_t)row * (NHEAD * DQK) + (2 * pn + bj) * DQK + d0) = pack8(acc[ai][bj][m][0] * rn * gg[0], acc[ai][bj][m][1] * rn * gg[1]); } }
        } else {
            const int hd = 4 * (pn - 4) + wc; f32x4 g1[2], g2[2];
#pragma unroll
            for (int n = 0; n < 2; ++n) { g1[n] = *(const f32x4*)(gqr + 8 * fq + 4 * n) * C2; g2[n] = *(const f32x4*)(gqr + 32 + 8 * fq + 4 * n) * C2; }
#pragma unroll
            for (int ai = 0; ai < 2; ++ai) if (ai == 0 || !u.half)
#pragma unroll
                for (int m = 0; m < 4; ++m) { const int row = row0 + ai * HALF + m * 16; float s = 0.f;
#pragma unroll
                    for (int n = 0; n < 2; ++n) s += sq4(acc[ai][0][m][n]) + sq4(acc[ai][1][m][n]);
                    s = fq_sum(s); const float r = 1.0f / sqrtf(s * (1.f / DROPE) + EPS); const int pos = row_pos(row);
                    f32x4 o1[2], o2[2];
#pragma unroll
                    for (int n = 0; n < 2; ++n) { const f32x4 cs = *(const f32x4*)(COS + pos * 32 + 8 * fq + 4 * n), sn = *(const f32x4*)(SIN + pos * 32 + 8 * fq + 4 * n);
                        const f32x4 y1 = acc[ai][0][m][n] * r * g1[n], y2 = acc[ai][1][m][n] * r * g2[n]; o1[n] = y1 * cs - y2 * sn; o2[n] = y2 * cs + y1 * sn; }
                    bf16_t* rp = QCAT + (size_t)row * (NHEAD * DQK) + hd * DQK + DNOPE + 8 * fq;
                    *(u32x4*)(rp) = pack8(o1[0], o1[1]); *(u32x4*)(rp + 32) = pack8(o2[0], o2[1]); }
        }
    }
};

struct EpiKV {
    EPI_INIT_ZERO
    unsigned char* ws;
    __device__ __forceinline__ void operator()(Acc& acc, const Unit& u, int wr, int wc, int fr, int fq, LAS unsigned char* scr) const {
        bf16_t* KCAT = (bf16_t*)(ws + WS_KCAT); bf16_t* V = (bf16_t*)(ws + WS_V);
        const int row0 = u.row0 + wr * 64 + fr, d0 = wc * 32 + 8 * fq, hd = u.pn;
        float p[1][2][4];
#pragma unroll
        for (int ai = 0; ai < 2; ++ai) if (ai == 0 || !u.half)
#pragma unroll
            for (int m = 0; m < 4; ++m) p[0][ai][m] = fq_sum(sq4(acc[ai][0][m][0]) + sq4(acc[ai][0][m][1]));
        xwave_rowsum<1>(p, scr, wr, wc, fr, fq);
#pragma unroll
        for (int ai = 0; ai < 2; ++ai) if (ai == 0 || !u.half)
#pragma unroll
            for (int m = 0; m < 4; ++m) { const int row = row0 + ai * HALF + m * 16; const float rk = 1.0f / sqrtf(p[0][ai][m] * (1.f / DNOPE) + EPS);
                *(u32x4*)(KCAT + (size_t)row * (NHEAD * DNOPE) + hd * DNOPE + d0) = pack8(acc[ai][0][m][0] * rk, acc[ai][0][m][1] * rk);
                *(u32x4*)(V + (size_t)row * (NHEAD * DV) + hd * DV + d0) = pack8(acc[ai][1][m][0], acc[ai][1][m][1]); }
    }
};

struct EpiOut {
    const float* xp; const float* xs; float* Y; unsigned char* ws;
    __device__ __forceinline__ void init(Acc& acc, const Unit& u, int wr, int wc, int fr, int fq) const {
        const int row0 = u.row0 + wr * 64 + fr, col0 = u.pn * BM + wc * 32 + 8 * fq;
#pragma unroll
        for (int ai = 0; ai < 2; ++ai)
#pragma unroll
            for (int m = 0; m < 4; ++m) { const int row = row0 + ai * HALF + m * 16; const float* xr = (row < MP ? xp + (size_t)row * DM : xs + (size_t)(row - MP) * DM) + col0;
#pragma unroll
                for (int bj = 0; bj < 2; ++bj) { if (ai == 0 || !u.half) { acc[ai][bj][m][0] = *(const f32x4*)(xr + bj * HALF); acc[ai][bj][m][1] = *(const f32x4*)(xr + bj * HALF + 4); }
                                                 else { acc[ai][bj][m][0] = (f32x4){0.f, 0.f, 0.f, 0.f}; acc[ai][bj][m][1] = (f32x4){0.f, 0.f, 0.f, 0.f}; } } }
    }
    __device__ __forceinline__ void operator()(Acc& acc, const Unit& u, int wr, int wc, int fr, int fq, LAS unsigned char* scr) const {
        float* SSQH = (float*)(ws + WS_SSQH); const rsrc_t rH = make_rsrc(ws + WS_HBF, (unsigned)MT * DM * 2);
        const int row0 = u.row0 + wr * 64 + fr, col0 = u.pn * BM + wc * 32 + 8 * fq;
        float p[1][2][4];
#pragma unroll
        for (int ai = 0; ai < 2; ++ai) if (ai == 0 || !u.half)
#pragma unroll
            for (int m = 0; m < 4; ++m) { const int row = row0 + ai * HALF + m * 16; float s = 0.f;
#pragma unroll
                for (int bj = 0; bj < 2; ++bj) { const f32x4 a = acc[ai][bj][m][0], b = acc[ai][bj][m][1];
                    const unsigned eo = (unsigned)(row * DM + col0 + bj * HALF);
                    st16_wt(rH, eo * 2u, pack8(a, b)); s += sq4(a) + sq4(b); }
                p[0][ai][m] = fq_sum(s); }
        xwave_rowsum<1>(p, scr, wr, wc, fr, fq);
        if (wc == 0 && fq == 0) {
#pragma unroll
            for (int ai = 0; ai < 2; ++ai) if (ai == 0 || !u.half)
#pragma unroll
                for (int m = 0; m < 4; ++m) __hip_atomic_store(SSQH + (size_t)(row0 + ai * HALF + m * 16) * 8 + u.pn, p[0][ai][m], __ATOMIC_RELAXED, __HIP_MEMORY_SCOPE_AGENT);
        }
    }
};

struct EpiGate {
    EPI_INIT_ZERO
    float* Y; unsigned char* ws; const float* bias;
    __device__ __forceinline__ void operator()(Acc& acc, const Unit& u, int wr, int wc, int fr, int fq, LAS unsigned char*) const {
        const bf16_t* PV = (const bf16_t*)(ws + WS_PV); const bf16_t* HB = (const bf16_t*)(ws + WS_HBF); const float* SSQH = (const float*)(ws + WS_SSQH);
        const int row0 = u.row0 + wr * 64 + fr, col0 = u.pn * BM + wc * 32 + 8 * fq;
        f32x4 bv[2][2];
#pragma unroll
        for (int bj = 0; bj < 2; ++bj) { bv[bj][0] = *(const f32x4*)(bias + col0 + bj * HALF); bv[bj][1] = *(const f32x4*)(bias + col0 + bj * HALF + 4); }
#pragma unroll
        for (int ai = 0; ai < 2; ++ai) if (ai == 0 || !u.half)
#pragma unroll
            for (int m = 0; m < 4; ++m) { const int row = row0 + ai * HALF + m * 16; const f32x4 sa = *(const f32x4*)(SSQH + (size_t)row * 8), sb = *(const f32x4*)(SSQH + (size_t)row * 8 + 4);
                const float rh = 1.0f / sqrtf((((sa[0] + sa[1]) + (sa[2] + sa[3])) + ((sb[0] + sb[1]) + (sb[2] + sb[3]))) * (1.f / DM) + EPS);
#pragma unroll
                for (int bj = 0; bj < 2; ++bj) { float* yp = Y + (size_t)row * DM + col0 + bj * HALF; const u32x4 pw = *(const u32x4*)(PV + (size_t)row * DM + col0 + bj * HALF);
                    const u32x4 hw = *(const u32x4*)(HB + (size_t)row * DM + col0 + bj * HALF);
                    f32x4 h0 = {__uint_as_float(hw.x << 16), __uint_as_float(hw.x & 0xffff0000u), __uint_as_float(hw.y << 16), __uint_as_float(hw.y & 0xffff0000u)};
                    f32x4 h1 = {__uint_as_float(hw.z << 16), __uint_as_float(hw.z & 0xffff0000u), __uint_as_float(hw.w << 16), __uint_as_float(hw.w & 0xffff0000u)}; const f32x4 g0 = acc[ai][bj][m][0] * rh + bv[bj][0], g1 = acc[ai][bj][m][1] * rh + bv[bj][1];
                    h0[0] += sigmoid_f(g0[0]) * __uint_as_float(pw.x << 16); h0[1] += sigmoid_f(g0[1]) * __uint_as_float(pw.x & 0xffff0000u);
                    h0[2] += sigmoid_f(g0[2]) * __uint_as_float(pw.y << 16); h0[3] += sigmoid_f(g0[3]) * __uint_as_float(pw.y & 0xffff0000u);
                    h1[0] += sigmoid_f(g1[0]) * __uint_as_float(pw.z << 16); h1[1] += sigmoid_f(g1[1]) * __uint_as_float(pw.z & 0xffff0000u);
                    h1[2] += sigmoid_f(g1[2]) * __uint_as_float(pw.w << 16); h1[3] += sigmoid_f(g1[3]) * __uint_as_float(pw.w & 0xffff0000u);
                    *(f32x4*)yp = h0; *(f32x4*)(yp + 4) = h1; }
                if (m & 1) asm volatile("" ::: "memory"); }
    }
};

struct SchedP1 { const char* ws; int c, G;
    static constexpr bool SPLITK = false;
    __device__ __forceinline__ float* slab(const Unit&) const { return nullptr; }
    __device__ __forceinline__ unsigned* ticket(const Unit&) const { return nullptr; }
    __device__ __forceinline__ void a_ready(const Unit&, int) const {}
    __device__ __forceinline__ void done(const Unit&, int) const {}
    __device__ __forceinline__ bool get(int i, Unit& u) const {
        constexpr int NF = 32 * 16, NH = 4 * 16; int nf = (NF - c + G - 1) / G; nf = nf < 0 ? 0 : nf;
        u.lda = DM; u.ldb = DM; u.nt = DM / BK; u.type = 0; u.slice = -1; u.uid = 0;
        if (i < nf) { int pm, pn; grid_map(c + i * G, 32, 16, pm, pn); u.row0 = pm * BM; u.pn = pn; u.half = 0; }
        else { const int t = c + (i - nf) * G; if (t >= NH) return false; u.row0 = MP + (t >> 4) * HALF; u.pn = t & 15; u.half = 1; }
        u.A = ws + WS_XN + (size_t)u.row0 * DM * 2; u.B = ws + WS_WIN + (size_t)u.pn * BM * DM * 2; return true; }
};
struct SchedP2 { const char* ws; int c, G;
    static constexpr bool SPLITK = false;
    __device__ __forceinline__ float* slab(const Unit&) const { return nullptr; }
    __device__ __forceinline__ unsigned* ticket(const Unit&) const { return nullptr; }
    __device__ __forceinline__ void a_ready(const Unit&, int) const {}
    __device__ __forceinline__ void done(const Unit&, int) const {}
    __device__ __forceinline__ bool get(int i, Unit& u) const {
        int L = c + i * G, pm, pn; u.half = 0; u.slice = -1; u.uid = 0;
        if (L < 204) { grid_map(L, 34, 6, pm, pn); u.type = 0; u.lda = QRANK; u.ldb = QRANK; u.nt = QRANK / BK; u.row0 = pm * BM; u.pn = pn;
            u.A = ws + WS_CQ + (size_t)u.row0 * QRANK * 2; u.B = ws + WS_WUQ + (size_t)pn * BM * QRANK * 2; return true; }
        L -= 204;
        if (L < 256) { grid_map(L, 32, 8, pm, pn); u.type = 1; u.lda = KVRANK; u.ldb = KVRANK; u.nt = KVRANK / BK; u.row0 = pm * BM; u.pn = pn;
            u.A = ws + WS_CKVN + (size_t)u.row0 * KVRANK * 2; u.B = ws + WS_WUKV + (size_t)pn * BM * KVRANK * 2; return true; }
        L -= 256;
        if (L < 144) { grid_map(L, 36, 4, pm, pn); u.type = 2; u.lda = DPOOL; u.ldb = 256; u.nt = 4; u.row0 = pm * BM; u.pn = pn;
            u.A = ws + WS_UBF + ((size_t)u.row0 * DPOOL + pn * 256) * 2; u.B = ws + WS_WPOOL + (size_t)pn * BM * 256 * 2; return true; }
        return false; }
};
struct EpiP2 { unsigned char* ws;
    EPI_INIT_ZERO
    __device__ __forceinline__ void operator()(Acc& acc, const Unit& u, int wr, int wc, int fr, int fq, LAS unsigned char* scr) const {
        if (u.type == 0) { const EpiQ q{ws, arg_in(13), arg_in(15), arg_in(14)}; q(acc, u, wr, wc, fr, fq, scr); }
        else if (u.type == 1) { const EpiKV kv{ws}; kv(acc, u, wr, wc, fr, fq, scr); }
        else { const EpiBf16 z{(bf16_t*)(ws + WS_Z), DPOOL, 0}; z(acc, u, wr, wc, fr, fq, scr); } }
};

struct SchedP45 { const char* ws; unsigned* cnt; int c, G, stream;
    static constexpr bool SPLITK = true;
    __device__ __forceinline__ bool warm(const Unit&) const { return false; }
    __device__ __forceinline__ int panel_of(const Unit& u) const { return u.row0 < MP ? (u.row0 >> 8) : 32 + ((u.row0 - MP) >> 7); }
    __device__ __forceinline__ float* slab(const Unit& u) const { return (float*)(ws + (u.type == 0 ? WS_SGM : WS_V)) + (size_t)u.uid * (4 * HALF * BM); }
    __device__ __forceinline__ unsigned* ticket(const Unit& u) const { return cnt + 64 * ((u.type == 0 ? 38 : 70) + u.uid); }
    __device__ __forceinline__ bool get(int i, Unit& u) const {
        constexpr int NF = 32 * 8, NS = 32 * 4, NH = 32; int pm = 0, pn = 0, type, row0, half = 0, slice = -1, uid = 0; bool ok = true;
        int nf = (NF - c + G - 1) / G; nf = nf < 0 ? 0 : nf; int ns = (NS - c + G - 1) / G; ns = ns < 0 ? 0 : ns;
        const int c2 = (c + G - (128 % G)) % G; int ns2 = (NS - c2 + G - 1) / G; ns2 = ns2 < 0 ? 0 : ns2;
        if (stream == 1) {
            if (i < 2 * nf) { grid_map(c + (i >> 1) * G, 32, 8, pm, pn); type = (i & 1) ? 1 : 0; row0 = pm * BM; }
            else if (i - 2 * nf < ns) { const int j = c + (i - 2 * nf) * G; type = 0; uid = j >> 2; slice = j & 3; row0 = MP + (uid >> 3) * HALF; pn = uid & 7; half = 1; }
            else { const int t = c2 + (i - 2 * nf - ns) * G; ok = t < NH; type = 1; row0 = MP + ((t >> 3) & 3) * HALF; pn = t & 7; half = 1; }
        } else {
            type = 2;
            if (i < nf) { grid_map(c + i * G, 32, 8, pm, pn); row0 = pm * BM; }
            else { const int j = c2 + (i - nf) * G; ok = j < NS; uid = (j >> 2) & 31; slice = j & 3; row0 = MP + (uid >> 3) * HALF; pn = uid & 7; half = 1; }
        }
        const bool ple = type == 1; const int ld = ple ? DPLE : DM; const int nt = slice >= 0 ? 8 : ld / BK; const size_t koff = slice >= 0 ? (size_t)slice * 8 * BK * 2 : 0;
        u.type = type; u.row0 = row0; u.pn = pn; u.half = half; u.slice = slice; u.uid = uid; u.lda = ld; u.ldb = ld; u.nt = nt;
        u.A = ws + (ple ? WS_PBF : (type == 0 ? WS_MIX : WS_HBF)) + (size_t)row0 * ld * 2 + koff;
        u.B = ws + (ple ? WS_WPLE : (type == 0 ? WS_WOUT : WS_WGATE)) + (size_t)pn * BM * ld * 2 + koff;
        return ok; }
    __device__ __forceinline__ void a_ready(const Unit& u, int wid) const {
        if (u.type != 2) return;
        if (wid == 0) {
            unsigned* p1 = cnt + 64 * panel_of(u); unsigned* p2 = cnt + 64 * 37; const unsigned need2 = u.half ? 32u : 0u; unsigned sp = 0;
            while ((unsigned)__builtin_amdgcn_readfirstlane(__hip_atomic_load(p1, __ATOMIC_RELAXED, __HIP_MEMORY_SCOPE_AGENT)) < 8u ||
                   (unsigned)__builtin_amdgcn_readfirstlane(__hip_atomic_load(p2, __ATOMIC_RELAXED, __HIP_MEMORY_SCOPE_AGENT)) < need2) { __builtin_amdgcn_s_sleep(2); if (++sp > (1u << 24)) break; }
            __builtin_amdgcn_fence(__ATOMIC_ACQUIRE, "agent");
            asm volatile("s_waitcnt vmcnt(0)" ::: "memory");
        }
        asm volatile("" ::: "memory"); __builtin_amdgcn_s_barrier(); asm volatile("" ::: "memory");
    }
    __device__ __forceinline__ void done(const Unit& u, int wid) const {
        if (u.type == 2 || (u.type == 1 && !u.half)) return;
        asm volatile("s_waitcnt vmcnt(0)" ::: "memory");
        __builtin_amdgcn_s_barrier(); asm volatile("" ::: "memory");
        if (wid == 0 && lane_id() == 0) __hip_atomic_fetch_add(cnt + 64 * (u.type == 1 ? 37 : panel_of(u)), 1u, __ATOMIC_RELAXED, __HIP_MEMORY_SCOPE_AGENT);
    }
};
struct EpiP45 { unsigned char* ws; float* out;
    __device__ __forceinline__ void init(Acc& acc, const Unit& u, int wr, int wc, int fr, int fq) const {
        if (u.type == 0 && u.slice <= 0) { const EpiOut o{arg_in(0), arg_in(1), out + O_Y, ws}; o.init(acc, u, wr, wc, fr, fq); } else acc_zero(acc); }
    __device__ __forceinline__ void operator()(Acc& acc, const Unit& u, int wr, int wc, int fr, int fq, LAS unsigned char* scr) const {
        if (u.type == 0) { const EpiOut o{nullptr, nullptr, out + O_Y, ws}; o(acc, u, wr, wc, fr, fq, scr); }
        else if (u.type == 1) { const EpiBf16 e{(bf16_t*)(ws + WS_PV), DM, u.half}; e(acc, u, wr, wc, fr, fq, scr); }
        else { const EpiGate g{out + O_Y, ws, arg_in(22)}; g(acc, u, wr, wc, fr, fq, scr); } }
};
}

struct Args { const float* in[24]; float* out; unsigned char* ws; int ph_lo, ph_hi, li, pad; };
enum { I_XP = 0, I_XS, I_CCKV, I_CKR, I_SPOOL, I_PP, I_PS, I_NORMG, I_WIN, I_QNG, I_WUQ, I_KVNG, I_WUKV, I_QNOPEG, I_QROPEG, I_KNOPEG, I_KROPEG, I_WPOOL, I_PSCALE, I_WOUT, I_PLENG, I_WGATE, I_BGATE, I_WPLE };


__device__ __forceinline__ void cache_item(const float* W, bf16_t* CB, bf16_t* CT, int k0, int n0, LAS float* scr, int lane, bool doB, bool doT) {
    float tv[32];
#pragma unroll
    for (int i = 0; i < 32; ++i) tv[i] = W[(size_t)(k0 + 2 * i + (lane >> 5)) * KVRANK + n0 + (lane & 31)];
#pragma unroll
    for (int i = 0; i < 32; ++i) scr[(2 * i + (lane >> 5)) * 33 + (lane & 31)] = tv[i];
    LDS_WAIT(); asm volatile("" ::: "memory");
    const int kb0 = k0 >> 5, s0 = n0 >> 4;
#pragma unroll
    for (int c = 0; c < 4; ++c) { const int kbl = c >> 1, sl = c & 1;
        if (doB) { const LAS float* p = scr + (kbl * 32 + (lane & 31)) * 33 + sl * 16 + 8 * (lane >> 5);
          u32x4 o; o.x = cvtpk(p[0], p[1]); o.y = cvtpk(p[2], p[3]); o.z = cvtpk(p[4], p[5]); o.w = cvtpk(p[6], p[7]);
          *(u32x4*)(CB + ((size_t)((kb0 + kbl) * 16 + s0 + sl) * 64 + lane) * 8) = o; }
        if (doT) { const LAS float* p = scr + (kbl * 32 + 8 * (lane >> 4)) * 33 + sl * 16 + (lane & 15);
          u32x4 o; o.x = cvtpk(p[0 * 33], p[1 * 33]); o.y = cvtpk(p[2 * 33], p[3 * 33]); o.z = cvtpk(p[4 * 33], p[5 * 33]); o.w = cvtpk(p[6 * 33], p[7 * 33]);
          *(u32x4*)(CT + ((size_t)((kb0 + kbl) * 16 + s0 + sl) * 64 + lane) * 8) = o; } }
    LDS_WAIT(); asm volatile("" ::: "memory");
}
__device__ __forceinline__ bf16_t* ckvt_base(unsigned char* ws, int b) { return (bf16_t*)(ws + (b < NBT_A ? WS_CKVT_A + (size_t)b * CKVT_B : WS_CKVT_B + (size_t)(b - NBT_A) * CKVT_B)); }

__device__ __forceinline__ void transpose_item(const float* W, int N, bf16_t* WT, int ldt, int k0, int n0, int drow0, const float* kgain, LAS float* scr, int lane) {
    float tv[32];
#pragma unroll
    for (int i = 0; i < 32; ++i) tv[i] = W[(size_t)(k0 + 2 * i + (lane >> 5)) * N + n0 + (lane & 31)];
    if (kgain) {
#pragma unroll
        for (int i = 0; i < 32; ++i) tv[i] *= kgain[k0 + 2 * i + (lane >> 5)]; }
#pragma unroll
    for (int i = 0; i < 32; ++i) scr[(2 * i + (lane >> 5)) * 33 + (lane & 31)] = tv[i];
    LDS_WAIT(); asm volatile("" ::: "memory");
    const int c = lane & 7;
#pragma unroll
    for (int j = 0; j < 4; ++j) { const int n = (lane >> 3) + 8 * j; const LAS float* s = scr + (8 * c) * 33 + n;
        u32x4 o; o.x = cvtpk(s[0 * 33], s[1 * 33]); o.y = cvtpk(s[2 * 33], s[3 * 33]); o.z = cvtpk(s[4 * 33], s[5 * 33]); o.w = cvtpk(s[6 * 33], s[7 * 33]);
        *(u32x4*)(WT + (size_t)(drow0 + n) * ldt + k0 + 8 * c) = o; }
    LDS_WAIT(); asm volatile("" ::: "memory");
}

__device__ __forceinline__ void p0_prologue(const Args& a, LAS unsigned char* lds, int vcu, int G, int wv, int part) {
    const int lane = lane_id(), wave = wv, tid = (wv << 6) | lane;
    LAS float* scr = (LAS float*)(lds + wave * 16384);
    const int gw = vcu * 8 + wave, NGW = G * 8;
    unsigned char* ws = a.ws;
    bf16_t* Win_t = (bf16_t*)(ws + WS_WIN);
    const int gt = vcu * 512 + tid, NGT = G * 512;
    if (part == 0) {
        constexpr int I_IN = 32 * 122;
        { const float* W = AIN(I_WIN);
          for (int r = gw; r < I_IN; r += NGW) { const int kb = r / 122, nb = r % 122, n0 = 32 * nb; const int d = n0 < 2816 ? n0 : (n0 == 2816 ? 3840 : (n0 == 2848 ? 3968 : n0 - 64));
              transpose_item(W, DIN, Win_t, DM, 64 * kb, n0, d, nullptr, scr, lane); } }
        {
            bf16_t* XN = (bf16_t*)(ws + WS_XN); const float* gp = AIN(I_NORMG); const float* xp = AIN(I_XP); const float* xs = AIN(I_XS);
            for (int m = gw; m < MT; m += NGW) {
                const float* xr = (m < MP ? xp + (size_t)m * DM : xs + (size_t)(m - MP) * DM) + 4 * lane;
                f32x4 v[8]; float sm = 0.f;
#pragma unroll
                for (int j = 0; j < 8; ++j) { v[j] = *(const f32x4*)(xr + 256 * j); sm += pg8::sq4(v[j]); }
                const float r = 1.0f / sqrtf(wave_sum(sm) * (1.f / DM) + EPS);
#pragma unroll
                for (int j = 0; j < 8; ++j) { const f32x4 gv = *(const f32x4*)(gp + 4 * lane + 256 * j); const f32x4 o = v[j] * r * gv;
                    u32x2 w; w.x = cvtpk(o[0], o[1]); w.y = cvtpk(o[2], o[3]); *(u32x2*)(XN + (size_t)m * DM + 4 * lane + 256 * j) = w; }
            }
        }
        {
            float* COS = (float*)(ws + WS_COS); float* SIN = (float*)(ws + WS_SIN);
            for (int i = tid * G + vcu; i < SKV_S * 32; i += 512 * G) { const int pos = i >> 5, fi = i & 31; const float inv = (float)exp(-(double)fi * (1.0 / 32.0) * 9.210340371976184); const float ang = (float)pos * inv;
                float sv, cv; sincosf(ang, &sv, &cv); COS[i] = cv; SIN[i] = sv; }
        }
        {
            for (int i = gt; i < 192 * (DM / 8); i += NGT) { const int rr = i >> 8, c = (i & 255) * 8; const int row = 3840 + (rr < 96 ? 32 + rr : 160 + (rr - 96));
                *(u32x4*)(Win_t + (size_t)row * DM + c) = (u32x4){0u, 0u, 0u, 0u}; }
        }
        return;
    }
    bf16_t* Wuq_t = (bf16_t*)(ws + WS_WUQ); bf16_t* Wukv_t = (bf16_t*)(ws + WS_WUKV); bf16_t* Wpool_t = (bf16_t*)(ws + WS_WPOOL);
    bf16_t* Wout_t = (bf16_t*)(ws + WS_WOUT); bf16_t* Wgate_t = (bf16_t*)(ws + WS_WGATE); bf16_t* Wple_t = (bf16_t*)(ws + WS_WPLE);
    constexpr int I_UQ = 8 * 48, I_UKV = 4 * 64, I_POOL = 4 * 4 * 8, I_OUT = 32 * 64, I_GATE = 32 * 64, I_PLE = 4 * 64;
    constexpr int NITEMS = I_UQ + I_UKV + I_POOL + I_OUT + I_GATE + I_PLE;
    static_assert(NITEMS == 5120, "chunk map");
    unsigned* cctr = (unsigned*)(ws + WS_CTL) + 11776 + 64 * a.li;
    volatile LAS unsigned* MISCp = (volatile LAS unsigned*)(lds + MISC_OFF);
    for (;;) {
        if (tid == 0) MISCp[23] = __hip_atomic_fetch_add(cctr, 1u, __ATOMIC_RELAXED, __HIP_MEMORY_SCOPE_AGENT);
        __syncthreads();
        const int ch = (int)MISCp[23];
        __syncthreads();
        if (ch >= 852 + NBT_A * 32) break;
        if (ch >= 852) { const int item = (ch - 852) * 8 + wave, bb = item >> 8, kbk = (item & 255) >> 3, nb = item & 7;
            cache_item(AIN(I_CCKV) + (size_t)bb * PAST * KVRANK, nullptr, ckvt_base(ws, bb), 64 * kbk, 32 * nb, scr, lane, false, true); continue; }
        if (ch < 640) {
            int r = ch * 8 + wave;
            if (r < I_UQ) { const int kb = r / 48, nb = r % 48, n0 = 32 * nb, h = n0 / DQK, j0 = n0 % DQK;
                const int d = j0 < 128 ? h * 128 + j0 : 1024 + 256 * (h >> 2) + 32 * (h & 3) + (j0 == 160 ? 128 : 0);
                transpose_item(AIN(I_WUQ), NHEAD * DQK, Wuq_t, QRANK, 64 * kb, n0, d, AIN(I_QNG), scr, lane); continue; } r -= I_UQ;
            if (r < I_UKV) { const int kb = r / 64, nb = r % 64; transpose_item(AIN(I_WUKV), 2048, Wukv_t, KVRANK, 64 * kb, 32 * nb, 32 * nb, nullptr, scr, lane); continue; } r -= I_UKV;
            if (r < I_POOL) { const int gq = r / 32, kb = (r % 32) / 8, nb = r % 8; transpose_item(AIN(I_WPOOL) + (size_t)gq * 65536, 256, Wpool_t, 256, 64 * kb, 32 * nb, gq * 256 + 32 * nb, nullptr, scr, lane); continue; } r -= I_POOL;
            if (r < I_OUT) { const int kb = r / 64, nb = r % 64; transpose_item(AIN(I_WOUT), DM, Wout_t, DM, 64 * kb, 32 * nb, 32 * nb, nullptr, scr, lane); continue; } r -= I_OUT;
            if (r < I_GATE) { const int kb = r / 64, nb = r % 64; transpose_item(AIN(I_WGATE), DM, Wgate_t, DM, 64 * kb, 32 * nb, 32 * nb, AIN(I_PLENG), scr, lane); continue; } r -= I_GATE;
            { const int kb = r / 64, nb = r % 64; transpose_item(AIN(I_WPLE), DM, Wple_t, DPLE, 64 * kb, 32 * nb, 32 * nb, nullptr, scr, lane); }
        } else if (ch < 708) {
            bf16_t* PBF = (bf16_t*)(ws + WS_PBF); const float* pp = AIN(I_PP); const float* ps = AIN(I_PS);
#pragma unroll
            for (int k = 0; k < 8; ++k) { const int i = (ch - 640) * 4096 + tid + k * 512, m = i >> 5, c = (i & 31) * 8; const float* src = (m < MP ? pp + (size_t)m * DPLE : ps + (size_t)(m - MP) * DPLE) + c;
                *(u32x4*)(PBF + (size_t)m * DPLE + c) = pack8(*(const f32x4*)src, *(const f32x4*)(src + 4)); }
        } else if (ch < 724) {
            bf16_t* UBF = (bf16_t*)(ws + WS_UBF); const float* sp = AIN(I_SPOOL);
#pragma unroll
            for (int k = 0; k < 8; ++k) { const int i = (ch - 708) * 4096 + tid + k * 512, rr = i >> 7, c = (i & 127) * 8; u32x4 w = {0u, 0u, 0u, 0u};
                if (rr < DBATCH * POOLH) { const float* src = sp + (size_t)rr * DPOOL + c; w = pack8(*(const f32x4*)src, *(const f32x4*)(src + 4)); }
                *(u32x4*)(UBF + (size_t)(MT + rr) * DPOOL + c) = w; }
        } else {
            const float* src = AIN(I_CKR) + (size_t)(ch - 724) * 32768; bf16_t* dst = (bf16_t*)(ws + WS_KRB) + (size_t)(ch - 724) * 32768;
#pragma unroll
            for (int k = 0; k < 8; ++k) { const int o = tid * 8 + k * 4096; *(u32x4*)(dst + o) = pack8(*(const f32x4*)(src + o), *(const f32x4*)(src + o + 4)); }
        }
    }
}

namespace pattn {
constexpr int KVBLK = 64, NW = 8, QBLK = 32;
constexpr int SHM_V = 16384, SHM_KN = 16384, SHM_KR = 8192;
constexpr int L_V = 0, L_KN = 2 * SHM_V, L_KR = L_KN + 2 * SHM_KN, L_WS = L_KR + 2 * SHM_KR, L_END = L_WS + NW * 64 * 4;
constexpr int LDQ = NHEAD * DQK, LDK = NHEAD * DNOPE, LDV = NHEAD * DV;
constexpr float THR = 4.0f;
#define KSWZ(row, colB) ((row) * 256 + ((colB) ^ (((row) & 7) << 4)))
#define RSWZ(row, colB) ((row) * 128 + ((colB) ^ (((row) & 7) << 4)))
__device__ __forceinline__ int crow(int r, int hi) { return (r & 3) + 8 * (r >> 2) + 4 * hi; }

__device__ __forceinline__ void partialSM(f32x16& p0, f32x16& p1, float& m_reg, float& alpha) {
    float pmax = p0[0];
#pragma unroll
    for (int r = 1; r < 16; ++r) pmax = fmaxf(pmax, p0[r]);
#pragma unroll
    for (int r = 0; r < 16; ++r) pmax = fmaxf(pmax, p1[r]);
    { auto rr = __builtin_amdgcn_permlane32_swap(__float_as_uint(pmax), __float_as_uint(pmax), false, false); pmax = fmaxf(__uint_as_float(rr[0]), __uint_as_float(rr[1])); }
    float mn;
    if (__builtin_expect(__all(pmax - m_reg <= THR), 1)) { mn = m_reg; alpha = 1.f; }
    else { mn = fmaxf(m_reg, pmax); alpha = __builtin_amdgcn_exp2f(m_reg - mn); m_reg = mn; }
#pragma unroll
    for (int r = 0; r < 16; ++r) p0[r] = p0[r] - mn;
#pragma unroll
    for (int r = 0; r < 16; ++r) p1[r] = p1[r] - mn;
#pragma unroll
    for (int r = 0; r < 16; ++r) p0[r] = __builtin_amdgcn_exp2f(p0[r]);
}
__device__ __forceinline__ void finishSM(f32x16& p0, f32x16& p1, float alpha, float& l_reg, bf16x8& pa0, bf16x8& pa1, bf16x8& pa2, bf16x8& pa3) {
#pragma unroll
    for (int r = 0; r < 16; ++r) p1[r] = __builtin_amdgcn_exp2f(p1[r]);
    float ps = 0;
#pragma unroll
    for (int r = 0; r < 16; ++r) ps += p0[r];
#pragma unroll
    for (int r = 0; r < 16; ++r) ps += p1[r];
    { auto rr = __builtin_amdgcn_permlane32_swap(__float_as_uint(ps), __float_as_uint(ps), false, false); ps = __uint_as_float(rr[0]) + __uint_as_float(rr[1]); }
    l_reg = l_reg * alpha + ps;
#define PK4(P, BASE, OUT) do { unsigned a0 = cvtpk(P[BASE + 0], P[BASE + 1]), a1 = cvtpk(P[BASE + 2], P[BASE + 3]);   \
    unsigned b0 = cvtpk(P[BASE + 4], P[BASE + 5]), b1 = cvtpk(P[BASE + 6], P[BASE + 7]);                              \
    auto r0 = __builtin_amdgcn_permlane32_swap(a0, b0, false, false); auto r1 = __builtin_amdgcn_permlane32_swap(a1, b1, false, false); \
    u32x4 w = {r0[0], r1[0], r0[1], r1[1]}; OUT = __builtin_bit_cast(bf16x8, w); } while (0)
    PK4(p0, 0, pa0); PK4(p0, 8, pa1); PK4(p1, 0, pa2); PK4(p1, 8, pa3);
#undef PK4
}
__device__ __forceinline__ void qkt(f32x16& p0, f32x16& p1, LAS const unsigned char* Kn, LAS const unsigned char* Kr, const bf16x8* qr, int r32, int hi) {
    p0 = f32x16{}; p1 = f32x16{};
#pragma unroll
    for (int d0 = 0; d0 < 8; ++d0) { const int cb = (d0 * 16 + hi * 8) * 2;
        const bf16x8 b0 = *(LAS const bf16x8*)(Kn + KSWZ(r32, cb)); const bf16x8 b1 = *(LAS const bf16x8*)(Kn + KSWZ(32 + r32, cb));
        p0 = __builtin_amdgcn_mfma_f32_32x32x16_bf16(b0, qr[d0], p0, 0, 0, 0); p1 = __builtin_amdgcn_mfma_f32_32x32x16_bf16(b1, qr[d0], p1, 0, 0, 0); }
#pragma unroll
    for (int d0 = 0; d0 < 4; ++d0) { const int cb = (d0 * 16 + hi * 8) * 2;
        const bf16x8 b0 = *(LAS const bf16x8*)(Kr + RSWZ(r32, cb)); const bf16x8 b1 = *(LAS const bf16x8*)(Kr + RSWZ(32 + r32, cb));
        p0 = __builtin_amdgcn_mfma_f32_32x32x16_bf16(b0, qr[8 + d0], p0, 0, 0, 0); p1 = __builtin_amdgcn_mfma_f32_32x32x16_bf16(b1, qr[8 + d0], p1, 0, 0, 0); }
}
__device__ __forceinline__ int v_st(int k, int c) { const int kk = (k & ~0xC) | ((k & 4) << 1) | ((k & 8) >> 1); return ((kk >> 3) * 4 + (c >> 5)) * 512 + ((kk & 7) * 32 + (c & 31)) * 2; }
__device__ __forceinline__ int v_rd_base(int lane) { return ((lane & 3) << 3) | (((lane >> 2) & 3) << 6) | (((lane >> 4) & 1) << 5) | (((lane >> 5) & 1) << 8); }
constexpr int v_rd_off(int d0, int ks, int half) { return d0 * 512 + ks * 4096 + half * 2048; }
template <int OFF> __device__ __forceinline__ s16x4 tr_read(int vb) { s16x4 r; asm volatile("ds_read_b64_tr_b16 %0, %1 offset:%2" : "=&v"(r) : "v"(vb), "i"(OFF) : "memory"); return r; }
template <int D0> __device__ __forceinline__ void pv_one(f32x16& od, int vb, bf16x8 pa0, bf16x8 pa1, bf16x8 pa2, bf16x8 pa3) {
    const s16x4 l0 = tr_read<v_rd_off(D0, 0, 0)>(vb), h0 = tr_read<v_rd_off(D0, 0, 1)>(vb), l1 = tr_read<v_rd_off(D0, 1, 0)>(vb), h1 = tr_read<v_rd_off(D0, 1, 1)>(vb);
    const s16x4 l2 = tr_read<v_rd_off(D0, 2, 0)>(vb), h2 = tr_read<v_rd_off(D0, 2, 1)>(vb), l3 = tr_read<v_rd_off(D0, 3, 0)>(vb), h3 = tr_read<v_rd_off(D0, 3, 1)>(vb);
    asm volatile("s_waitcnt lgkmcnt(0)" ::: "memory"); SBAR();
#define PK(L, H) (bf16x8){L[0], L[1], L[2], L[3], H[0], H[1], H[2], H[3]}
    od = __builtin_amdgcn_mfma_f32_32x32x16_bf16(pa0, PK(l0, h0), od, 0, 0, 0);
    od = __builtin_amdgcn_mfma_f32_32x32x16_bf16(pa1, PK(l1, h1), od, 0, 0, 0);
    od = __builtin_amdgcn_mfma_f32_32x32x16_bf16(pa2, PK(l2, h2), od, 0, 0, 0);
    od = __builtin_amdgcn_mfma_f32_32x32x16_bf16(pa3, PK(l3, h3), od, 0, 0, 0);
#undef PK
}
__device__ __forceinline__ void pv_d0(f32x16* o, int vb, bf16x8 pa0, bf16x8 pa1, bf16x8 pa2, bf16x8 pa3) {
    pv_one<0>(o[0], vb, pa0, pa1, pa2, pa3); pv_one<1>(o[1], vb, pa0, pa1, pa2, pa3); pv_one<2>(o[2], vb, pa0, pa1, pa2, pa3); pv_one<3>(o[3], vb, pa0, pa1, pa2, pa3);
}

__device__ __forceinline__ void unit(int b, int h, int qb, const bf16_t* __restrict__ QCAT, const bf16_t* __restrict__ KCAT, const bf16_t* __restrict__ KRN, const bf16_t* __restrict__ Vb, const bf16_t* __restrict__ SGM, bf16_t* MIX, LAS unsigned char* lds, int wv) {
    int lane = lane_id(); asm volatile("" : "+v"(lane));
    const int wid = wv, tid = (wv << 6) | lane, r32 = lane & 31, hi = lane >> 5;
    const long rowbase = (long)b * SEQ; const int q0 = qb * 256;
    LAS unsigned char* V_lds = lds + L_V; LAS unsigned char* KN_lds = lds + L_KN; LAS unsigned char* KR_lds = lds + L_KR;
    LAS float* wsf = (LAS float*)(lds + L_WS) + wid * 64; LAS float* li_l = wsf; LAS float* al_l = wsf + 32;
    const bf16_t* Kh = KCAT + rowbase * LDK + h * DNOPE; const bf16_t* Vh = Vb + rowbase * LDV + h * DV; const bf16_t* Kr = KRN + rowbase * DROPE;
    float m_reg = -1e30f, l_reg = 0.f; f32x16 o[4]; o[0] = f32x16{}; o[1] = f32x16{}; o[2] = f32x16{}; o[3] = f32x16{};
    bf16x8 qr[12];
    { const bf16_t* Qw = QCAT + (rowbase + q0 + wid * QBLK + r32) * LDQ + h * DQK + hi * 8;
#pragma unroll
      for (int d0 = 0; d0 < 12; ++d0) qr[d0] = *(const bf16x8*)(Qw + d0 * 16); }
    const int cw = 4 * qb + (wid >> 1);
    const int NT = 4 * qb + 4;
    const int sr = tid >> 4, sc = (tid & 15) * 8, vst0 = v_st(sr, sc), vst1 = v_st(32 + sr, sc);
    const int krr = tid >> 3, krc = (tid & 7) * 8;
    const int vb0 = (int)(uintptr_t)V_lds + v_rd_base(lane);
    bf16x8 sv0, sv1, sk0, sk1, skr;
#define SLOAD(k0) do { sv0 = *(const bf16x8*)(Vh + (long)((k0) + sr) * LDV + sc); sv1 = *(const bf16x8*)(Vh + (long)((k0) + 32 + sr) * LDV + sc); \
    sk0 = *(const bf16x8*)(Kh + (long)((k0) + sr) * LDK + sc); sk1 = *(const bf16x8*)(Kh + (long)((k0) + 32 + sr) * LDK + sc); \
    skr = *(const bf16x8*)(Kr + (long)((k0) + krr) * DROPE + krc); } while (0)
#define SWRITE(bb) do { *(LAS bf16x8*)(V_lds + (bb) * SHM_V + vst0) = sv0; *(LAS bf16x8*)(V_lds + (bb) * SHM_V + vst1) = sv1; \
    *(LAS bf16x8*)(KN_lds + (bb) * SHM_KN + KSWZ(sr, sc * 2)) = sk0; *(LAS bf16x8*)(KN_lds + (bb) * SHM_KN + KSWZ(32 + sr, sc * 2)) = sk1; \
    *(LAS bf16x8*)(KR_lds + (bb) * SHM_KR + RSWZ(krr, krc * 2)) = skr; } while (0)
#define RESC(a) do { if (__any((a) < 1.f)) { if (hi == 0) al_l[r32] = (a); asm volatile("s_waitcnt lgkmcnt(0)" ::: "memory"); \
    _Pragma("unroll") for (int d = 0; d < 4; ++d) _Pragma("unroll") for (int r = 0; r < 16; ++r) o[d][r] *= al_l[crow(r, hi)]; } } while (0)
#define QKT(P0, P1, bb, j) do { if ((j) <= cw) qkt(P0, P1, KN_lds + (bb) * SHM_KN, KR_lds + (bb) * SHM_KR, qr, r32, hi); \
    else { _Pragma("unroll") for (int r = 0; r < 16; ++r) { P0[r] = -1e30f; P1[r] = -1e30f; } } } while (0)
#define PV(bb, j) do { if ((j) <= cw) pv_d0(o, vb0 + (bb) * SHM_V, pa0, pa1, pa2, pa3); } while (0)
    f32x16 pA0, pA1, pB0, pB1; float alA, alB; bf16x8 pa0, pa1, pa2, pa3;
    SLOAD(0); SWRITE(0); __syncthreads();
    QKT(pA0, pA1, 0, 0); partialSM(pA0, pA1, m_reg, alA);
    SLOAD(KVBLK); SWRITE(1); __syncthreads();
    for (int j = 1; j + 1 < NT; j += 2) {
        SBAR(); QKT(pB0, pB1, 1, j);
        finishSM(pA0, pA1, alA, l_reg, pa0, pa1, pa2, pa3); SBAR();
        SLOAD((j + 1) * KVBLK); SBAR();
        PV(0, j - 1); partialSM(pB0, pB1, m_reg, alB);
        __syncthreads(); SWRITE(0);
        RESC(alB); __syncthreads();
        SBAR(); QKT(pA0, pA1, 0, j + 1);
        finishSM(pB0, pB1, alB, l_reg, pa0, pa1, pa2, pa3); SBAR();
        SLOAD((j + 2) * KVBLK); SBAR();
        PV(1, j); partialSM(pA0, pA1, m_reg, alA);
        __syncthreads(); SWRITE(1);
        RESC(alA); __syncthreads();
    }
    SBAR(); QKT(pB0, pB1, 1, NT - 1);
    finishSM(pA0, pA1, alA, l_reg, pa0, pa1, pa2, pa3); SBAR();
    PV(0, NT - 2); partialSM(pB0, pB1, m_reg, alB);
    __syncthreads(); RESC(alB);
    finishSM(pB0, pB1, alB, l_reg, pa0, pa1, pa2, pa3); SBAR();
    PV(1, NT - 1);
    if (hi == 0) li_l[r32] = l_reg; asm volatile("s_waitcnt lgkmcnt(0)" ::: "memory");
    float rli[16];
#pragma unroll
    for (int r = 0; r < 16; ++r) rli[r] = __builtin_amdgcn_rcpf(li_l[crow(r, hi)]);
    __syncthreads();
    LAS bf16_t* stg = (LAS bf16_t*)(lds + wid * 8192);
#pragma unroll
    for (int r = 0; r < 16; ++r) { const int orow = crow(r, hi);
#pragma unroll
        for (int d0 = 0; d0 < 4; ++d0) { const float v = o[d0][r] * rli[r]; stg[orow * 128 + d0 * 32 + r32] = (bf16_t)(cvtpk(v, 0.f) & 0xffffu); } }
    asm volatile("s_waitcnt lgkmcnt(0)" ::: "memory");
    const long orow0 = rowbase + q0 + wid * QBLK;
#pragma unroll
    for (int i = 0; i < 8; ++i) { const int row = i * 4 + (lane >> 4), ch = lane & 15; const u32x4 v = *(LAS const u32x4*)(stg + row * 128 + ch * 8);
        const u32x4 gq = *(const u32x4*)(SGM + (orow0 + row) * 1024 + h * DV + ch * 8); u32x4 w;
        w.x = cvtpk(__uint_as_float(v.x << 16) * __uint_as_float(gq.x << 16), __uint_as_float(v.x & 0xffff0000u) * __uint_as_float(gq.x & 0xffff0000u));
        w.y = cvtpk(__uint_as_float(v.y << 16) * __uint_as_float(gq.y << 16), __uint_as_float(v.y & 0xffff0000u) * __uint_as_float(gq.y & 0xffff0000u));
        w.z = cvtpk(__uint_as_float(v.z << 16) * __uint_as_float(gq.z << 16), __uint_as_float(v.z & 0xffff0000u) * __uint_as_float(gq.z & 0xffff0000u));
        w.w = cvtpk(__uint_as_float(v.w << 16) * __uint_as_float(gq.w << 16), __uint_as_float(v.w & 0xffff0000u) * __uint_as_float(gq.w & 0xffff0000u));
        *(u32x4*)(MIX + (orow0 + row) * DM + DPOOL + h * DV + ch * 8) = w; }
    __syncthreads();
#undef SLOAD
#undef SWRITE
#undef RESC
#undef QKT
#undef PV
}
}

namespace sattn {
__device__ __forceinline__ int crow(int r, int hi) { return (r & 3) + 8 * (r >> 2) + 4 * hi; }
__device__ __forceinline__ bf16x8 packf8(const f32x16& a, int base, float s) {
    u32x4 w; w.x = cvtpk(a[base + 0] * s, a[base + 1] * s); w.y = cvtpk(a[base + 2] * s, a[base + 3] * s); w.z = cvtpk(a[base + 4] * s, a[base + 5] * s); w.w = cvtpk(a[base + 6] * s, a[base + 7] * s);
    return __builtin_bit_cast(bf16x8, w);
}
constexpr int NKB = (SKV_S + 31) / 32;
constexpr int WROW = 528;
constexpr int PS_OFF = 69632;
constexpr int QF_OFF = 256 * WROW;
constexpr int CQ_STRIDE = 260;

__device__ __forceinline__ void unit(int b, int h, const bf16_t* __restrict__ CKVB, const bf16_t* __restrict__ KRB, const bf16_t* __restrict__ CKVN, const bf16_t* __restrict__ KRN, const bf16_t* __restrict__ CT,
                                     const bf16_t* __restrict__ Wukv_t, const bf16_t* __restrict__ QCAT, const bf16_t* __restrict__ SGM, bf16_t* MIX, LAS unsigned char* lds, LAS unsigned char* scr, int wv) {
    int lane = lane_id(); asm volatile("" : "+v"(lane));
    const int wid = wv, tid = (wv << 6) | lane, r32 = lane & 31, hh = lane >> 5;
    LAS unsigned char* qf = lds + QF_OFF;
    { const bf16_t* Wsrc = Wukv_t + (size_t)h * 256 * KVRANK;
#pragma unroll 4
      for (int i = 0; i < 8; ++i) { const int gi = tid + 512 * i, row = gi >> 5, c16 = gi & 31; const u32x4 v = *(const u32x4*)(Wsrc + (size_t)gi * 8);
          *(LAS u32x4*)(lds + row * WROW + (c16 << 4)) = v; } }
    { const bf16_t* qp = QCAT + (size_t)(MP + b * DSEQ + (r32 & 15)) * (NHEAD * DQK) + h * DQK;
      for (int f = wid; f < 12; f += 8) { u32x4 v = {0u, 0u, 0u, 0u};
          if (r32 < DSEQ) { if (f < 8) { const bf16_t* p = qp + (f >> 1) * 32 + (f & 1) * 16 + 4 * hh; const u32x2 lo = *(const u32x2*)p, hi2 = *(const u32x2*)(p + 8); v = (u32x4){lo.x, lo.y, hi2.x, hi2.y}; }
                            else v = *(const u32x4*)(qp + DNOPE + (f - 8) * 16 + 8 * hh); }
          *(LAS u32x4*)(qf + f * 1024 + lane * 16) = v; } }
    __syncthreads();
    float m_run = -1e30f, l_run = 0.f; f32x4 ol[16];
#pragma unroll
    for (int i = 0; i < 16; ++i) ol[i] = (f32x4){0.f, 0.f, 0.f, 0.f};
    LAS float* rks = (LAS float*)(lds + MISC_OFF + 256) + wid * 32;
    LAS unsigned char* ps = lds + PS_OFF + wid * 2048;
    LAS const unsigned char* wk = lds + r32 * WROW + hh * 16; LAS const unsigned char* qfl = qf + lane * 16;
    const int q16 = lane & 15, kq = lane >> 4;
    const bf16_t* ctl = CT + (size_t)lane * 8; const bf16_t* cbl = CKVB + (size_t)b * (CKVT_B / 2) + (size_t)lane * 8;
    for (int kb = wid; kb < NKB; kb += 8) {
        int key = kb * 32 + r32; if (key > SKV_S - 1) key = SKV_S - 1;
        const bf16_t* kp = (key < PAST ? KRB + (size_t)(b * PAST + key) * DROPE : KRN + (size_t)(MP + b * DSEQ + key - PAST) * DROPE) + 8 * hh;
        f32x16 z = f32x16{}; float ssq = 0.f;
        bf16x8 rf[4];
#pragma unroll
        for (int s = 0; s < 4; ++s) rf[s] = *(const bf16x8*)(kp + 16 * s);
        {
        bf16x8 cf[16];
#pragma unroll
        for (int s = 0; s < 16; ++s) cf[s] = *(const bf16x8*)(cbl + (size_t)(kb * 16 + s) * 512);
#pragma unroll
        for (int dh = 0; dh < 2; ++dh) {
            f32x16 acc[2];
#pragma unroll
            for (int d2 = 0; d2 < 2; ++d2) { acc[d2] = f32x16{};
#pragma unroll
                for (int s = 0; s < 16; ++s) { const bf16x8 wa = *(LAS const bf16x8*)(wk + (dh * 2 + d2) * 32 * WROW + s * 32);
                    acc[d2] = __builtin_amdgcn_mfma_f32_32x32x16_bf16(wa, cf[s], acc[d2], 0, 0, 0); } }
            SBAR();
            bf16x8 kn[4];
#pragma unroll
            for (int d2 = 0; d2 < 2; ++d2) {
#pragma unroll
                for (int r = 0; r < 16; ++r) ssq += acc[d2][r] * acc[d2][r];
                kn[2 * d2] = packf8(acc[d2], 0, 1.f); kn[2 * d2 + 1] = packf8(acc[d2], 8, 1.f); }
            SBAR();
#pragma unroll
            for (int f = 0; f < 4; ++f) { const bf16x8 qb = *(LAS const bf16x8*)(qfl + (dh * 4 + f) * 1024); z = __builtin_amdgcn_mfma_f32_32x32x16_bf16(kn[f], qb, z, 0, 0, 0); }
            SBAR();
        }
        }
        bf16x8 af[16];
        { const bf16_t* ck = ctl + (size_t)kb * 16 * 512;
#pragma unroll
          for (int lb = 0; lb < 16; ++lb) af[lb] = *(const bf16x8*)(ck + lb * 512); }
        { auto rr = __builtin_amdgcn_permlane32_swap(__float_as_uint(ssq), __float_as_uint(ssq), false, false); ssq = __uint_as_float(rr[0]) + __uint_as_float(rr[1]); }
        rks[lane & 31] = 1.0f / sqrtf(ssq * (1.f / DNOPE) + EPS);
        asm volatile("s_waitcnt lgkmcnt(0)" ::: "memory");
#pragma unroll
        for (int g4 = 0; g4 < 4; ++g4) { const f32x4 rv = *(LAS const f32x4*)(rks + 8 * g4 + 4 * hh);
#pragma unroll
            for (int j = 0; j < 4; ++j) z[4 * g4 + j] *= rv[j]; }
#pragma unroll
        for (int s = 0; s < 4; ++s) { const bf16x8 qb = *(LAS const bf16x8*)(qfl + (8 + s) * 1024); z = __builtin_amdgcn_mfma_f32_32x32x16_bf16(rf[s], qb, z, 0, 0, 0); }
        SBAR();
        if (kb == NKB - 1) {
#pragma unroll
            for (int r = 0; r < 16; ++r) if (kb * 32 + crow(r, hh) >= SKV_S) z[r] = -1e30f;
        }
        float mx = z[0];
#pragma unroll
        for (int r = 1; r < 16; ++r) mx = fmaxf(mx, z[r]);
        { auto rr = __builtin_amdgcn_permlane32_swap(__float_as_uint(mx), __float_as_uint(mx), false, false); mx = fmaxf(__uint_as_float(rr[0]), __uint_as_float(rr[1])); }
        const float mn = fmaxf(m_run, mx), alpha = __builtin_amdgcn_exp2f(m_run - mn); m_run = mn;
        float psum = 0.f;
#pragma unroll
        for (int r = 0; r < 16; ++r) { z[r] = __builtin_amdgcn_exp2f(z[r] - mn); psum += z[r]; }
        l_run = l_run * alpha + psum;
        if (r32 < DSEQ) {
#pragma unroll
            for (int k4 = 0; k4 < 4; ++k4) { u32x2 w; w.x = cvtpk(z[4 * k4], z[4 * k4 + 1]); w.y = cvtpk(z[4 * k4 + 2], z[4 * k4 + 3]); *(LAS u32x2*)(ps + (r32 * 4 + k4) * 16 + 8 * hh) = w; }
            if (hh == 0) *(LAS float*)(ps + 1024 + 4 * r32) = alpha;
        }
        asm volatile("s_waitcnt lgkmcnt(0)" ::: "memory");
        const bf16x8 pf = *(LAS const bf16x8*)(ps + (q16 * 4 + kq) * 16); const float al16 = *(LAS const float*)(ps + 1024 + 4 * q16);
        SBAR();
#pragma unroll
        for (int lb = 0; lb < 16; ++lb) ol[lb] = __builtin_amdgcn_mfma_f32_16x16x32_bf16(af[lb], pf, ol[lb] * al16, 0, 0, 0);
        SBAR();
    }
    { auto rr = __builtin_amdgcn_permlane32_swap(__float_as_uint(l_run), __float_as_uint(l_run), false, false); l_run = __uint_as_float(rr[0]) + __uint_as_float(rr[1]); }
    __syncthreads();
    LAS float* comb = (LAS float*)lds; LAS float* ml = (LAS float*)(lds + QF_OFF);
    const int lane2 = lane_id(), tid2 = (wv << 6) | lane2;
    { const int qq = lane2 & 15, rq = lane2 >> 4;
#pragma unroll
      for (int lb = 0; lb < 16; ++lb) *(LAS f32x4*)(comb + (wid * 16 + qq) * CQ_STRIDE + lb * 16 + 4 * rq) = ol[lb];
      if (lane2 < DSEQ) { ml[wid * 16 + lane2] = m_run; ml[128 + wid * 16 + lane2] = l_run; } }
    __syncthreads();
    { const int q = tid2 >> 5, l0 = (tid2 & 31) * 8; float M = ml[q];
#pragma unroll
      for (int w = 1; w < 8; ++w) M = fmaxf(M, ml[w * 16 + q]);
      float L = 0.f; f32x4 a0 = {0.f, 0.f, 0.f, 0.f}, a1 = {0.f, 0.f, 0.f, 0.f};
#pragma unroll
      for (int w = 0; w < 8; ++w) { const float e = __builtin_amdgcn_exp2f(ml[w * 16 + q] - M); L += ml[128 + w * 16 + q] * e; const LAS float* cp = comb + (w * 16 + q) * CQ_STRIDE + l0;
          a0 += *(LAS const f32x4*)cp * e; a1 += *(LAS const f32x4*)(cp + 4) * e; }
      const float rl = 1.0f / L;
      __syncthreads();
      *(LAS f32x4*)(comb + q * CQ_STRIDE + l0) = a0 * rl; *(LAS f32x4*)(comb + q * CQ_STRIDE + l0 + 4) = a1 * rl; }
    __syncthreads();
    { const int q16b = lane2 & 15, kqb = lane2 >> 4; const bf16_t* wvp = Wukv_t + ((size_t)h * 256 + 128 + wid * 16 + q16b) * KVRANK + 8 * kqb;
      const LAS float* arow = comb + q16b * CQ_STRIDE + 8 * kqb;
      f32x4 od = {0.f, 0.f, 0.f, 0.f};
#pragma unroll
      for (int ks = 0; ks < 8; ++ks) { const f32x4 x0 = *(LAS const f32x4*)(arow + 32 * ks), x1 = *(LAS const f32x4*)(arow + 32 * ks + 4);
          const bf16x8 af2 = __builtin_bit_cast(bf16x8, pack8(x0, x1)); const bf16x8 bf2 = *(const bf16x8*)(wvp + 32 * ks);
          od = __builtin_amdgcn_mfma_f32_16x16x32_bf16(af2, bf2, od, 0, 0, 0); }
      const int dim = wid * 16 + q16b;
#pragma unroll
      for (int r = 0; r < 4; ++r) { const size_t row = (size_t)(MP + b * DSEQ + 4 * kqb + r);
          const float gt = bf2f(SGM[row * 1024 + h * DV + dim]); MIX[row * DM + DPOOL + h * DV + dim] = (bf16_t)(cvtpk(od[r] * gt, 0.f) & 0xffffu); } }
    __syncthreads();
}
}

__device__ __forceinline__ void bf8_to_f(const u32x4 v, float (&d)[8]) {
    d[0] = __uint_as_float(v.x << 16); d[1] = __uint_as_float(v.x & 0xffff0000u); d[2] = __uint_as_float(v.y << 16); d[3] = __uint_as_float(v.y & 0xffff0000u);
    d[4] = __uint_as_float(v.z << 16); d[5] = __uint_as_float(v.z & 0xffff0000u); d[6] = __uint_as_float(v.w << 16); d[7] = __uint_as_float(v.w & 0xffff0000u); }
template <int W>
__device__ __forceinline__ void pool_window_run(int m0, int col, const bf16_t* __restrict__ Z, const bf16_t* __restrict__ SGP, const float* __restrict__ pscale, bf16_t* MIX) {
    const bool smp = m0 >= MP; const int sb = (m0 - MP) >> 4;
    const int u0 = smp ? POOLH + ((m0 - MP) & 15) : (m0 & (SEQ - 1));
    const long base_new = smp ? (long)(MP + sb * DSEQ) - POOLH : (long)(m0 - u0);
    const long base_hist = (long)MT + sb * POOLH;
    u32x4 zr[W + 7], gq[8];
#pragma unroll
    for (int i = 0; i < W + 7; ++i) { const int u = u0 - (W - 1) + i; zr[i] = (u32x4){0u, 0u, 0u, 0u};
        if (u >= 0) zr[i] = *(const u32x4*)(Z + ((smp && u < POOLH) ? base_hist + u : base_new + u) * DPOOL + col); }
#pragma unroll
    for (int r = 0; r < 8; ++r) gq[r] = *(const u32x4*)(SGP + (size_t)(m0 + r) * DPOOL + col);
    const f32x4 p0 = *(const f32x4*)(pscale + col), p1 = *(const f32x4*)(pscale + col + 4);
    float S[8];
#pragma unroll
    for (int i = 0; i < 8; ++i) S[i] = 0.f;
#pragma unroll
    for (int k = 0; k < W - 1; ++k) { float t[8]; bf8_to_f(zr[k], t);
#pragma unroll
        for (int i = 0; i < 8; ++i) S[i] += t[i]; }
#pragma unroll
    for (int r = 0; r < 8; ++r) { const int u = u0 + r; float zc[8], gv[8], td[8], ov[8]; bf8_to_f(zr[W - 1 + r], zc); bf8_to_f(gq[r], gv); bf8_to_f(zr[r], td);
#pragma unroll
        for (int i = 0; i < 8; ++i) S[i] += zc[i];
        const int pos1 = smp ? SEQ : u + 1; const float rc = 1.0f / (float)(pos1 < W ? pos1 : W);
#pragma unroll
        for (int i = 0; i < 8; ++i) ov[i] = (S[i] * rc - zc[i]) * (i < 4 ? p0[i] : p1[i - 4]) * gv[i];
        u32x4 wv4; wv4.x = cvtpk(ov[0], ov[1]); wv4.y = cvtpk(ov[2], ov[3]); wv4.z = cvtpk(ov[4], ov[5]); wv4.w = cvtpk(ov[6], ov[7]);
        *(u32x4*)(MIX + (size_t)(m0 + r) * DM + col) = wv4;
#pragma unroll
        for (int i = 0; i < 8; ++i) S[i] -= td[i]; }
}
__device__ __forceinline__ void pool_window_block(int blk, const bf16_t* __restrict__ Z, const bf16_t* __restrict__ SGP, const float* __restrict__ pscale, bf16_t* MIX, int wv) {
    const int lane = lane_id(), g = wv & 3, m0 = blk * 32 + ((lane >> 5) + 2 * (wv >> 2)) * 8, col = g * 256 + (lane & 31) * 8;
    if (g == 0) pool_window_run<2>(m0, col, Z, SGP, pscale, MIX);
    else if (g == 1) pool_window_run<4>(m0, col, Z, SGP, pscale, MIX);
    else if (g == 2) pool_window_run<8>(m0, col, Z, SGP, pscale, MIX);
    else pool_window_run<16>(m0, col, Z, SGP, pscale, MIX);
}

#define XB_TMO      128
#define XB_XCNT(j)  (256  + 64 * (j))
#define XB_XSUB(j)  (1280 + 64 * (j))
#define XB_XGEN(j)  (2304 + 64 * (j))
#define XB_TOP      3328
#define XB_TOPGEN   3392
#define XCD_BAR_WORDS 3456
#define XB_SPIN_CAP (1u << 22)
__device__ __forceinline__ unsigned xb_ld(unsigned* p)              { return __hip_atomic_load(p, __ATOMIC_RELAXED, __HIP_MEMORY_SCOPE_AGENT); }
__device__ __forceinline__ unsigned xb_add(unsigned* p, unsigned v) { return __hip_atomic_fetch_add(p, v, __ATOMIC_RELAXED, __HIP_MEMORY_SCOPE_AGENT); }
__device__ __forceinline__ unsigned xb_xcc_id() { return (unsigned)__builtin_amdgcn_s_getreg((3 << 11) | 20) & 0xFu; }
#define XB_SPIN(cond, bar) do { unsigned _sp = 0; while (cond) { __builtin_amdgcn_s_sleep(1); \
    if ((++_sp & 255u) == 0u) { if (xb_ld(&(bar)[XB_TMO])) break; if (_sp > XB_SPIN_CAP) { atomicAdd(&(bar)[XB_TMO], 1u); break; } } } } while (0)
struct XcdBarrier { unsigned* bar; unsigned x; volatile LAS unsigned* st; };
__device__ __forceinline__ XcdBarrier xcd_barrier_post(unsigned* bar, volatile LAS unsigned* st, int wv) {
    XcdBarrier b; b.bar = bar; b.x = xb_xcc_id(); b.st = st;
    if (TIDX(wv) == 0) (void)xb_add(&bar[XB_XCNT(b.x)], 1u);
    return b;
}
__device__ __forceinline__ void xcd_barrier_complete(unsigned* bar, unsigned x, unsigned& nloc, unsigned& nx) {
    const unsigned G = gridDim.x * gridDim.y * gridDim.z;
    unsigned sum, cnt, mine, sp = 0u;
    for (;;) {
        sum = 0u; cnt = 0u; mine = 0u;
#pragma unroll
        for (unsigned j = 0; j < 16; ++j) { const unsigned c = xb_ld(&bar[XB_XCNT(j)]); sum += c; cnt += (c > 0u) ? 1u : 0u; mine = (j == x) ? c : mine; }
        if (sum == G) break;
        __builtin_amdgcn_s_sleep(1);
        if ((++sp & 255u) == 0u) { if (xb_ld(&bar[XB_TMO])) break; if (sp > XB_SPIN_CAP) { atomicAdd(&bar[XB_TMO], 1u); break; } }
    }
    nloc = mine > 0u ? mine : 1u; nx = cnt > 0u ? cnt : 1u;
}
__device__ __forceinline__ void xcd_barrier(const XcdBarrier& b, int wv) {
    asm volatile("s_waitcnt vmcnt(0)" ::: "memory");
    __syncthreads();
    if (TIDX(wv) == 0) {
        unsigned* bar = b.bar;
        __builtin_amdgcn_s_waitcnt(0);
        unsigned nloc = b.st[0], nx = b.st[1];
        if (nloc == 0u) { xcd_barrier_complete(bar, b.x, nloc, nx); b.st[0] = nloc; b.st[1] = nx; }
        const unsigned old = xb_add(&bar[XB_XSUB(b.x)], 1u);
        const unsigned gen = old / nloc;
        if (old + 1u == (gen + 1u) * nloc) {
            __builtin_amdgcn_fence(__ATOMIC_RELEASE, "agent");
            asm volatile("s_waitcnt vmcnt(0)" ::: "memory");
            const unsigned og = xb_add(&bar[XB_TOP], 1u);
            const unsigned tg = og / nx;
            if (og + 1u == (tg + 1u) * nx) xb_add(&bar[XB_TOPGEN], 1u);
            else XB_SPIN(xb_ld(&bar[XB_TOPGEN]) == tg, bar);
            __builtin_amdgcn_fence(__ATOMIC_ACQUIRE, "agent");
            xb_add(&bar[XB_XGEN(b.x)], 1u);
            asm volatile("s_waitcnt vmcnt(0)" ::: "memory");
        } else {
            XB_SPIN(xb_ld(&bar[XB_XGEN(b.x)]) == gen, bar);
            __builtin_amdgcn_fence(__ATOMIC_ACQUIRE, "agent");
            asm volatile("s_waitcnt vmcnt(0)" ::: "memory");
        }
    }
    __syncthreads();
}

constexpr int N_PHASES = 5;
__global__ void __launch_bounds__(512, 2) hymba_fwd(Args a) {
    extern __shared__ __attribute__((aligned(16))) unsigned char lds_raw[];
    LAS unsigned char* lds = (LAS unsigned char*)lds_raw;
    LAS unsigned char* scr = lds + SCR_OFF;
    volatile LAS unsigned* MISC = (volatile LAS unsigned*)(lds + MISC_OFF);
    const int wv = __builtin_amdgcn_readfirstlane((int)threadIdx.x >> 6);
    const int tid = TIDX(wv);
    const int G = gridDim.x; const int bx = blockIdx.x; const int vcu = (G % 8 == 0) ? (bx % 8) * (G / 8) + bx / 8 : bx;
    unsigned char* ws = a.ws; float* out = a.out;
    if (tid < 64) MISC[tid] = 0u;
    __syncthreads();
    XcdBarrier bar; bar.bar = (unsigned*)(ws + WS_CTL) + 1024 + a.li * XCD_BAR_WORDS; bar.x = 0; bar.st = nullptr;
    const bool one_launch = (a.ph_hi - a.ph_lo) > 1;
    if (one_launch) bar = xcd_barrier_post((unsigned*)(ws + WS_CTL) + 1024 + a.li * XCD_BAR_WORDS, MISC + 8, wv);
    const int lo = a.ph_lo, hi = a.ph_hi;
#ifndef PHASE_MASK
#define PHASE_MASK 63
#endif
#define IN(k) (((PHASE_MASK >> (k)) & 1) && lo <= (k) && (k) < hi)
#define SEAM(k) do { if (IN(k) && IN((k) + 1)) xcd_barrier(bar, wv); } while (0)
#define WSP(T, off) ((T*)(ws + (off)))
    if (IN(0)) { p0_prologue(a, lds, vcu, G, wv, 0); __syncthreads(); }
    SEAM(0);
    if (IN(1)) {
        pg8::SchedP1 S{(const char*)ws, bx, G};
        pg8::EpiInProj E{ws, out};
        pg8::gemm_phase(lds, scr, S, E, wv);
        __syncthreads(); p0_prologue(a, lds, vcu, G, wv, 1);
    }
    SEAM(1);
    if (IN(2)) {
        { pg8::SchedP2 S{(const char*)ws, bx, G};
          pg8::EpiP2 E{ws};
          pg8::gemm_phase(lds, scr, S, E, wv); }
        {
            const float* c1 = AIN(I_CCKV);
            unsigned* cctr = (unsigned*)(ws + WS_CTL) + 11520 + 64 * a.li; constexpr int NC = DBATCH * 256 / 8;
            for (;;) {
                if (TIDX(wv) == 0) MISC[22] = __hip_atomic_fetch_add(cctr, 1u, __ATOMIC_RELAXED, __HIP_MEMORY_SCOPE_AGENT);
                __syncthreads();
                const int ch = (int)MISC[22];
                __syncthreads();
                if (ch >= NC) break;
                const int item = ch * 8 + wv, bb = item >> 8, kbk = (item & 255) >> 3, nb = item & 7;
                cache_item(c1 + (size_t)bb * PAST * KVRANK, WSP(bf16_t, WS_CKVB) + (size_t)bb * (CKVT_B / 2), ckvt_base(ws, bb), 64 * kbk, 32 * nb, (LAS float*)(lds + wv * 16384), lane_id(), true, bb >= NBT_A);
            }
            { const bf16_t* CKVN = WSP(bf16_t, WS_CKVN);
              for (int i = vcu * 512 + TIDX(wv); i < DBATCH * 16 * 64; i += G * 512) { const int bb = i >> 10, sb = (i >> 6) & 15, ln = i & 63;
                  const bf16_t* nk = CKVN + (size_t)(MP + bb * DSEQ) * KVRANK; const size_t fo = ((size_t)(64 * 16 + sb) * 64 + ln) * 8;
                  { const int t = ln & 31; u32x4 w = {0u, 0u, 0u, 0u}; if (t < DSEQ) w = *(const u32x4*)(nk + (size_t)t * KVRANK + 16 * sb + 8 * (ln >> 5));
                    *(u32x4*)(WSP(bf16_t, WS_CKVB) + (size_t)bb * (CKVT_B / 2) + fo) = w; }
                  { const int kq = ln >> 4; u32x4 w = {0u, 0u, 0u, 0u};
                    if (kq < 2) { const bf16_t* p = nk + (size_t)(8 * kq) * KVRANK + 16 * sb + (ln & 15);
                        w.x = p[0] | ((unsigned)p[KVRANK] << 16); w.y = p[2 * KVRANK] | ((unsigned)p[3 * KVRANK] << 16); w.z = p[4 * KVRANK] | ((unsigned)p[5 * KVRANK] << 16); w.w = p[6 * KVRANK] | ((unsigned)p[7 * KVRANK] << 16); }
                    *(u32x4*)(ckvt_base(ws, bb) + fo) = w; } } }
        }
    }
    SEAM(2);
    if (IN(3)) {
        const int qx = bx & 7; unsigned* ctr = (unsigned*)(ws + WS_CTL) + 8192 + 1024 * a.li + 64 * qx;
        for (;;) {
            if (TIDX(wv) == 0) MISC[20] = __hip_atomic_fetch_add(ctr, 1u, __ATOMIC_RELAXED, __HIP_MEMORY_SCOPE_AGENT);
            __syncthreads();
            const int it = (int)MISC[20];
            __syncthreads();
            if (it >= 98) break;
            if (it >= 64) { const int blk = (it - 64) * 8 + qx; pool_window_block(blk, WSP(bf16_t, WS_Z), WSP(bf16_t, WS_SGP), AIN(I_PSCALE), WSP(bf16_t, WS_MIX), wv); }
            else if (it >= 8 && it < 40) { const int j = it - 8, sb = qx * 4 + (j >> 3), sh = j & 7;
                sattn::unit(sb, sh, WSP(bf16_t, WS_CKVB), WSP(bf16_t, WS_KRB), WSP(bf16_t, WS_CKVN), WSP(bf16_t, WS_KRN), ckvt_base(ws, sb), WSP(bf16_t, WS_WUKV), WSP(bf16_t, WS_QCAT), WSP(bf16_t, WS_SGM), WSP(bf16_t, WS_MIX), lds, scr, wv); }
            else { const int k = it < 8 ? it : it - 32, qb = 7 - (k >> 2), bh = qx * 4 + (k & 3);
                pattn::unit(bh >> 3, bh & 7, qb, WSP(bf16_t, WS_QCAT), WSP(bf16_t, WS_KCAT), WSP(bf16_t, WS_KRN), WSP(bf16_t, WS_V), WSP(bf16_t, WS_SGM), WSP(bf16_t, WS_MIX), lds, wv); }
        }
    }
    SEAM(3);
    if (IN(4)) {
        unsigned* pcnt = (unsigned*)(ws + WS_CTL) + 13312 + 2560 * a.li;
        pg8::EpiP45 E{ws, out};
        { pg8::SchedP45 S{(const char*)ws, pcnt, bx, G, 1}; pg8::gemm_phase(lds, scr, S, E, wv); }
        { pg8::SchedP45 S{(const char*)ws, pcnt, bx, G, 2}; pg8::gemm_phase(lds, scr, S, E, wv); }
    }
#undef IN
#undef SEAM
}

extern "C" void kernel_launch(void* const* d_in, const int* in_sizes, int n_in, void* d_out, int out_size, void* d_ws, size_t ws_size, hipStream_t stream) {
    static int grid = 0;
    if (grid == 0) {
        if (n_in != 24 || in_sizes[0] != MP * DM || out_size != 21164032 || ws_size < WS_END) {
            fprintf(stderr, "kernel_launch: shape mismatch: n_in %d in0 %d out %d ws %zu (need >= %zu)\n", n_in, n_in > 0 ? in_sizes[0] : -1, out_size, ws_size, (size_t)WS_END); grid = -1; return; }
        int dev = 0, cus = 0, per_cu = 0;
        if (hipGetDevice(&dev) != hipSuccess || hipDeviceGetAttribute(&cus, hipDeviceAttributeMultiprocessorCount, dev) != hipSuccess) { fprintf(stderr, "kernel_launch: device query failed\n"); grid = -1; return; }
        if (hipFuncSetAttribute((const void*)hymba_fwd, hipFuncAttributeMaxDynamicSharedMemorySize, LDS_BYTES) != hipSuccess) { fprintf(stderr, "kernel_launch: hipFuncSetAttribute failed\n"); grid = -1; return; }
        if (hipOccupancyMaxActiveBlocksPerMultiprocessor(&per_cu, (const void*)hymba_fwd, 512, LDS_BYTES) != hipSuccess || per_cu < 1)
            fprintf(stderr, "kernel_launch: note: occupancy query reports %d workgroups per CU\n", per_cu);
        (void)hipGetLastError();
        grid = cus;
    }
    if (grid < 0) return;
    if (hipMemsetAsync((char*)d_ws + WS_CTL, 0, CTL_ZERO_BYTES, stream) != hipSuccess) { fprintf(stderr, "kernel_launch: memset failed\n"); return; }
    Args a{};
    for (int i = 0; i < 24; ++i) a.in[i] = (const float*)d_in[i];
    a.out = (float*)d_out; a.ws = (unsigned char*)d_ws;
#if MK_N_LAUNCHES == 1
    a.ph_lo = 0; a.ph_hi = N_PHASES;
    hipLaunchKernelGGL(hymba_fwd, dim3(grid), dim3(512), LDS_BYTES, stream, a);
#else
    for (int p = 0; p < N_PHASES; ++p) { a.ph_lo = p; a.ph_hi = p + 1; hipLaunchKernelGGL(hymba_fwd, dim3(grid), dim3(512), LDS_BYTES, stream, a); }
#endif
    const hipError_t le = hipPeekAtLastError();
    if (le != hipSuccess) fprintf(stderr, "kernel_launch: launch failed: %s\n", hipGetErrorName(le));
}
```

```cpp
#include <hip/hip_runtime.h>
#include <hip/hip_bf16.h>
#include <cstdio>
#include <cstdint>

#ifndef DUP_PHASE
#define DUP_PHASE -1
#endif
#ifndef MK_N_LAUNCHES
#define MK_N_LAUNCHES 1
#endif

#define LAS __attribute__((address_space(3)))
#define GAS __attribute__((address_space(1)))
typedef unsigned short bf16_t;
typedef short bf16x8 __attribute__((ext_vector_type(8)));
typedef short s16x4 __attribute__((ext_vector_type(4)));
typedef float f32x4 __attribute__((ext_vector_type(4)));
typedef float f32x16 __attribute__((ext_vector_type(16)));
typedef unsigned u32x4 __attribute__((ext_vector_type(4)));
typedef unsigned u32x2 __attribute__((ext_vector_type(2)));
typedef float f32x2_t __attribute__((ext_vector_type(2)));
typedef __bf16 bf16x2_t __attribute__((ext_vector_type(2)));

constexpr int DM = 2048, NBATCH = 4, SEQ = 2048, DBATCH = 32, DSEQ = 16, PAST = 2048;
constexpr int MP = NBATCH * SEQ, MS = DBATCH * DSEQ, MT = MP + MS;
constexpr int DPOOL = 1024, NHEAD = 8, DNOPE = 128, DROPE = 64, DV = 128, QRANK = 512, KVRANK = 256, DPLE = 256;
constexpr int DQK = DNOPE + DROPE;
constexpr int DIN = 3904, DINP = 4096;
constexpr int SKV_S = PAST + DSEQ;
constexpr int POOLH = 15;
constexpr int MZ = 9216;
constexpr float EPS = 1e-6f;
constexpr float C2 = 0.07216878364870322f * 1.4426950408889634f;
constexpr size_t O_Y = 0, O_CKVP = 17825792, O_KRP = 19922944, O_POOLP = 20447232, O_CKVS = 20508672, O_KRS = 20639744, O_POOLS = 20672512;

constexpr size_t MiB = 1u << 20;
constexpr size_t WS_CTL = 0, CTL_ZERO_BYTES = 128 * 1024;
constexpr size_t WS_WIN = 1 * MiB;
constexpr size_t WS_WUQ = 17 * MiB;
constexpr size_t WS_WUKV = 18 * MiB + MiB / 2;
constexpr size_t WS_WPOOL = 19 * MiB + MiB / 2;
constexpr size_t WS_WOUT = 20 * MiB;
constexpr size_t WS_WGATE = 28 * MiB;
constexpr size_t WS_WPLE = 36 * MiB;
constexpr size_t WS_COS = 37 * MiB;
constexpr size_t WS_SIN = 37 * MiB + MiB / 2;
constexpr size_t WS_SSQCQ = 38 * MiB;
constexpr size_t WS_SSQH = 38 * MiB + MiB / 2;
constexpr size_t WS_CKVN = 39 * MiB;
constexpr size_t WS_KRN = 43 * MiB + MiB / 2;
constexpr size_t WS_PBF = 45 * MiB;
constexpr size_t WS_XN = 49 * MiB + MiB / 2;
constexpr size_t WS_KRB = 227 * MiB;
constexpr int CKVT_LD = 2080; constexpr size_t CKVT_B = (size_t)KVRANK * CKVT_LD * 2; constexpr int NBT_A = 20;
constexpr size_t OB_CKVB = 0, OB_CKVT = (size_t)DBATCH * CKVT_B;
static_assert(2 * (size_t)DBATCH * CKVT_B <= (size_t)MT * DM * 4, "cache copies fit in the y region of d_out");
constexpr int NB_EARLY = 0;
constexpr size_t WS_UBF = 83 * MiB + MiB / 2;
constexpr size_t WS_CQ = 101 * MiB + MiB / 2;
constexpr size_t WS_MIX = WS_UBF;
constexpr size_t WS_SGP = 117 * MiB + MiB / 2;
constexpr size_t WS_Z = 134 * MiB + MiB / 2;
constexpr size_t WS_PV = WS_SGP;
constexpr size_t WS_SGM = 152 * MiB + MiB / 2;
constexpr size_t WS_QCAT = 169 * MiB + MiB / 2;
constexpr size_t WS_KCAT = 195 * MiB;
constexpr size_t WS_HBF = WS_QCAT;
constexpr size_t WS_V = 211 * MiB;
constexpr size_t WS_END = 256 * MiB;
static_assert(WS_MIX + (size_t)MT * DM * 2 <= WS_SGP && WS_PV + (size_t)MT * DM * 2 <= WS_SGM && WS_HBF + (size_t)MT * DM * 2 <= WS_V && WS_END <= 256 * MiB, "d_ws map");
static_assert(WS_KRB + (size_t)DBATCH * PAST * DROPE * 2 <= WS_END && WS_V + 16 * MiB <= WS_KRB, "d_ws map (cache copies)");

constexpr int RING_BYTES = 131072;
constexpr int SCR_OFF = RING_BYTES;
constexpr int SCR_BYTES = 16384;
constexpr int MISC_OFF = SCR_OFF + SCR_BYTES;
constexpr int LDS_BYTES = 151552;

#define LDS_WAIT() asm volatile("s_waitcnt lgkmcnt(0)" ::: "memory")
#define VM_WAIT() asm volatile("s_waitcnt vmcnt(0)" ::: "memory")
#define WG_BAR() do { asm volatile("s_waitcnt lgkmcnt(0)" ::: "memory"); __builtin_amdgcn_s_barrier(); asm volatile("" ::: "memory"); } while (0)
#define SBAR() __builtin_amdgcn_sched_barrier(0)
__device__ __forceinline__ unsigned cvtpk(float lo, float hi) { f32x2_t v = {lo, hi}; bf16x2_t b = __builtin_convertvector(v, bf16x2_t); return __builtin_bit_cast(unsigned, b); }
__device__ __forceinline__ u32x4 pack8(f32x4 a, f32x4 b) { u32x4 w; w.x = cvtpk(a[0], a[1]); w.y = cvtpk(a[2], a[3]); w.z = cvtpk(b[0], b[1]); w.w = cvtpk(b[2], b[3]); return w; }
typedef __amdgpu_buffer_rsrc_t rsrc_t;
__device__ __forceinline__ rsrc_t make_rsrc(const void* p, unsigned bytes) { return __builtin_amdgcn_make_buffer_rsrc(const_cast<void*>(p), 0, bytes, 0x00020000); }
__device__ __forceinline__ void st16_wt(rsrc_t r, unsigned byteoff, u32x4 v) { __builtin_amdgcn_raw_buffer_store_b128(v, r, byteoff, 0, 16); }
__device__ __forceinline__ void st16_wt(rsrc_t r, unsigned byteoff, f32x4 v) { __builtin_amdgcn_raw_buffer_store_b128(__builtin_bit_cast(u32x4, v), r, byteoff, 0, 16); }
__device__ __forceinline__ float bf2f(unsigned short h) { return __uint_as_float((unsigned)h << 16); }
__device__ __forceinline__ float silu_f(float v) { return v / (1.f + __expf(-v)); }
__device__ __forceinline__ float sigmoid_f(float v) { return 1.f / (1.f + __expf(-v)); }
__device__ __forceinline__ float wave_sum(float v) {
#pragma unroll
    for (int o = 1; o < 64; o <<= 1) v += __shfl_xor(v, o);
    return v;
}
__device__ __forceinline__ int lane_id() { int l; asm volatile("v_mbcnt_lo_u32_b32 %0, -1, 0\n\tv_mbcnt_hi_u32_b32 %0, -1, %0" : "=v"(l)); return l; }
#define TIDX(wv) (((wv) << 6) | lane_id())
__device__ __forceinline__ int row_pos(int row) { return row < MP ? (row & (SEQ - 1)) : PAST + ((row - MP) & (DSEQ - 1)); }

#define AS4 __attribute__((address_space(4)))
__device__ __forceinline__ const float* arg_in(int k) {
    const char AS4* p = (const char AS4*)__builtin_amdgcn_kernarg_segment_ptr(); int off = k * 8; asm volatile("" : "+s"(off));
    return *(const float* const AS4*)(p + off);
}
#define AIN(k) arg_in(k)

namespace pg8 {
constexpr int BM = 256, BK = 64, HALF = 128, HTB = HALF * BK * 2, STAGE_BYTES = 8 * HTB, NXCD = 8, WGM = 8;
__host__ __device__ __forceinline__ int lds_byte(int r, int c) { const int st = (r >> 4) * 2 + (c >> 5), rr = r & 15, cc = c & 31, ob = rr * 64 + cc * 2; return st * 1024 + (ob ^ (((ob >> 9) & 1) << 5)); }
__host__ __device__ __forceinline__ void stage_rc(int b, int& R, int& C) { const int st = b / 1024, sb = b % 1024, swz = sb ^ (((sb >> 9) & 1) << 5); R = (st >> 1) * 16 + swz / 64; C = (st & 1) * 32 + (swz % 64) / 2; }
__host__ __device__ __forceinline__ int perm32(int rho) { const int n = rho >> 4, i = rho & 15; return 8 * (i >> 2) + 4 * n + (i & 3); }

struct Unit { const char* A; const char* B; int lda, ldb, nt, type, row0, pn, half, slice, uid; };
__device__ __forceinline__ void grid_map(int L, int nM, int nN, int& pm, int& pn) {
    const int nwg = nM * nN; int wgid = L; { const int q = nwg / NXCD, r = nwg % NXCD, xcd = wgid % NXCD, off = wgid / NXCD; wgid = (xcd < r ? xcd * (q + 1) : r * (q + 1) + (xcd - r) * q) + off; }
    const int nig = WGM * nN, gid = wgid / nig, fm = gid * WGM, gsz = (nM - fm) < WGM ? (nM - fm) : WGM;
    pm = fm + ((wgid % nig) % gsz); pn = (wgid % nig) / gsz;
}

template <class Sched, class Epi>
__device__ __forceinline__ void gemm_phase(LAS unsigned char* lds, LAS unsigned char* scr, const Sched& S, const Epi& E, int wv) {
    const int wid = wv, lane = lane_id(), tid = (wv << 6) | lane, wr = wid >> 2, wc = wid & 3, fr = lane & 15, fq = lane >> 4;
    Unit cur, nxt; int ui = 0;
    if (!S.get(0, cur)) return;
    int RA[2], RB[2], CC[2];
#pragma unroll
    for (int i = 0; i < 2; ++i) { int R, C; stage_rc(tid * 16 + i * 8192, R, C); RA[i] = R * 2; RB[i] = ((R & ~31) + perm32(R & 31)) * 2; CC[i] = C * 2; }
    unsigned voffA[2], voffB[2], nvA[2], nvB[2];
#pragma unroll
    for (int i = 0; i < 2; ++i) { voffA[i] = (unsigned)(RA[i] * cur.lda + CC[i]); voffB[i] = (unsigned)(RB[i] * cur.ldb + CC[i]); }
    const size_t kstep = (size_t)(BK * 2);
    unsigned hA = cur.half ? 0u : (unsigned)(HALF * cur.lda * 2), hB = (unsigned)(HALF * cur.ldb * 2);
    const unsigned ldsw = (unsigned)wid * 1024u;
    const int aoff = lds_byte(wr * 64 + fr, fq * 8), boff = lds_byte(wc * 32 + fr, fq * 8);
#define PG8_SA(b, h) (((b) * 2 + (h)) * HTB)
#define PG8_SB(b, h) ((4 + (b) * 2 + (h)) * HTB)
#define PG8_STAGE(bufoff, gbase, voff) do { _Pragma("unroll") for (int _i = 0; _i < 2; ++_i) \
        __builtin_amdgcn_global_load_lds((const unsigned*)((const char*)(gbase) + (voff)[_i]), (LAS unsigned*)(lds + (bufoff) + ldsw + _i * 8192), 16, 0, 0); } while (0)
#define PG8_LDA(dst, b, h) do { _Pragma("unroll") for (int m = 0; m < 4; ++m) _Pragma("unroll") for (int k = 0; k < 2; ++k) dst[m][k] = *(const LAS bf16x8*)(lds + PG8_SA(b, h) + aoff + m * 2048 + k * 1024); } while (0)
#define PG8_LDB(dst, b, h) do { _Pragma("unroll") for (int n = 0; n < 2; ++n) _Pragma("unroll") for (int k = 0; k < 2; ++k) dst[n][k] = *(const LAS bf16x8*)(lds + PG8_SB(b, h) + boff + n * 2048 + k * 1024); } while (0)
#define PG8_MMA(ai, bj, At, Bt) do { __builtin_amdgcn_s_setprio(1); _Pragma("unroll") for (int m = 0; m < 4; ++m) _Pragma("unroll") for (int n = 0; n < 2; ++n) _Pragma("unroll") for (int k = 0; k < 2; ++k) \
        acc[ai][bj][m][n] = __builtin_amdgcn_mfma_f32_16x16x32_bf16(Bt[n][k], At[m][k], acc[ai][bj][m][n], 0, 0, 0); __builtin_amdgcn_s_setprio(0); } while (0)
#define PG8_WAIT_V(n) asm volatile("s_waitcnt vmcnt(" #n ")" ::: "memory")
#define PG8_WAIT_L(n) asm volatile("s_waitcnt lgkmcnt(" #n ")" ::: "memory")
#define PG8_BAR __builtin_amdgcn_s_barrier()
#define PG8_SCHED __builtin_amdgcn_sched_barrier(0)
    f32x4 acc[2][2][4][2];
    { int fr_e = fr, fq_e = fq; asm volatile("" : "+v"(fr_e), "+v"(fq_e)); E.init(acc, cur, wr, wc, fr_e, fq_e); }
    bf16x8 At[4][2], B0[2][2], B1[2][2];
    const char* cA = cur.A; const char* cB = cur.B;
    int rot = ((S.c & 7) * cur.nt) >> 3, nrot = 0;
    S.a_ready(cur, wid);
    { const size_t k0 = (size_t)rot * kstep, k1 = (size_t)((rot + 1) & (cur.nt - 1)) * kstep;
    PG8_STAGE(PG8_SB(0, 0), cB + k0, voffB); PG8_STAGE(PG8_SB(0, 1), cB + hB + k0, voffB); PG8_STAGE(PG8_SA(0, 0), cA + k0, voffA); PG8_STAGE(PG8_SA(0, 1), cA + hA + k0, voffA);
    if (wr == 1) PG8_BAR;
    PG8_WAIT_V(2); PG8_BAR;
    PG8_STAGE(PG8_SB(1, 0), cB + k1, voffB); PG8_STAGE(PG8_SA(1, 0), cA + k1, voffA); PG8_STAGE(PG8_SB(1, 1), cB + hB + k1, voffB); }
    PG8_WAIT_V(6); PG8_BAR;
    for (;;) {
        const bool has_next = S.get(ui + 1, nxt);
        if (!has_next) nxt = cur;
#pragma unroll
        for (int i = 0; i < 2; ++i) { nvA[i] = (unsigned)(RA[i] * nxt.lda + CC[i]); nvB[i] = (unsigned)(RB[i] * nxt.ldb + CC[i]); }
        const unsigned nhA = nxt.half ? 0u : (unsigned)(HALF * nxt.lda * 2), nhB = (unsigned)(HALF * nxt.ldb * 2);
        const char* nA = nxt.A; const char* nB = nxt.B; nrot = ((S.c & 7) * nxt.nt) >> 3; const int nmask = nxt.nt - 1;
        int nt = __builtin_amdgcn_readfirstlane(cur.nt); asm volatile("" : "+s"(nt));
        const bool full = !cur.half;
        for (int t = 0; t < nt; t += 2) {
            const bool last = (t == nt - 2);
            if (last && has_next) S.a_ready(nxt, wid);
            const size_t o1 = (size_t)((t + 1 + rot) & (nt - 1)) * kstep;
            const size_t o2 = (size_t)(last ? (nrot & nmask) : ((t + 2 + rot) & (nt - 1))) * kstep, o3 = (size_t)(last ? ((nrot + 1) & nmask) : ((t + 3 + rot) & (nt - 1))) * kstep;
            const char* a1 = cA + o1;
            const char* a2 = (last ? nA : cA) + o2; const char* b2 = (last ? nB : cB) + o2;
            const char* a3 = (last ? nA : cA) + o3; const char* b3 = (last ? nB : cB) + o3;
            const unsigned hA2 = last ? nhA : hA, hB2 = last ? nhB : hB;
            unsigned vA2[2], vB2[2];
#pragma unroll
            for (int i = 0; i < 2; ++i) { vA2[i] = last ? nvA[i] : voffA[i]; vB2[i] = last ? nvB[i] : voffB[i]; }
            PG8_LDB(B0, 0, 0); PG8_LDB(B1, 0, 1); PG8_SCHED; PG8_LDA(At, 0, 0); PG8_STAGE(PG8_SA(1, 1), a1 + hA, voffA);
            PG8_WAIT_V(8); PG8_WAIT_L(0); PG8_BAR; PG8_MMA(0, 0, At, B0); PG8_MMA(0, 1, At, B1); PG8_BAR; PG8_SCHED;
            if (full) PG8_LDA(At, 0, 1);
            PG8_STAGE(PG8_SB(0, 0), b2, vB2); PG8_STAGE(PG8_SB(0, 1), b2 + hB2, vB2); PG8_STAGE(PG8_SA(0, 0), a2, vA2);
            PG8_WAIT_V(8); PG8_WAIT_L(0); PG8_BAR; if (full) { PG8_MMA(1, 0, At, B0); PG8_MMA(1, 1, At, B1); } PG8_BAR; PG8_SCHED;
            PG8_LDB(B0, 1, 0); PG8_LDB(B1, 1, 1); PG8_SCHED; PG8_LDA(At, 1, 0); PG8_STAGE(PG8_SA(0, 1), a2 + hA2, vA2);
            PG8_WAIT_V(8); PG8_WAIT_L(0); PG8_BAR; PG8_MMA(0, 0, At, B0); PG8_MMA(0, 1, At, B1); PG8_BAR; PG8_SCHED;
            if (full) PG8_LDA(At, 1, 1);
            PG8_STAGE(PG8_SB(1, 0), b3, vB2); PG8_STAGE(PG8_SB(1, 1), b3 + hB2, vB2); PG8_STAGE(PG8_SA(1, 0), a3, vA2);
            PG8_WAIT_V(8); PG8_WAIT_L(0); PG8_BAR; if (full) { PG8_MMA(1, 0, At, B0); PG8_MMA(1, 1, At, B1); } PG8_BAR; PG8_SCHED;
        }
        if (wr == 0) PG8_BAR;
        bool run_epi = true;
        if constexpr (Sched::SPLITK) {
            if (cur.slice >= 0) {
                constexpr int NSLICE = 4; constexpr unsigned SLABB = HALF * BM * 4;
                float* sl = S.slab(cur); const rsrc_t rs = make_rsrc(sl, NSLICE * SLABB); const unsigned lo = (unsigned)(wid * 16 * 64 + lane) * 16u;
#pragma unroll
                for (int bj = 0; bj < 2; ++bj)
#pragma unroll
                    for (int m = 0; m < 4; ++m)
#pragma unroll
                        for (int n = 0; n < 2; ++n) st16_wt(rs, (unsigned)cur.slice * SLABB + lo + (unsigned)(bj * 8 + m * 2 + n) * 1024u, acc[0][bj][m][n]);
                asm volatile("s_waitcnt vmcnt(0)" ::: "memory");
                PG8_BAR; asm volatile("" ::: "memory");
                volatile LAS unsigned* TK = (volatile LAS unsigned*)(lds + MISC_OFF) + 27;
                if (wid == 0 && lane == 0) { const unsigned old = __hip_atomic_fetch_add(S.ticket(cur), 1u, __ATOMIC_RELAXED, __HIP_MEMORY_SCOPE_AGENT);
                    if (old == NSLICE - 1) { __builtin_amdgcn_fence(__ATOMIC_ACQUIRE, "agent"); asm volatile("s_waitcnt vmcnt(0)" ::: "memory"); }
                    *TK = old; }
                asm volatile("s_waitcnt lgkmcnt(0)" ::: "memory"); PG8_BAR; asm volatile("" ::: "memory");
                run_epi = (*TK == NSLICE - 1);
                if (run_epi) {
#pragma unroll
                    for (int sp = 0; sp < NSLICE; ++sp) if (sp != cur.slice) { const char* ob = (const char*)sl + (size_t)sp * SLABB + lo;
#pragma unroll
                        for (int bj = 0; bj < 2; ++bj)
#pragma unroll
                            for (int m = 0; m < 4; ++m)
#pragma unroll
                                for (int n = 0; n < 2; ++n) acc[0][bj][m][n] += *(const f32x4*)(ob + (bj * 8 + m * 2 + n) * 1024); }
                }
                asm volatile("s_waitcnt lgkmcnt(0)" ::: "memory"); PG8_BAR; asm volatile("" ::: "memory");
            }
        }
        if (run_epi) {
        { int fr_e = fr, fq_e = fq; asm volatile("" : "+v"(fr_e), "+v"(fq_e));
          E(acc, cur, wr, wc, fr_e, fq_e, scr); }
        S.done(cur, wid);
        }
        if (!has_next) break;
        { int fr_e = fr, fq_e = fq; asm volatile("" : "+v"(fr_e), "+v"(fq_e)); E.init(acc, nxt, wr, wc, fr_e, fq_e); }
        cur = nxt; cA = nA; cB = nB; hA = nhA; hB = nhB; rot = nrot; ++ui;
#pragma unroll
        for (int i = 0; i < 2; ++i) { voffA[i] = nvA[i]; voffB[i] = nvB[i]; }
        if (wr == 1) PG8_BAR;
    }
    PG8_WAIT_V(0);
    PG8_BAR;
#undef PG8_SA
#undef PG8_SB
#undef PG8_STAGE
#undef PG8_LDA
#undef PG8_LDB
#undef PG8_MMA
#undef PG8_WAIT_V
#undef PG8_WAIT_L
#undef PG8_BAR
#undef PG8_SCHED
}

typedef f32x4 Acc[2][2][4][2];
__device__ __forceinline__ void acc_zero(Acc& acc) {
#pragma unroll
    for (int a = 0; a < 2; ++a)
#pragma unroll
        for (int b = 0; b < 2; ++b)
#pragma unroll
            for (int m = 0; m < 4; ++m)
#pragma unroll
                for (int n = 0; n < 2; ++n) acc[a][b][m][n] = (f32x4){0.f, 0.f, 0.f, 0.f};
}
#define EPI_INIT_ZERO __device__ __forceinline__ void init(Acc& acc, const Unit&, int, int, int, int) const { acc_zero(acc); }
template <int NG>
__device__ __forceinline__ void xwave_rowsum(float (&p)[NG][2][4], LAS unsigned char* scr, int wr, int wc, int fr, int fq) {
    LAS float* red = (LAS float*)scr;
    if (fq == 0) {
#pragma unroll
        for (int gq = 0; gq < NG; ++gq)
#pragma unroll
            for (int ai = 0; ai < 2; ++ai)
#pragma unroll
                for (int m = 0; m < 4; ++m) red[gq * 1024 + (ai * HALF + wr * 64 + m * 16 + fr) * 4 + wc] = p[gq][ai][m];
    }
    WG_BAR();
#pragma unroll
    for (int gq = 0; gq < NG; ++gq)
#pragma unroll
        for (int ai = 0; ai < 2; ++ai)
#pragma unroll
            for (int m = 0; m < 4; ++m) { const f32x4 v = *(const LAS f32x4*)(red + gq * 1024 + (ai * HALF + wr * 64 + m * 16 + fr) * 4); p[gq][ai][m] = (v[0] + v[1]) + (v[2] + v[3]); }
    WG_BAR();
}
__device__ __forceinline__ float sq4(f32x4 v) { return (v[0] * v[0] + v[1] * v[1]) + (v[2] * v[2] + v[3] * v[3]); }
__device__ __forceinline__ float fq_sum(float s) { s += __shfl_xor(s, 16); s += __shfl_xor(s, 32); return s; }

struct EpiBf16 {
    EPI_INIT_ZERO
    bf16_t* O; int ldc; int wt;
    __device__ __forceinline__ void operator()(Acc& acc, const Unit& u, int wr, int wc, int fr, int fq, LAS unsigned char*) const {
        const int row0 = u.row0 + wr * 64 + fr, col0 = u.pn * BM + wc * 32 + 8 * fq;
        if (wt) { const rsrc_t rO = make_rsrc(O, (unsigned)MT * DM * 2);
#pragma unroll
            for (int ai = 0; ai < 2; ++ai) if (ai == 0 || !u.half)
#pragma unroll
                for (int m = 0; m < 4; ++m) { const unsigned off = (unsigned)((row0 + ai * HALF + m * 16) * ldc + col0) * 2u;
#pragma unroll
                    for (int bj = 0; bj < 2; ++bj) st16_wt(rO, off + bj * HALF * 2, pack8(acc[ai][bj][m][0], acc[ai][bj][m][1])); }
            return; }
#pragma unroll
        for (int ai = 0; ai < 2; ++ai) if (ai == 0 || !u.half)
#pragma unroll
            for (int m = 0; m < 4; ++m) { bf16_t* rp = O + (size_t)(row0 + ai * HALF + m * 16) * ldc + col0;
#pragma unroll
                for (int bj = 0; bj < 2; ++bj) *(u32x4*)(rp + bj * HALF) = pack8(acc[ai][bj][m][0], acc[ai][bj][m][1]); }
    }
};

struct EpiInProj {
    EPI_INIT_ZERO
    unsigned char* ws; float* out;
    __device__ __forceinline__ void operator()(Acc& acc, const Unit& u, int wr, int wc, int fr, int fq, LAS unsigned char* scr) const {
        const float* kvg = arg_in(11); const float* krg = arg_in(16);
        bf16_t* UBF = (bf16_t*)(ws + WS_UBF); bf16_t* SGP = (bf16_t*)(ws + WS_SGP); bf16_t* CQ = (bf16_t*)(ws + WS_CQ); bf16_t* CKVN = (bf16_t*)(ws + WS_CKVN); bf16_t* SGM = (bf16_t*)(ws + WS_SGM); bf16_t* KRN = (bf16_t*)(ws + WS_KRN);
        float* SSQCQ = (float*)(ws + WS_SSQCQ); const float* COS = (const float*)(ws + WS_COS); const float* SIN = (const float*)(ws + WS_SIN);
        const int row0 = u.row0 + wr * 64 + fr, cl = wc * 32 + 8 * fq, pn = u.pn;
        if (pn < 4) {
            const bool tail = (((u.row0 >> 8) & 7) == 7) || (u.row0 >= MP);
#pragma unroll
            for (int ai = 0; ai < 2; ++ai) if (ai == 0 || !u.half)
#pragma unroll
                for (int m = 0; m < 4; ++m) { const int row = row0 + ai * HALF + m * 16; bf16_t* rp = UBF + (size_t)row * DPOOL + pn * BM + cl;
#pragma unroll
                    for (int bj = 0; bj < 2; ++bj) *(u32x4*)(rp + bj * HALF) = pack8(acc[ai][bj][m][0], acc[ai][bj][m][1]);
                    if (tail) { float* dst = nullptr;
                        if (row < MP) { const int t = row & (SEQ - 1), b = row >> 11; if (t >= SEQ - POOLH) dst = out + O_POOLP + (size_t)(b * POOLH + t - (SEQ - POOLH)) * DPOOL; }
                        else { const int s = row - MP, b = s >> 4, t = s & 15; if (t >= 1) dst = out + O_POOLS + (size_t)(b * POOLH + t - 1) * DPOOL; }
                        if (dst) { dst += pn * BM + cl;
#pragma unroll
                            for (int bj = 0; bj < 2; ++bj) { *(f32x4*)(dst + bj * HALF) = acc[ai][bj][m][0]; *(f32x4*)(dst + bj * HALF + 4) = acc[ai][bj][m][1]; } } } }
        } else if (pn < 8 || (pn >= 11 && pn < 15)) {
            bf16_t* G0 = pn < 8 ? SGP + (pn - 4) * BM : SGM + (pn - 11) * BM;
#pragma unroll
            for (int ai = 0; ai < 2; ++ai) if (ai == 0 || !u.half)
#pragma unroll
                for (int m = 0; m < 4; ++m) { bf16_t* rp = G0 + (size_t)(row0 + ai * HALF + m * 16) * 1024 + cl;
#pragma unroll
                    for (int bj = 0; bj < 2; ++bj) { f32x4 a = acc[ai][bj][m][0], b = acc[ai][bj][m][1];
#pragma unroll
                        for (int j = 0; j < 4; ++j) { a[j] = silu_f(a[j]); b[j] = silu_f(b[j]); }
                        *(u32x4*)(rp + bj * HALF) = pack8(a, b); } }
        } else if (pn < 10) {
#pragma unroll
            for (int ai = 0; ai < 2; ++ai) if (ai == 0 || !u.half)
#pragma unroll
                for (int m = 0; m < 4; ++m) { const int row = row0 + ai * HALF + m * 16; bf16_t* rp = CQ + (size_t)row * QRANK + (pn - 8) * BM + cl; float s = 0.f;
#pragma unroll
                    for (int bj = 0; bj < 2; ++bj) { *(u32x4*)(rp + bj * HALF) = pack8(acc[ai][bj][m][0], acc[ai][bj][m][1]); s += sq4(acc[ai][bj][m][0]) + sq4(acc[ai][bj][m][1]); }
                    s = fq_sum(s);
                    if (fq == 0) SSQCQ[(size_t)row * 8 + (pn - 8) * 4 + wc] = s; }
        } else if (pn == 10) {
            float p[1][2][4];
#pragma unroll
            for (int ai = 0; ai < 2; ++ai) if (ai == 0 || !u.half)
#pragma unroll
                for (int m = 0; m < 4; ++m) { float s = 0.f;
#pragma unroll
                    for (int bj = 0; bj < 2; ++bj) s += sq4(acc[ai][bj][m][0]) + sq4(acc[ai][bj][m][1]);
                    p[0][ai][m] = fq_sum(s); }
            xwave_rowsum<1>(p, scr, wr, wc, fr, fq);
            f32x4 gv[2][2];
#pragma unroll
            for (int bj = 0; bj < 2; ++bj) { gv[bj][0] = *(const f32x4*)(kvg + bj * HALF + cl); gv[bj][1] = *(const f32x4*)(kvg + bj * HALF + cl + 4); }
#pragma unroll
            for (int ai = 0; ai < 2; ++ai) if (ai == 0 || !u.half)
#pragma unroll
                for (int m = 0; m < 4; ++m) { const int row = row0 + ai * HALF + m * 16; const float r = 1.0f / sqrtf(p[0][ai][m] * (1.f / KVRANK) + EPS);
                    float* dst = (row < MP ? out + O_CKVP + (size_t)row * KVRANK : out + O_CKVS + (size_t)(row - MP) * KVRANK) + cl; bf16_t* rp = CKVN + (size_t)row * KVRANK + cl;
#pragma unroll
                    for (int bj = 0; bj < 2; ++bj) { const f32x4 a = acc[ai][bj][m][0] * r * gv[bj][0], b = acc[ai][bj][m][1] * r * gv[bj][1];
                        *(f32x4*)(dst + bj * HALF) = a; *(f32x4*)(dst + bj * HALF + 4) = b; *(u32x4*)(rp + bj * HALF) = pack8(a, b); } }
        } else {
            if (wc == 0) {
                f32x4 g1[2], g2[2];
#pragma unroll
                for (int n = 0; n < 2; ++n) { g1[n] = *(const f32x4*)(krg + 8 * fq + 4 * n); g2[n] = *(const f32x4*)(krg + 32 + 8 * fq + 4 * n); }
#pragma unroll
                for (int ai = 0; ai < 2; ++ai) if (ai == 0 || !u.half)
#pragma unroll
                    for (int m = 0; m < 4; ++m) { const int row = row0 + ai * HALF + m * 16; float s = 0.f;
#pragma unroll
                        for (int n = 0; n < 2; ++n) s += sq4(acc[ai][0][m][n]) + sq4(acc[ai][1][m][n]);
                        s = fq_sum(s); const float r = 1.0f / sqrtf(s * (1.f / DROPE) + EPS); const int pos = row_pos(row);
                        float* dst = (row < MP ? out + O_KRP + (size_t)row * DROPE : out + O_KRS + (size_t)(row - MP) * DROPE) + 8 * fq; bf16_t* rp = KRN + (size_t)row * DROPE + 8 * fq;
                        f32x4 o1[2], o2[2];
#pragma unroll
                        for (int n = 0; n < 2; ++n) { const f32x4 cs = *(const f32x4*)(COS + pos * 32 + 8 * fq + 4 * n), sn = *(const f32x4*)(SIN + pos * 32 + 8 * fq + 4 * n);
                            const f32x4 y1 = acc[ai][0][m][n] * r * g1[n], y2 = acc[ai][1][m][n] * r * g2[n]; o1[n] = y1 * cs - y2 * sn; o2[n] = y2 * cs + y1 * sn; }
                        *(f32x4*)(dst) = o1[0]; *(f32x4*)(dst + 4) = o1[1]; *(f32x4*)(dst + 32) = o2[0]; *(f32x4*)(dst + 36) = o2[1];
                        *(u32x4*)(rp) = pack8(o1[0], o1[1]); *(u32x4*)(rp + 32) = pack8(o2[0], o2[1]); }
            }
        }
    }
};

struct EpiQ {
    EPI_INIT_ZERO
    unsigned char* ws; const float* gqn; const float* gkn; const float* gqr;
    __device__ __forceinline__ void operator()(Acc& acc, const Unit& u, int wr, int wc, int fr, int fq, LAS unsigned char* scr) const {
        bf16_t* QCAT = (bf16_t*)(ws + WS_QCAT); const float* SSQCQ = (const float*)(ws + WS_SSQCQ); const float* COS = (const float*)(ws + WS_COS); const float* SIN = (const float*)(ws + WS_SIN);
        const int row0 = u.row0 + wr * 64 + fr, pn = u.pn;
        { f32x4 sa[2][4], sb[2][4];
#pragma unroll
          for (int ai = 0; ai < 2; ++ai) if (ai == 0 || !u.half)
#pragma unroll
              for (int m = 0; m < 4; ++m) { const float* sp = SSQCQ + (size_t)(row0 + ai * HALF + m * 16) * 8; sa[ai][m] = *(const f32x4*)sp; sb[ai][m] = *(const f32x4*)(sp + 4); }
#pragma unroll
          for (int ai = 0; ai < 2; ++ai) if (ai == 0 || !u.half)
#pragma unroll
              for (int m = 0; m < 4; ++m) { const f32x4 a = sa[ai][m], b = sb[ai][m];
                const float rq = 1.0f / sqrtf((((a[0] + a[1]) + (a[2] + a[3])) + ((b[0] + b[1]) + (b[2] + b[3]))) * (1.f / QRANK) + EPS);
#pragma unroll
                for (int bj = 0; bj < 2; ++bj)
#pragma unroll
                    for (int n = 0; n < 2; ++n) acc[ai][bj][m][n] *= rq; }
          asm volatile("" ::: "memory"); }
        if (pn < 4) {
            float p[2][2][4];
#pragma unroll
            for (int bj = 0; bj < 2; ++bj)
#pragma unroll
                for (int ai = 0; ai < 2; ++ai) if (ai == 0 || !u.half)
#pragma unroll
                    for (int m = 0; m < 4; ++m) p[bj][ai][m] = fq_sum(sq4(acc[ai][bj][m][0]) + sq4(acc[ai][bj][m][1]));
            xwave_rowsum<2>(p, scr, wr, wc, fr, fq);
            const int d0 = wc * 32 + 8 * fq; f32x4 gg[2];
#pragma unroll
            for (int n = 0; n < 2; ++n) gg[n] = *(const f32x4*)(gqn + d0 + 4 * n) * *(const f32x4*)(gkn + d0 + 4 * n) * C2;
#pragma unroll
            for (int ai = 0; ai < 2; ++ai) if (ai == 0 || !u.half)
#pragma unroll
                for (int m = 0; m < 4; ++m) { const int row = row0 + ai * HALF + m * 16;
#pragma unroll
                    for (int bj = 0; bj < 2; ++bj) { const float rn = 1.0f / sqrtf(p[bj][ai][m] * (1.f / DNOPE) + EPS);
                        *(u32x4*)(QCAT + (size_t)row * (NHEAD * DQK) + (2 * pn + bj) * DQK + d0) = pack8(acc[ai][bj][m][0] * rn * gg[0], acc[ai][bj][m][1] * rn * gg[1]); } }
        } else {
            const int hd = 4 * (pn - 4) + wc; f32x4 g1[2], g2[2];
#pragma unroll
            for (int n = 0; n < 2; ++n) { g1[n] = *(const f32x4*)(gqr + 8 * fq + 4 * n) * C2; g2[n] = *(const f32x4*)(gqr + 32 + 8 * fq + 4 * n) * C2; }
#pragma unroll
            for (int ai = 0; ai < 2; ++ai) if (ai == 0 || !u.half)
#pragma unroll
                for (int m = 0; m < 4; ++m) { const int row = row0 + ai * HALF + m * 16; float s = 0.f;
#pragma unroll
                    for (int n = 0; n < 2; ++n) s += sq4(acc[ai][0][m][n]) + sq4(acc[ai][1][m][n]);
                    s = fq_sum(s); const float r = 1.0f / sqrtf(s * (1.f / DROPE) + EPS); const int pos = row_pos(row);
                    f32x4 o1[2], o2[2];
#pragma unroll
                    for (int n = 0; n < 2; ++n) { const f32x4 cs = *(const f32x4*)(COS + pos * 32 + 8 * fq + 4 * n), sn = *(const f32x4*)(SIN + pos * 32 + 8 * fq + 4 * n);
                        const f32x4 y1 = acc[ai][0][m][n] * r * g1[n], y2 = acc[ai][1][m][n] * r * g2[n]; o1[n] = y1 * cs - y2 * sn; o2[n] = y2 * cs + y1 * sn; }
                    bf16_t* rp = QCAT + (size_t)row * (NHEAD * DQK) + hd * DQK + DNOPE + 8 * fq;
                    *(u32x4*)(rp) = pack8(o1[0], o1[1]); *(u32x4*)(rp + 32) = pack8(o2[0], o2[1]); }
        }
    }
};

struct EpiKV {
    EPI_INIT_ZERO
    unsigned char* ws;
    __device__ __forceinline__ void operator()(Acc& acc, const Unit& u, int wr, int wc, int fr, int fq, LAS unsigned char* scr) const {
        bf16_t* KCAT = (bf16_t*)(ws + WS_KCAT); bf16_t* V = (bf16_t*)(ws + WS_V);
        const int row0 = u.row0 + wr * 64 + fr, d0 = wc * 32 + 8 * fq, hd = u.pn;
        float p[1][2][4];
#pragma unroll
        for (int ai = 0; ai < 2; ++ai) if (ai == 0 || !u.half)
#pragma unroll
            for (int m = 0; m < 4; ++m) p[0][ai][m] = fq_sum(sq4(acc[ai][0][m][0]) + sq4(acc[ai][0][m][1]));
        xwave_rowsum<1>(p, scr, wr, wc, fr, fq);
#pragma unroll
        for (int ai = 0; ai < 2; ++ai) if (ai == 0 || !u.half)
#pragma unroll
            for (int m = 0; m < 4; ++m) { const int row = row0 + ai * HALF + m * 16; const float rk = 1.0f / sqrtf(p[0][ai][m] * (1.f / DNOPE) + EPS);
                *(u32x4*)(KCAT + (size_t)row * (NHEAD * DNOPE) + hd * DNOPE + d0) = pack8(acc[ai][0][m][0] * rk, acc[ai][0][m][1] * rk);
                *(u32x4*)(V + (size_t)row * (NHEAD * DV) + hd * DV + d0) = pack8(acc[ai][1][m][0], acc[ai][1][m][1]); }
    }
};

struct EpiOut {
    const float* xp; const float* xs; float* Y; unsigned char* ws;
    __device__ __forceinline__ void init(Acc& acc, const Unit& u, int wr, int wc, int fr, int fq) const {
        const int row0 = u.row0 + wr * 64 + fr, col0 = u.pn * BM + wc * 32 + 8 * fq;
#pragma unroll
        for (int ai = 0; ai < 2; ++ai)
#pragma unroll
            for (int m = 0; m < 4; ++m) { const int row = row0 + ai * HALF + m * 16; const float* xr = (row < MP ? xp + (size_t)row * DM : xs + (size_t)(row - MP) * DM) + col0;
#pragma unroll
                for (int bj = 0; bj < 2; ++bj) { if (ai == 0 || !u.half) { acc[ai][bj][m][0] = *(const f32x4*)(xr + bj * HALF); acc[ai][bj][m][1] = *(const f32x4*)(xr + bj * HALF + 4); }
                                                 else { acc[ai][bj][m][0] = (f32x4){0.f, 0.f, 0.f, 0.f}; acc[ai][bj][m][1] = (f32x4){0.f, 0.f, 0.f, 0.f}; } } }
    }
    __device__ __forceinline__ void operator()(Acc& acc, const Unit& u, int wr, int wc, int fr, int fq, LAS unsigned char* scr) const {
        float* SSQH = (float*)(ws + WS_SSQH); const rsrc_t rH = make_rsrc(ws + WS_HBF, (unsigned)MT * DM * 2);
        const int row0 = u.row0 + wr * 64 + fr, col0 = u.pn * BM + wc * 32 + 8 * fq;
        float p[1][2][4];
#pragma unroll
        for (int ai = 0; ai < 2; ++ai) if (ai == 0 || !u.half)
#pragma unroll
            for (int m = 0; m < 4; ++m) { const int row = row0 + ai * HALF + m * 16; float s = 0.f;
#pragma unroll
                for (int bj = 0; bj < 2; ++bj) { const f32x4 a = acc[ai][bj][m][0], b = acc[ai][bj][m][1];
                    const unsigned eo = (unsigned)(row * DM + col0 + bj * HALF);
                    st16_wt(rH, eo * 2u, pack8(a, b)); s += sq4(a) + sq4(b); }
                p[0][ai][m] = fq_sum(s); }
        xwave_rowsum<1>(p, scr, wr, wc, fr, fq);
        if (wc == 0 && fq == 0) {
#pragma unroll
            for (int ai = 0; ai < 2; ++ai) if (ai == 0 || !u.half)
#pragma unroll
                for (int m = 0; m < 4; ++m) __hip_atomic_store(SSQH + (size_t)(row0 + ai * HALF + m * 16) * 8 + u.pn, p[0][ai][m], __ATOMIC_RELAXED, __HIP_MEMORY_SCOPE_AGENT);
        }
    }
};

struct EpiGate {
    EPI_INIT_ZERO
    float* Y; unsigned char* ws; const float* bias;
    __device__ __forceinline__ void operator()(Acc& acc, const Unit& u, int wr, int wc, int fr, int fq, LAS unsigned char*) const {
        const bf16_t* PV = (const bf16_t*)(ws + WS_PV); const bf16_t* HB = (const bf16_t*)(ws + WS_HBF); const float* SSQH = (const float*)(ws + WS_SSQH);
        const int row0 = u.row0 + wr * 64 + fr, col0 = u.pn * BM + wc * 32 + 8 * fq;
        f32x4 bv[2][2];
#pragma unroll
        for (int bj = 0; bj < 2; ++bj) { bv[bj][0] = *(const f32x4*)(bias + col0 + bj * HALF); bv[bj][1] = *(const f32x4*)(bias + col0 + bj * HALF + 4); }
#pragma unroll
        for (int ai = 0; ai < 2; ++ai) if (ai == 0 || !u.half)
#pragma unroll
            for (int m = 0; m < 4; ++m) { const int row = row0 + ai * HALF + m * 16; const f32x4 sa = *(const f32x4*)(SSQH + (size_t)row * 8), sb = *(const f32x4*)(SSQH + (size_t)row * 8 + 4);
                const float rh = 1.0f / sqrtf((((sa[0] + sa[1]) + (sa[2] + sa[3])) + ((sb[0] + sb[1]) + (sb[2] + sb[3]))) * (1.f / DM) + EPS);
#pragma unroll
                for (int bj = 0; bj < 2; ++bj) { float* yp = Y + (size_t)row * DM + col0 + bj * HALF; const u32x4 pw = *(const u32x4*)(PV + (size_t)row * DM + col0 + bj * HALF);
                    const u32x4 hw = *(const u32x4*)(HB + (size_t)row * DM + col0 + bj * HALF);
                    f32x4 h0 = {__uint_as_float(hw.x << 16), __uint_as_float(hw.x & 0xffff0000u), __uint_as_float(hw.y << 16), __uint_as_float(hw.y & 0xffff0000u)};
                    f32x4 h1 = {__uint_as_float(hw.z << 16), __uint_as_float(hw.z & 0xffff0000u), __uint_as_float(hw.w << 16), __uint_as_float(hw.w & 0xffff0000u)}; const f32x4 g0 = acc[ai][bj][m][0] * rh + bv[bj][0], g1 = acc[ai][bj][m][1] * rh + bv[bj][1];
                    h0[0] += sigmoid_f(g0[0]) * __uint_as_float(pw.x << 16); h0[1] += sigmoid_f(g0[1]) * __uint_as_float(pw.x & 0xffff0000u);
                    h0[2] += sigmoid_f(g0[2]) * __uint_as_float(pw.y << 16); h0[3] += sigmoid_f(g0[3]) * __uint_as_float(pw.y & 0xffff0000u);
                    h1[0] += sigmoid_f(g1[0]) * __uint_as_float(pw.z << 16); h1[1] += sigmoid_f(g1[1]) * __uint_as_float(pw.z & 0xffff0000u);
                    h1[2] += sigmoid_f(g1[2]) * __uint_as_float(pw.w << 16); h1[3] += sigmoid_f(g1[3]) * __uint_as_float(pw.w & 0xffff0000u);
                    *(f32x4*)yp = h0; *(f32x4*)(yp + 4) = h1; }
                if (m & 1) asm volatile("" ::: "memory"); }
    }
};

struct SchedP1 { const char* ws; int c, G;
    static constexpr bool SPLITK = false;
    __device__ __forceinline__ float* slab(const Unit&) const { return nullptr; }
    __device__ __forceinline__ unsigned* ticket(const Unit&) const { return nullptr; }
    __device__ __forceinline__ void a_ready(const Unit&, int) const {}
    __device__ __forceinline__ void done(const Unit&, int) const {}
    __device__ __forceinline__ bool get(int i, Unit& u) const {
        constexpr int NF = 32 * 16, NH = 4 * 16; int nf = (NF - c + G - 1) / G; nf = nf < 0 ? 0 : nf;
        u.lda = DM; u.ldb = DM; u.nt = DM / BK; u.type = 0; u.slice = -1; u.uid = 0;
        if (i < nf) { int pm, pn; grid_map(c + i * G, 32, 16, pm, pn); u.row0 = pm * BM; u.pn = pn; u.half = 0; }
        else { const int t = c + (i - nf) * G; if (t >= NH) return false; u.row0 = MP + (t >> 4) * HALF; u.pn = t & 15; u.half = 1; }
        u.A = ws + WS_XN + (size_t)u.row0 * DM * 2; u.B = ws + WS_WIN + (size_t)u.pn * BM * DM * 2; return true; }
};
struct SchedP2 { const char* ws; int c, G;
    static constexpr bool SPLITK = false;
    __device__ __forceinline__ float* slab(const Unit&) const { return nullptr; }
    __device__ __forceinline__ unsigned* ticket(const Unit&) const { return nullptr; }
    __device__ __forceinline__ void a_ready(const Unit&, int) const {}
    __device__ __forceinline__ void done(const Unit&, int) const {}
    __device__ __forceinline__ bool get(int i, Unit& u) const {
        int L = c + i * G, pm, pn; u.half = 0; u.slice = -1; u.uid = 0;
        if (L < 204) { grid_map(L, 34, 6, pm, pn); u.type = 0; u.lda = QRANK; u.ldb = QRANK; u.nt = QRANK / BK; u.row0 = pm * BM; u.pn = pn;
            u.A = ws + WS_CQ + (size_t)u.row0 * QRANK * 2; u.B = ws + WS_WUQ + (size_t)pn * BM * QRANK * 2; return true; }
        L -= 204;
        if (L < 256) { grid_map(L, 32, 8, pm, pn); u.type = 1; u.lda = KVRANK; u.ldb = KVRANK; u.nt = KVRANK / BK; u.row0 = pm * BM; u.pn = pn;
            u.A = ws + WS_CKVN + (size_t)u.row0 * KVRANK * 2; u.B = ws + WS_WUKV + (size_t)pn * BM * KVRANK * 2; return true; }
        L -= 256;
        if (L < 144) { grid_map(L, 36, 4, pm, pn); u.type = 2; u.lda = DPOOL; u.ldb = 256; u.nt = 4; u.row0 = pm * BM; u.pn = pn;
            u.A = ws + WS_UBF + ((size_t)u.row0 * DPOOL + pn * 256) * 2; u.B = ws + WS_WPOOL + (size_t)pn * BM * 256 * 2; return true; }
        return false; }
};
struct EpiP2 { unsigned char* ws;
    EPI_INIT_ZERO
    __device__ __forceinline__ void operator()(Acc& acc, const Unit& u, int wr, int wc, int fr, int fq, LAS unsigned char* scr) const {
        if (u.type == 0) { const EpiQ q{ws, arg_in(13), arg_in(15), arg_in(14)}; q(acc, u, wr, wc, fr, fq, scr); }
        else if (u.type == 1) { const EpiKV kv{ws}; kv(acc, u, wr, wc, fr, fq, scr); }
        else { const EpiBf16 z{(bf16_t*)(ws + WS_Z), DPOOL, 0}; z(acc, u, wr, wc, fr, fq, scr); } }
};

struct SchedP45 { const char* ws; unsigned* cnt; int c, G, stream;
    static constexpr bool SPLITK = true;
    __device__ __forceinline__ bool warm(const Unit&) const { return false; }
    __device__ __forceinline__ int panel_of(const Unit& u) const { return u.row0 < MP ? (u.row0 >> 8) : 32 + ((u.row0 - MP) >> 7); }
    __device__ __forceinline__ float* slab(const Unit& u) const { return (float*)(ws + (u.type == 0 ? WS_SGM : WS_V)) + (size_t)u.uid * (4 * HALF * BM); }
    __device__ __forceinline__ unsigned* ticket(const Unit& u) const { return cnt + 64 * ((u.type == 0 ? 38 : 70) + u.uid); }
    __device__ __forceinline__ bool get(int i, Unit& u) const {
        constexpr int NF = 32 * 8, NS = 32 * 4, NH = 32; int pm = 0, pn = 0, type, row0, half = 0, slice = -1, uid = 0; bool ok = true;
        int nf = (NF - c + G - 1) / G; nf = nf < 0 ? 0 : nf; int ns = (NS - c + G - 1) / G; ns = ns < 0 ? 0 : ns;
        const int c2 = (c + G - (128 % G)) % G; int ns2 = (NS - c2 + G - 1) / G; ns2 = ns2 < 0 ? 0 : ns2;
        if (stream == 1) {
            if (i < 2 * nf) { grid_map(c + (i >> 1) * G, 32, 8, pm, pn); type = (i & 1) ? 1 : 0; row0 = pm * BM; }
            else if (i - 2 * nf < ns) { const int j = c + (i - 2 * nf) * G; type = 0; uid = j >> 2; slice = j & 3; row0 = MP + (uid >> 3) * HALF; pn = uid & 7; half = 1; }
            else { const int t = c2 + (i - 2 * nf - ns) * G; ok = t < NH; type = 1; row0 = MP + ((t >> 3) & 3) * HALF; pn = t & 7; half = 1; }
        } else {
            type = 2;
            if (i < nf) { grid_map(c + i * G, 32, 8, pm, pn); row0 = pm * BM; }
            else { const int j = c2 + (i - nf) * G; ok = j < NS; uid = (j >> 2) & 31; slice = j & 3; row0 = MP + (uid >> 3) * HALF; pn = uid & 7; half = 1; }
        }
        const bool ple = type == 1; const int ld = ple ? DPLE : DM; const int nt = slice >= 0 ? 8 : ld / BK; const size_t koff = slice >= 0 ? (size_t)slice * 8 * BK * 2 : 0;
        u.type = type; u.row0 = row0; u.pn = pn; u.half = half; u.slice = slice; u.uid = uid; u.lda = ld; u.ldb = ld; u.nt = nt;
        u.A = ws + (ple ? WS_PBF : (type == 0 ? WS_MIX : WS_HBF)) + (size_t)row0 * ld * 2 + koff;
        u.B = ws + (ple ? WS_WPLE : (type == 0 ? WS_WOUT : WS_WGATE)) + (size_t)pn * BM * ld * 2 + koff;
        return ok; }
    __device__ __forceinline__ void a_ready(const Unit& u, int wid) const {
        if (u.type != 2) return;
        if (wid == 0) {
            unsigned* p1 = cnt + 64 * panel_of(u); unsigned* p2 = cnt + 64 * 37; const unsigned need2 = u.half ? 32u : 0u; unsigned sp = 0;
            while ((unsigned)__builtin_amdgcn_readfirstlane(__hip_atomic_load(p1, __ATOMIC_RELAXED, __HIP_MEMORY_SCOPE_AGENT)) < 8u ||
                   (unsigned)__builtin_amdgcn_readfirstlane(__hip_atomic_load(p2, __ATOMIC_RELAXED, __HIP_MEMORY_SCOPE_AGENT)) < need2) { __builtin_amdgcn_s_sleep(2); if (++sp > (1u << 24)) break; }
            __builtin_amdgcn_fence(__ATOMIC_ACQUIRE, "agent");
            asm volatile("s_waitcnt vmcnt(0)" ::: "memory");
        }
        asm volatile("" ::: "memory"); __builtin_amdgcn_s_barrier(); asm volatile("" ::: "memory");
    }
    __device__ __forceinline__ void done(const Unit& u, int wid) const {
        if (u.type == 2 || (u.type == 1 && !u.half)) return;
        asm volatile("s_waitcnt vmcnt(0)" ::: "memory");
        __builtin_amdgcn_s_barrier(); asm volatile("" ::: "memory");
        if (wid == 0 && lane_id() == 0) __hip_atomic_fetch_add(cnt + 64 * (u.type == 1 ? 37 : panel_of(u)), 1u, __ATOMIC_RELAXED, __HIP_MEMORY_SCOPE_AGENT);
    }
};
struct EpiP45 { unsigned char* ws; float* out;
    __device__ __forceinline__ void init(Acc& acc, const Unit& u, int wr, int wc, int fr, int fq) const {
        if (u.type == 0 && u.slice <= 0) { const EpiOut o{arg_in(0), arg_in(1), out + O_Y, ws}; o.init(acc, u, wr, wc, fr, fq); } else acc_zero(acc); }
    __device__ __forceinline__ void operator()(Acc& acc, const Unit& u, int wr, int wc, int fr, int fq, LAS unsigned char* scr) const {
        if (u.type == 0) { const EpiOut o{nullptr, nullptr, out + O_Y, ws}; o(acc, u, wr, wc, fr, fq, scr); }
        else if (u.type == 1) { const EpiBf16 e{(bf16_t*)(ws + WS_PV), DM, u.half}; e(acc, u, wr, wc, fr, fq, scr); }
        else { const EpiGate g{out + O_Y, ws, arg_in(22)}; g(acc, u, wr, wc, fr, fq, scr); } }
};
}

struct Args { const float* in[24]; float* out; unsigned char* ws; int ph_lo, ph_hi, li, pad; };
enum { I_XP = 0, I_XS, I_CCKV, I_CKR, I_SPOOL, I_PP, I_PS, I_NORMG, I_WIN, I_QNG, I_WUQ, I_KVNG, I_WUKV, I_QNOPEG, I_QROPEG, I_KNOPEG, I_KROPEG, I_WPOOL, I_PSCALE, I_WOUT, I_PLENG, I_WGATE, I_BGATE, I_WPLE };


__device__ __forceinline__ void cache_item(const float* W, bf16_t* CB, bf16_t* CT, int k0, int n0, LAS float* scr, int lane, bool doB, bool doT) {
    float tv[32];
#pragma unroll
    for (int i = 0; i < 32; ++i) tv[i] = W[(size_t)(k0 + 2 * i + (lane >> 5)) * KVRANK + n0 + (lane & 31)];
#pragma unroll
    for (int i = 0; i < 32; ++i) scr[(2 * i + (lane >> 5)) * 33 + (lane & 31)] = tv[i];
    LDS_WAIT(); asm volatile("" ::: "memory");
    const int kb0 = k0 >> 5, s0 = n0 >> 4;
#pragma unroll
    for (int c = 0; c < 4; ++c) { const int kbl = c >> 1, sl = c & 1;
        if (doB) { const LAS float* p = scr + (kbl * 32 + (lane & 31)) * 33 + sl * 16 + 8 * (lane >> 5);
          u32x4 o; o.x = cvtpk(p[0], p[1]); o.y = cvtpk(p[2], p[3]); o.z = cvtpk(p[4], p[5]); o.w = cvtpk(p[6], p[7]);
          *(u32x4*)(CB + ((size_t)((kb0 + kbl) * 16 + s0 + sl) * 64 + lane) * 8) = o; }
        if (doT) { const LAS float* p = scr + (kbl * 32 + 8 * (lane >> 4)) * 33 + sl * 16 + (lane & 15);
          u32x4 o; o.x = cvtpk(p[0 * 33], p[1 * 33]); o.y = cvtpk(p[2 * 33], p[3 * 33]); o.z = cvtpk(p[4 * 33], p[5 * 33]); o.w = cvtpk(p[6 * 33], p[7 * 33]);
          *(u32x4*)(CT + ((size_t)((kb0 + kbl) * 16 + s0 + sl) * 64 + lane) * 8) = o; } }
    LDS_WAIT(); asm volatile("" ::: "memory");
}
__device__ __forceinline__ bf16_t* ckvb_base(float* out, int b) { return (bf16_t*)((unsigned char*)out + OB_CKVB + (size_t)b * CKVT_B); }
__device__ __forceinline__ bf16_t* ckvt_base(float* out, int b) { return (bf16_t*)((unsigned char*)out + OB_CKVT + (size_t)b * CKVT_B); }

__device__ __forceinline__ void transpose_item(const float* W, int N, bf16_t* WT, int ldt, int k0, int n0, int drow0, const float* kgain, LAS float* scr, int lane) {
    float tv[32];
#pragma unroll
    for (int i = 0; i < 32; ++i) tv[i] = W[(size_t)(k0 + 2 * i + (lane >> 5)) * N + n0 + (lane & 31)];
    if (kgain) {
#pragma unroll
        for (int i = 0; i < 32; ++i) tv[i] *= kgain[k0 + 2 * i + (lane >> 5)]; }
#pragma unroll
    for (int i = 0; i < 32; ++i) scr[(2 * i + (lane >> 5)) * 33 + (lane & 31)] = tv[i];
    LDS_WAIT(); asm volatile("" ::: "memory");
    const int c = lane & 7;
#pragma unroll
    for (int j = 0; j < 4; ++j) { const int n = (lane >> 3) + 8 * j; const LAS float* s = scr + (8 * c) * 33 + n;
        u32x4 o; o.x = cvtpk(s[0 * 33], s[1 * 33]); o.y = cvtpk(s[2 * 33], s[3 * 33]); o.z = cvtpk(s[4 * 33], s[5 * 33]); o.w = cvtpk(s[6 * 33], s[7 * 33]);
        *(u32x4*)(WT + (size_t)(drow0 + n) * ldt + k0 + 8 * c) = o; }
    LDS_WAIT(); asm volatile("" ::: "memory");
}

__device__ __forceinline__ void p0_prologue(const Args& a, LAS unsigned char* lds, int vcu, int G, int wv, int part) {
    const int lane = lane_id(), wave = wv, tid = (wv << 6) | lane;
    LAS float* scr = (LAS float*)(lds + wave * 16384);
    const int gw = vcu * 8 + wave, NGW = G * 8;
    unsigned char* ws = a.ws;
    bf16_t* Win_t = (bf16_t*)(ws + WS_WIN);
    const int gt = vcu * 512 + tid, NGT = G * 512;
    if (part == 0) {
        constexpr int I_IN = 32 * 122;
        { const float* W = AIN(I_WIN);
          for (int r = gw; r < I_IN; r += NGW) { const int kb = r / 122, nb = r % 122, n0 = 32 * nb; const int d = n0 < 2816 ? n0 : (n0 == 2816 ? 3840 : (n0 == 2848 ? 3968 : n0 - 64));
              transpose_item(W, DIN, Win_t, DM, 64 * kb, n0, d, nullptr, scr, lane); } }
        {
            bf16_t* XN = (bf16_t*)(ws + WS_XN); const float* gp = AIN(I_NORMG); const float* xp = AIN(I_XP); const float* xs = AIN(I_XS);
            for (int m = gw; m < MT; m += NGW) {
                const float* xr = (m < MP ? xp + (size_t)m * DM : xs + (size_t)(m - MP) * DM) + 4 * lane;
                f32x4 v[8]; float sm = 0.f;
#pragma unroll
                for (int j = 0; j < 8; ++j) { v[j] = *(const f32x4*)(xr + 256 * j); sm += pg8::sq4(v[j]); }
                const float r = 1.0f / sqrtf(wave_sum(sm) * (1.f / DM) + EPS);
#pragma unroll
                for (int j = 0; j < 8; ++j) { const f32x4 gv = *(const f32x4*)(gp + 4 * lane + 256 * j); const f32x4 o = v[j] * r * gv;
                    u32x2 w; w.x = cvtpk(o[0], o[1]); w.y = cvtpk(o[2], o[3]); *(u32x2*)(XN + (size_t)m * DM + 4 * lane + 256 * j) = w; }
            }
        }
        {
            float* COS = (float*)(ws + WS_COS); float* SIN = (float*)(ws + WS_SIN);
            for (int i = tid * G + vcu; i < SKV_S * 32; i += 512 * G) { const int pos = i >> 5, fi = i & 31; const float inv = (float)exp(-(double)fi * (1.0 / 32.0) * 9.210340371976184); const float ang = (float)pos * inv;
                float sv, cv; sincosf(ang, &sv, &cv); COS[i] = cv; SIN[i] = sv; }
        }
        {
            for (int i = gt; i < 192 * (DM / 8); i += NGT) { const int rr = i >> 8, c = (i & 255) * 8; const int row = 3840 + (rr < 96 ? 32 + rr : 160 + (rr - 96));
                *(u32x4*)(Win_t + (size_t)row * DM + c) = (u32x4){0u, 0u, 0u, 0u}; }
        }
        return;
    }
    bf16_t* Wuq_t = (bf16_t*)(ws + WS_WUQ); bf16_t* Wukv_t = (bf16_t*)(ws + WS_WUKV); bf16_t* Wpool_t = (bf16_t*)(ws + WS_WPOOL);
    bf16_t* Wout_t = (bf16_t*)(ws + WS_WOUT); bf16_t* Wgate_t = (bf16_t*)(ws + WS_WGATE); bf16_t* Wple_t = (bf16_t*)(ws + WS_WPLE);
    constexpr int I_UQ = 8 * 48, I_UKV = 4 * 64, I_POOL = 4 * 4 * 8, I_OUT = 32 * 64, I_GATE = 32 * 64, I_PLE = 4 * 64;
    constexpr int NITEMS = I_UQ + I_UKV + I_POOL + I_OUT + I_GATE + I_PLE;
    static_assert(NITEMS == 5120, "chunk map");
    unsigned* cctr = (unsigned*)(ws + WS_CTL) + 11776 + 64 * a.li;
    volatile LAS unsigned* MISCp = (volatile LAS unsigned*)(lds + MISC_OFF);
    for (;;) {
        if (tid == 0) MISCp[23] = __hip_atomic_fetch_add(cctr, 1u, __ATOMIC_RELAXED, __HIP_MEMORY_SCOPE_AGENT);
        __syncthreads();
        const int ch = (int)MISCp[23];
        __syncthreads();
        if (ch >= 852 + NBT_A * 32) break;
        if (ch >= 852) { const int item = (ch - 852) * 8 + wave, bb = item >> 8, kbk = (item & 255) >> 3, nb = item & 7;
            cache_item(AIN(I_CCKV) + (size_t)bb * PAST * KVRANK, ckvb_base(a.out, bb), ckvt_base(a.out, bb), 64 * kbk, 32 * nb, scr, lane, true, true); continue; }
        if (ch < 640) {
            int r = ch * 8 + wave;
            if (r < I_UQ) { const int kb = r / 48, nb = r % 48, n0 = 32 * nb, h = n0 / DQK, j0 = n0 % DQK;
                const int d = j0 < 128 ? h * 128 + j0 : 1024 + 256 * (h >> 2) + 32 * (h & 3) + (j0 == 160 ? 128 : 0);
                transpose_item(AIN(I_WUQ), NHEAD * DQK, Wuq_t, QRANK, 64 * kb, n0, d, AIN(I_QNG), scr, lane); continue; } r -= I_UQ;
            if (r < I_UKV) { const int kb = r / 64, nb = r % 64; transpose_item(AIN(I_WUKV), 2048, Wukv_t, KVRANK, 64 * kb, 32 * nb, 32 * nb, nullptr, scr, lane); continue; } r -= I_UKV;
            if (r < I_POOL) { const int gq = r / 32, kb = (r % 32) / 8, nb = r % 8; transpose_item(AIN(I_WPOOL) + (size_t)gq * 65536, 256, Wpool_t, 256, 64 * kb, 32 * nb, gq * 256 + 32 * nb, nullptr, scr, lane); continue; } r -= I_POOL;
            if (r < I_OUT) { const int kb = r / 64, nb = r % 64; transpose_item(AIN(I_WOUT), DM, Wout_t, DM, 64 * kb, 32 * nb, 32 * nb, nullptr, scr, lane); continue; } r -= I_OUT;
            if (r < I_GATE) { const int kb = r / 64, nb = r % 64; transpose_item(AIN(I_WGATE), DM, Wgate_t, DM, 64 * kb, 32 * nb, 32 * nb, AIN(I_PLENG), scr, lane); continue; } r -= I_GATE;
            { const int kb = r / 64, nb = r % 64; transpose_item(AIN(I_WPLE), DM, Wple_t, DPLE, 64 * kb, 32 * nb, 32 * nb, nullptr, scr, lane); }
        } else if (ch < 708) {
            bf16_t* PBF = (bf16_t*)(ws + WS_PBF); const float* pp = AIN(I_PP); const float* ps = AIN(I_PS);
#pragma unroll
            for (int k = 0; k < 8; ++k) { const int i = (ch - 640) * 4096 + tid + k * 512, m = i >> 5, c = (i & 31) * 8; const float* src = (m < MP ? pp + (size_t)m * DPLE : ps + (size_t)(m - MP) * DPLE) + c;
                *(u32x4*)(PBF + (size_t)m * DPLE + c) = pack8(*(const f32x4*)src, *(const f32x4*)(src + 4)); }
        } else if (ch < 724) {
            bf16_t* UBF = (bf16_t*)(ws + WS_UBF); const float* sp = AIN(I_SPOOL);
#pragma unroll
            for (int k = 0; k < 8; ++k) { const int i = (ch - 708) * 4096 + tid + k * 512, rr = i >> 7, c = (i & 127) * 8; u32x4 w = {0u, 0u, 0u, 0u};
                if (rr < DBATCH * POOLH) { const float* src = sp + (size_t)rr * DPOOL + c; w = pack8(*(const f32x4*)src, *(const f32x4*)(src + 4)); }
                *(u32x4*)(UBF + (size_t)(MT + rr) * DPOOL + c) = w; }
        } else {
            const float* src = AIN(I_CKR) + (size_t)(ch - 724) * 32768; bf16_t* dst = (bf16_t*)(ws + WS_KRB) + (size_t)(ch - 724) * 32768;
#pragma unroll
            for (int k = 0; k < 8; ++k) { const int o = tid * 8 + k * 4096; *(u32x4*)(dst + o) = pack8(*(const f32x4*)(src + o), *(const f32x4*)(src + o + 4)); }
        }
    }
}

namespace pattn {
constexpr int KVBLK = 64, NW = 8, QBLK = 32;
constexpr int SHM_V = 16384, SHM_KN = 16384, SHM_KR = 8192;
constexpr int L_V = 0, L_KN = 2 * SHM_V, L_KR = L_KN + 2 * SHM_KN, L_WS = L_KR + 2 * SHM_KR, L_END = L_WS + NW * 64 * 4;
constexpr int LDQ = NHEAD * DQK, LDK = NHEAD * DNOPE, LDV = NHEAD * DV;
constexpr float THR = 4.0f;
#define KSWZ(row, colB) ((row) * 256 + ((colB) ^ (((row) & 7) << 4)))
#define RSWZ(row, colB) ((row) * 128 + ((colB) ^ (((row) & 7) << 4)))
__device__ __forceinline__ int crow(int r, int hi) { return (r & 3) + 8 * (r >> 2) + 4 * hi; }

__device__ __forceinline__ void partialSM(f32x16& p0, f32x16& p1, float& m_reg, float& alpha) {
    float pmax = p0[0];
#pragma unroll
    for (int r = 1; r < 16; ++r) pmax = fmaxf(pmax, p0[r]);
#pragma unroll
    for (int r = 0; r < 16; ++r) pmax = fmaxf(pmax, p1[r]);
    { auto rr = __builtin_amdgcn_permlane32_swap(__float_as_uint(pmax), __float_as_uint(pmax), false, false); pmax = fmaxf(__uint_as_float(rr[0]), __uint_as_float(rr[1])); }
    float mn;
    if (__builtin_expect(__all(pmax - m_reg <= THR), 1)) { mn = m_reg; alpha = 1.f; }
    else { mn = fmaxf(m_reg, pmax); alpha = __builtin_amdgcn_exp2f(m_reg - mn); m_reg = mn; }
#pragma unroll
    for (int r = 0; r < 16; ++r) p0[r] = p0[r] - mn;
#pragma unroll
    for (int r = 0; r < 16; ++r) p1[r] = p1[r] - mn;
#pragma unroll
    for (int r = 0; r < 16; ++r) p0[r] = __builtin_amdgcn_exp2f(p0[r]);
}
__device__ __forceinline__ void finishSM(f32x16& p0, f32x16& p1, float alpha, float& l_reg, bf16x8& pa0, bf16x8& pa1, bf16x8& pa2, bf16x8& pa3) {
#pragma unroll
    for (int r = 0; r < 16; ++r) p1[r] = __builtin_amdgcn_exp2f(p1[r]);
    float ps = 0;
#pragma unroll
    for (int r = 0; r < 16; ++r) ps += p0[r];
#pragma unroll
    for (int r = 0; r < 16; ++r) ps += p1[r];
    { auto rr = __builtin_amdgcn_permlane32_swap(__float_as_uint(ps), __float_as_uint(ps), false, false); ps = __uint_as_float(rr[0]) + __uint_as_float(rr[1]); }
    l_reg = l_reg * alpha + ps;
#define PK4(P, BASE, OUT) do { unsigned a0 = cvtpk(P[BASE + 0], P[BASE + 1]), a1 = cvtpk(P[BASE + 2], P[BASE + 3]);   \
    unsigned b0 = cvtpk(P[BASE + 4], P[BASE + 5]), b1 = cvtpk(P[BASE + 6], P[BASE + 7]);                              \
    auto r0 = __builtin_amdgcn_permlane32_swap(a0, b0, false, false); auto r1 = __builtin_amdgcn_permlane32_swap(a1, b1, false, false); \
    u32x4 w = {r0[0], r1[0], r0[1], r1[1]}; OUT = __builtin_bit_cast(bf16x8, w); } while (0)
    PK4(p0, 0, pa0); PK4(p0, 8, pa1); PK4(p1, 0, pa2); PK4(p1, 8, pa3);
#undef PK4
}
__device__ __forceinline__ void qkt(f32x16& p0, f32x16& p1, LAS const unsigned char* Kn, LAS const unsigned char* Kr, const bf16x8* qr, int r32, int hi) {
    p0 = f32x16{}; p1 = f32x16{};
#pragma unroll
    for (int d0 = 0; d0 < 8; ++d0) { const int cb = (d0 * 16 + hi * 8) * 2;
        const bf16x8 b0 = *(LAS const bf16x8*)(Kn + KSWZ(r32, cb)); const bf16x8 b1 = *(LAS const bf16x8*)(Kn + KSWZ(32 + r32, cb));
        p0 = __builtin_amdgcn_mfma_f32_32x32x16_bf16(b0, qr[d0], p0, 0, 0, 0); p1 = __builtin_amdgcn_mfma_f32_32x32x16_bf16(b1, qr[d0], p1, 0, 0, 0); }
#pragma unroll
    for (int d0 = 0; d0 < 4; ++d0) { const int cb = (d0 * 16 + hi * 8) * 2;
        const bf16x8 b0 = *(LAS const bf16x8*)(Kr + RSWZ(r32, cb)); const bf16x8 b1 = *(LAS const bf16x8*)(Kr + RSWZ(32 + r32, cb));
        p0 = __builtin_amdgcn_mfma_f32_32x32x16_bf16(b0, qr[8 + d0], p0, 0, 0, 0); p1 = __builtin_amdgcn_mfma_f32_32x32x16_bf16(b1, qr[8 + d0], p1, 0, 0, 0); }
}
__device__ __forceinline__ int v_st(int k, int c) { const int kk = (k & ~0xC) | ((k & 4) << 1) | ((k & 8) >> 1); return ((kk >> 3) * 4 + (c >> 5)) * 512 + ((kk & 7) * 32 + (c & 31)) * 2; }
__device__ __forceinline__ int v_rd_base(int lane) { return ((lane & 3) << 3) | (((lane >> 2) & 3) << 6) | (((lane >> 4) & 1) << 5) | (((lane >> 5) & 1) << 8); }
constexpr int v_rd_off(int d0, int ks, int half) { return d0 * 512 + ks * 4096 + half * 2048; }
template <int OFF> __device__ __forceinline__ s16x4 tr_read(int vb) { s16x4 r; asm volatile("ds_read_b64_tr_b16 %0, %1 offset:%2" : "=&v"(r) : "v"(vb), "i"(OFF) : "memory"); return r; }
template <int D0> __device__ __forceinline__ void pv_one(f32x16& od, int vb, bf16x8 pa0, bf16x8 pa1, bf16x8 pa2, bf16x8 pa3) {
    const s16x4 l0 = tr_read<v_rd_off(D0, 0, 0)>(vb), h0 = tr_read<v_rd_off(D0, 0, 1)>(vb), l1 = tr_read<v_rd_off(D0, 1, 0)>(vb), h1 = tr_read<v_rd_off(D0, 1, 1)>(vb);
    const s16x4 l2 = tr_read<v_rd_off(D0, 2, 0)>(vb), h2 = tr_read<v_rd_off(D0, 2, 1)>(vb), l3 = tr_read<v_rd_off(D0, 3, 0)>(vb), h3 = tr_read<v_rd_off(D0, 3, 1)>(vb);
    asm volatile("s_waitcnt lgkmcnt(0)" ::: "memory"); SBAR();
#define PK(L, H) (bf16x8){L[0], L[1], L[2], L[3], H[0], H[1], H[2], H[3]}
    od = __builtin_amdgcn_mfma_f32_32x32x16_bf16(pa0, PK(l0, h0), od, 0, 0, 0);
    od = __builtin_amdgcn_mfma_f32_32x32x16_bf16(pa1, PK(l1, h1), od, 0, 0, 0);
    od = __builtin_amdgcn_mfma_f32_32x32x16_bf16(pa2, PK(l2, h2), od, 0, 0, 0);
    od = __builtin_amdgcn_mfma_f32_32x32x16_bf16(pa3, PK(l3, h3), od, 0, 0, 0);
#undef PK
}
__device__ __forceinline__ void pv_d0(f32x16* o, int vb, bf16x8 pa0, bf16x8 pa1, bf16x8 pa2, bf16x8 pa3) {
    pv_one<0>(o[0], vb, pa0, pa1, pa2, pa3); pv_one<1>(o[1], vb, pa0, pa1, pa2, pa3); pv_one<2>(o[2], vb, pa0, pa1, pa2, pa3); pv_one<3>(o[3], vb, pa0, pa1, pa2, pa3);
}

__device__ __forceinline__ void unit(int b, int h, int qb, const bf16_t* __restrict__ QCAT, const bf16_t* __restrict__ KCAT, const bf16_t* __restrict__ KRN, const bf16_t* __restrict__ Vb, const bf16_t* __restrict__ SGM, bf16_t* MIX, LAS unsigned char* lds, int wv) {
    int lane = lane_id(); asm volatile("" : "+v"(lane));
    const int wid = wv, tid = (wv << 6) | lane, r32 = lane & 31, hi = lane >> 5;
    const long rowbase = (long)b * SEQ; const int q0 = qb * 256;
    LAS unsigned char* V_lds = lds + L_V; LAS unsigned char* KN_lds = lds + L_KN; LAS unsigned char* KR_lds = lds + L_KR;
    LAS float* wsf = (LAS float*)(lds + L_WS) + wid * 64; LAS float* li_l = wsf; LAS float* al_l = wsf + 32;
    const bf16_t* Kh = KCAT + rowbase * LDK + h * DNOPE; const bf16_t* Vh = Vb + rowbase * LDV + h * DV; const bf16_t* Kr = KRN + rowbase * DROPE;
    float m_reg = -1e30f, l_reg = 0.f; f32x16 o[4]; o[0] = f32x16{}; o[1] = f32x16{}; o[2] = f32x16{}; o[3] = f32x16{};
    bf16x8 qr[12];
    { const bf16_t* Qw = QCAT + (rowbase + q0 + wid * QBLK + r32) * LDQ + h * DQK + hi * 8;
#pragma unroll
      for (int d0 = 0; d0 < 12; ++d0) qr[d0] = *(const bf16x8*)(Qw + d0 * 16); }
    const int cw = 4 * qb + (wid >> 1);
    const int NT = 4 * qb + 4;
    const int sr = tid >> 4, sc = (tid & 15) * 8, vst0 = v_st(sr, sc), vst1 = v_st(32 + sr, sc);
    const int krr = tid >> 3, krc = (tid & 7) * 8;
    const int vb0 = (int)(uintptr_t)V_lds + v_rd_base(lane);
    bf16x8 sv0, sv1, sk0, sk1, skr;
#define SLOAD(k0) do { sv0 = *(const bf16x8*)(Vh + (long)((k0) + sr) * LDV + sc); sv1 = *(const bf16x8*)(Vh + (long)((k0) + 32 + sr) * LDV + sc); \
    sk0 = *(const bf16x8*)(Kh + (long)((k0) + sr) * LDK + sc); sk1 = *(const bf16x8*)(Kh + (long)((k0) + 32 + sr) * LDK + sc); \
    skr = *(const bf16x8*)(Kr + (long)((k0) + krr) * DROPE + krc); } while (0)
#define SWRITE(bb) do { *(LAS bf16x8*)(V_lds + (bb) * SHM_V + vst0) = sv0; *(LAS bf16x8*)(V_lds + (bb) * SHM_V + vst1) = sv1; \
    *(LAS bf16x8*)(KN_lds + (bb) * SHM_KN + KSWZ(sr, sc * 2)) = sk0; *(LAS bf16x8*)(KN_lds + (bb) * SHM_KN + KSWZ(32 + sr, sc * 2)) = sk1; \
    *(LAS bf16x8*)(KR_lds + (bb) * SHM_KR + RSWZ(krr, krc * 2)) = skr; } while (0)
#define RESC(a) do { if (__any((a) < 1.f)) { if (hi == 0) al_l[r32] = (a); asm volatile("s_waitcnt lgkmcnt(0)" ::: "memory"); \
    _Pragma("unroll") for (int d = 0; d < 4; ++d) _Pragma("unroll") for (int r = 0; r < 16; ++r) o[d][r] *= al_l[crow(r, hi)]; } } while (0)
#define QKT(P0, P1, bb, j) do { if ((j) <= cw) qkt(P0, P1, KN_lds + (bb) * SHM_KN, KR_lds + (bb) * SHM_KR, qr, r32, hi); \
    else { _Pragma("unroll") for (int r = 0; r < 16; ++r) { P0[r] = -1e30f; P1[r] = -1e30f; } } } while (0)
#define PV(bb, j) do { if ((j) <= cw) pv_d0(o, vb0 + (bb) * SHM_V, pa0, pa1, pa2, pa3); } while (0)
    f32x16 pA0, pA1, pB0, pB1; float alA, alB; bf16x8 pa0, pa1, pa2, pa3;
    SLOAD(0); SWRITE(0); __syncthreads();
    QKT(pA0, pA1, 0, 0); partialSM(pA0, pA1, m_reg, alA);
    SLOAD(KVBLK); SWRITE(1); __syncthreads();
    for (int j = 1; j + 1 < NT; j += 2) {
        SBAR(); QKT(pB0, pB1, 1, j);
        finishSM(pA0, pA1, alA, l_reg, pa0, pa1, pa2, pa3); SBAR();
        SLOAD((j + 1) * KVBLK); SBAR();
        PV(0, j - 1); partialSM(pB0, pB1, m_reg, alB);
        __syncthreads(); SWRITE(0);
        RESC(alB); __syncthreads();
        SBAR(); QKT(pA0, pA1, 0, j + 1);
        finishSM(pB0, pB1, alB, l_reg, pa0, pa1, pa2, pa3); SBAR();
        SLOAD((j + 2) * KVBLK); SBAR();
        PV(1, j); partialSM(pA0, pA1, m_reg, alA);
        __syncthreads(); SWRITE(1);
        RESC(alA); __syncthreads();
    }
    SBAR(); QKT(pB0, pB1, 1, NT - 1);
    finishSM(pA0, pA1, alA, l_reg, pa0, pa1, pa2, pa3); SBAR();
    PV(0, NT - 2); partialSM(pB0, pB1, m_reg, alB);
    __syncthreads(); RESC(alB);
    finishSM(pB0, pB1, alB, l_reg, pa0, pa1, pa2, pa3); SBAR();
    PV(1, NT - 1);
    if (hi == 0) li_l[r32] = l_reg; asm volatile("s_waitcnt lgkmcnt(0)" ::: "memory");
    float rli[16];
#pragma unroll
    for (int r = 0; r < 16; ++r) rli[r] = __builtin_amdgcn_rcpf(li_l[crow(r, hi)]);
    __syncthreads();
    LAS bf16_t* stg = (LAS bf16_t*)(lds + wid * 8192);
#pragma unroll
    for (int r = 0; r < 16; ++r) { const int orow = crow(r, hi);
#pragma unroll
        for (int d0 = 0; d0 < 4; ++d0) { const float v = o[d0][r] * rli[r]; stg[orow * 128 + d0 * 32 + r32] = (bf16_t)(cvtpk(v, 0.f) & 0xffffu); } }
    asm volatile("s_waitcnt lgkmcnt(0)" ::: "memory");
    const long orow0 = rowbase + q0 + wid * QBLK;
#pragma unroll
    for (int i = 0; i < 8; ++i) { const int row = i * 4 + (lane >> 4), ch = lane & 15; const u32x4 v = *(LAS const u32x4*)(stg + row * 128 + ch * 8);
        const u32x4 gq = *(const u32x4*)(SGM + (orow0 + row) * 1024 + h * DV + ch * 8); u32x4 w;
        w.x = cvtpk(__uint_as_float(v.x << 16) * __uint_as_float(gq.x << 16), __uint_as_float(v.x & 0xffff0000u) * __uint_as_float(gq.x & 0xffff0000u));
        w.y = cvtpk(__uint_as_float(v.y << 16) * __uint_as_float(gq.y << 16), __uint_as_float(v.y & 0xffff0000u) * __uint_as_float(gq.y & 0xffff0000u));
        w.z = cvtpk(__uint_as_float(v.z << 16) * __uint_as_float(gq.z << 16), __uint_as_float(v.z & 0xffff0000u) * __uint_as_float(gq.z & 0xffff0000u));
        w.w = cvtpk(__uint_as_float(v.w << 16) * __uint_as_float(gq.w << 16), __uint_as_float(v.w & 0xffff0000u) * __uint_as_float(gq.w & 0xffff0000u));
        *(u32x4*)(MIX + (orow0 + row) * DM + DPOOL + h * DV + ch * 8) = w; }
    __syncthreads();
#undef SLOAD
#undef SWRITE
#undef RESC
#undef QKT
#undef PV
}
}

namespace sattn {
__device__ __forceinline__ int crow(int r, int hi) { return (r & 3) + 8 * (r >> 2) + 4 * hi; }
__device__ __forceinline__ bf16x8 packf8(const f32x16& a, int base, float s) {
    u32x4 w; w.x = cvtpk(a[base + 0] * s, a[base + 1] * s); w.y = cvtpk(a[base + 2] * s, a[base + 3] * s); w.z = cvtpk(a[base + 4] * s, a[base + 5] * s); w.w = cvtpk(a[base + 6] * s, a[base + 7] * s);
    return __builtin_bit_cast(bf16x8, w);
}
constexpr int NKB = (SKV_S + 31) / 32;
constexpr int WROW = 528;
constexpr int PS_OFF = 69632;
constexpr int QF_OFF = 256 * WROW;
constexpr int CQ_STRIDE = 260;

__device__ __forceinline__ void unit(int b, int h, const bf16_t* __restrict__ CKVB, const bf16_t* __restrict__ KRB, const bf16_t* __restrict__ CKVN, const bf16_t* __restrict__ KRN, const bf16_t* __restrict__ CT,
                                     const bf16_t* __restrict__ Wukv_t, const bf16_t* __restrict__ QCAT, const bf16_t* __restrict__ SGM, bf16_t* MIX, LAS unsigned char* lds, LAS unsigned char* scr, int wv) {
    int lane = lane_id(); asm volatile("" : "+v"(lane));
    const int wid = wv, tid = (wv << 6) | lane, r32 = lane & 31, hh = lane >> 5;
    LAS unsigned char* qf = lds + QF_OFF;
    { const bf16_t* Wsrc = Wukv_t + (size_t)h * 256 * KVRANK;
#pragma unroll 4
      for (int i = 0; i < 8; ++i) { const int gi = tid + 512 * i, row = gi >> 5, c16 = gi & 31; const u32x4 v = *(const u32x4*)(Wsrc + (size_t)gi * 8);
          *(LAS u32x4*)(lds + row * WROW + (c16 << 4)) = v; } }
    { const bf16_t* qp = QCAT + (size_t)(MP + b * DSEQ + (r32 & 15)) * (NHEAD * DQK) + h * DQK;
      for (int f = wid; f < 12; f += 8) { u32x4 v = {0u, 0u, 0u, 0u};
          if (r32 < DSEQ) { if (f < 8) { const bf16_t* p = qp + (f >> 1) * 32 + (f & 1) * 16 + 4 * hh; const u32x2 lo = *(const u32x2*)p, hi2 = *(const u32x2*)(p + 8); v = (u32x4){lo.x, lo.y, hi2.x, hi2.y}; }
                            else v = *(const u32x4*)(qp + DNOPE + (f - 8) * 16 + 8 * hh); }
          *(LAS u32x4*)(qf + f * 1024 + lane * 16) = v; } }
    __syncthreads();
    float m_run = -1e30f, l_run = 0.f; f32x4 ol[16];
#pragma unroll
    for (int i = 0; i < 16; ++i) ol[i] = (f32x4){0.f, 0.f, 0.f, 0.f};
    LAS float* rks = (LAS float*)(lds + MISC_OFF + 256) + wid * 32;
    LAS unsigned char* ps = lds + PS_OFF + wid * 2048;
    LAS const unsigned char* wk = lds + r32 * WROW + hh * 16; LAS const unsigned char* qfl = qf + lane * 16;
    const int q16 = lane & 15, kq = lane >> 4;
    const bf16_t* ctl = CT + (size_t)lane * 8; const bf16_t* cbl = CKVB + (size_t)lane * 8;
    for (int kb = wid; kb < NKB; kb += 8) {
        int key = kb * 32 + r32; if (key > SKV_S - 1) key = SKV_S - 1;
        const bf16_t* kp = (key < PAST ? KRB + (size_t)(b * PAST + key) * DROPE : KRN + (size_t)(MP + b * DSEQ + key - PAST) * DROPE) + 8 * hh;
        f32x16 z = f32x16{}; float ssq = 0.f;
        bf16x8 rf[4];
#pragma unroll
        for (int s = 0; s < 4; ++s) rf[s] = *(const bf16x8*)(kp + 16 * s);
        {
        bf16x8 cf[16];
#pragma unroll
        for (int s = 0; s < 16; ++s) cf[s] = *(const bf16x8*)(cbl + (size_t)(kb * 16 + s) * 512);
#pragma unroll
        for (int dh = 0; dh < 2; ++dh) {
            f32x16 acc[2];
#pragma unroll
            for (int d2 = 0; d2 < 2; ++d2) { acc[d2] = f32x16{};
#pragma unroll
                for (int s = 0; s < 16; ++s) { const bf16x8 wa = *(LAS const bf16x8*)(wk + (dh * 2 + d2) * 32 * WROW + s * 32);
                    acc[d2] = __builtin_amdgcn_mfma_f32_32x32x16_bf16(wa, cf[s], acc[d2], 0, 0, 0); } }
            SBAR();
            bf16x8 kn[4];
#pragma unroll
            for (int d2 = 0; d2 < 2; ++d2) {
#pragma unroll
                for (int r = 0; r < 16; ++r) ssq += acc[d2][r] * acc[d2][r];
                kn[2 * d2] = packf8(acc[d2], 0, 1.f); kn[2 * d2 + 1] = packf8(acc[d2], 8, 1.f); }
            SBAR();
#pragma unroll
            for (int f = 0; f < 4; ++f) { const bf16x8 qb = *(LAS const bf16x8*)(qfl + (dh * 4 + f) * 1024); z = __builtin_amdgcn_mfma_f32_32x32x16_bf16(kn[f], qb, z, 0, 0, 0); }
            SBAR();
        }
        }
        bf16x8 af[16];
        { const bf16_t* ck = ctl + (size_t)kb * 16 * 512;
#pragma unroll
          for (int lb = 0; lb < 16; ++lb) af[lb] = *(const bf16x8*)(ck + lb * 512); }
        { auto rr = __builtin_amdgcn_permlane32_swap(__float_as_uint(ssq), __float_as_uint(ssq), false, false); ssq = __uint_as_float(rr[0]) + __uint_as_float(rr[1]); }
        rks[lane & 31] = 1.0f / sqrtf(ssq * (1.f / DNOPE) + EPS);
        asm volatile("s_waitcnt lgkmcnt(0)" ::: "memory");
#pragma unroll
        for (int g4 = 0; g4 < 4; ++g4) { const f32x4 rv = *(LAS const f32x4*)(rks + 8 * g4 + 4 * hh);
#pragma unroll
            for (int j = 0; j < 4; ++j) z[4 * g4 + j] *= rv[j]; }
#pragma unroll
        for (int s = 0; s < 4; ++s) { const bf16x8 qb = *(LAS const bf16x8*)(qfl + (8 + s) * 1024); z = __builtin_amdgcn_mfma_f32_32x32x16_bf16(rf[s], qb, z, 0, 0, 0); }
        SBAR();
        if (kb == NKB - 1) {
#pragma unroll
            for (int r = 0; r < 16; ++r) if (kb * 32 + crow(r, hh) >= SKV_S) z[r] = -1e30f;
        }
        float mx = z[0];
#pragma unroll
        for (int r = 1; r < 16; ++r) mx = fmaxf(mx, z[r]);
        { auto rr = __builtin_amdgcn_permlane32_swap(__float_as_uint(mx), __float_as_uint(mx), false, false); mx = fmaxf(__uint_as_float(rr[0]), __uint_as_float(rr[1])); }
        const float mn = fmaxf(m_run, mx), alpha = __builtin_amdgcn_exp2f(m_run - mn); m_run = mn;
        float psum = 0.f;
#pragma unroll
        for (int r = 0; r < 16; ++r) { z[r] = __builtin_amdgcn_exp2f(z[r] - mn); psum += z[r]; }
        l_run = l_run * alpha + psum;
        if (r32 < DSEQ) {
#pragma unroll
            for (int k4 = 0; k4 < 4; ++k4) { u32x2 w; w.x = cvtpk(z[4 * k4], z[4 * k4 + 1]); w.y = cvtpk(z[4 * k4 + 2], z[4 * k4 + 3]); *(LAS u32x2*)(ps + (r32 * 4 + k4) * 16 + 8 * hh) = w; }
            if (hh == 0) *(LAS float*)(ps + 1024 + 4 * r32) = alpha;
        }
        asm volatile("s_waitcnt lgkmcnt(0)" ::: "memory");
        const bf16x8 pf = *(LAS const bf16x8*)(ps + (q16 * 4 + kq) * 16); const float al16 = *(LAS const float*)(ps + 1024 + 4 * q16);
        SBAR();
#pragma unroll
        for (int lb = 0; lb < 16; ++lb) ol[lb] = __builtin_amdgcn_mfma_f32_16x16x32_bf16(af[lb], pf, ol[lb] * al16, 0, 0, 0);
        SBAR();
    }
    { auto rr = __builtin_amdgcn_permlane32_swap(__float_as_uint(l_run), __float_as_uint(l_run), false, false); l_run = __uint_as_float(rr[0]) + __uint_as_float(rr[1]); }
    __syncthreads();
    LAS float* comb = (LAS float*)lds; LAS float* ml = (LAS float*)(lds + QF_OFF);
    const int lane2 = lane_id(), tid2 = (wv << 6) | lane2;
    { const int qq = lane2 & 15, rq = lane2 >> 4;
#pragma unroll
      for (int lb = 0; lb < 16; ++lb) *(LAS f32x4*)(comb + (wid * 16 + qq) * CQ_STRIDE + lb * 16 + 4 * rq) = ol[lb];
      if (lane2 < DSEQ) { ml[wid * 16 + lane2] = m_run; ml[128 + wid * 16 + lane2] = l_run; } }
    __syncthreads();
    { const int q = tid2 >> 5, l0 = (tid2 & 31) * 8; float M = ml[q];
#pragma unroll
      for (int w = 1; w < 8; ++w) M = fmaxf(M, ml[w * 16 + q]);
      float L = 0.f; f32x4 a0 = {0.f, 0.f, 0.f, 0.f}, a1 = {0.f, 0.f, 0.f, 0.f};
#pragma unroll
      for (int w = 0; w < 8; ++w) { const float e = __builtin_amdgcn_exp2f(ml[w * 16 + q] - M); L += ml[128 + w * 16 + q] * e; const LAS float* cp = comb + (w * 16 + q) * CQ_STRIDE + l0;
          a0 += *(LAS const f32x4*)cp * e; a1 += *(LAS const f32x4*)(cp + 4) * e; }
      const float rl = 1.0f / L;
      __syncthreads();
      *(LAS f32x4*)(comb + q * CQ_STRIDE + l0) = a0 * rl; *(LAS f32x4*)(comb + q * CQ_STRIDE + l0 + 4) = a1 * rl; }
    __syncthreads();
    { const int q16b = lane2 & 15, kqb = lane2 >> 4; const bf16_t* wvp = Wukv_t + ((size_t)h * 256 + 128 + wid * 16 + q16b) * KVRANK + 8 * kqb;
      const LAS float* arow = comb + q16b * CQ_STRIDE + 8 * kqb;
      f32x4 od = {0.f, 0.f, 0.f, 0.f};
#pragma unroll
      for (int ks = 0; ks < 8; ++ks) { const f32x4 x0 = *(LAS const f32x4*)(arow + 32 * ks), x1 = *(LAS const f32x4*)(arow + 32 * ks + 4);
          const bf16x8 af2 = __builtin_bit_cast(bf16x8, pack8(x0, x1)); const bf16x8 bf2 = *(const bf16x8*)(wvp + 32 * ks);
          od = __builtin_amdgcn_mfma_f32_16x16x32_bf16(af2, bf2, od, 0, 0, 0); }
      const int dim = wid * 16 + q16b;
#pragma unroll
      for (int r = 0; r < 4; ++r) { const size_t row = (size_t)(MP + b * DSEQ + 4 * kqb + r);
          const float gt = bf2f(SGM[row * 1024 + h * DV + dim]); MIX[row * DM + DPOOL + h * DV + dim] = (bf16_t)(cvtpk(od[r] * gt, 0.f) & 0xffffu); } }
    __syncthreads();
}
}

__device__ __forceinline__ void bf8_to_f(const u32x4 v, float (&d)[8]) {
    d[0] = __uint_as_float(v.x << 16); d[1] = __uint_as_float(v.x & 0xffff0000u); d[2] = __uint_as_float(v.y << 16); d[3] = __uint_as_float(v.y & 0xffff0000u);
    d[4] = __uint_as_float(v.z << 16); d[5] = __uint_as_float(v.z & 0xffff0000u); d[6] = __uint_as_float(v.w << 16); d[7] = __uint_as_float(v.w & 0xffff0000u); }
template <int W>
__device__ __forceinline__ void pool_window_run(int m0, int col, const bf16_t* __restrict__ Z, const bf16_t* __restrict__ SGP, const float* __restrict__ pscale, bf16_t* MIX) {
    const bool smp = m0 >= MP; const int sb = (m0 - MP) >> 4;
    const int u0 = smp ? POOLH + ((m0 - MP) & 15) : (m0 & (SEQ - 1));
    const long base_new = smp ? (long)(MP + sb * DSEQ) - POOLH : (long)(m0 - u0);
    const long base_hist = (long)MT + sb * POOLH;
    u32x4 zr[W + 7], gq[8];
#pragma unroll
    for (int i = 0; i < W + 7; ++i) { const int u = u0 - (W - 1) + i; zr[i] = (u32x4){0u, 0u, 0u, 0u};
        if (u >= 0) zr[i] = *(const u32x4*)(Z + ((smp && u < POOLH) ? base_hist + u : base_new + u) * DPOOL + col); }
#pragma unroll
    for (int r = 0; r < 8; ++r) gq[r] = *(const u32x4*)(SGP + (size_t)(m0 + r) * DPOOL + col);
    const f32x4 p0 = *(const f32x4*)(pscale + col), p1 = *(const f32x4*)(pscale + col + 4);
    float S[8];
#pragma unroll
    for (int i = 0; i < 8; ++i) S[i] = 0.f;
#pragma unroll
    for (int k = 0; k < W - 1; ++k) { float t[8]; bf8_to_f(zr[k], t);
#pragma unroll
        for (int i = 0; i < 8; ++i) S[i] += t[i]; }
#pragma unroll
    for (int r = 0; r < 8; ++r) { const int u = u0 + r; float zc[8], gv[8], td[8], ov[8]; bf8_to_f(zr[W - 1 + r], zc); bf8_to_f(gq[r], gv); bf8_to_f(zr[r], td);
#pragma unroll
        for (int i = 0; i < 8; ++i) S[i] += zc[i];
        const int pos1 = smp ? SEQ : u + 1; const float rc = 1.0f / (float)(pos1 < W ? pos1 : W);
#pragma unroll
        for (int i = 0; i < 8; ++i) ov[i] = (S[i] * rc - zc[i]) * (i < 4 ? p0[i] : p1[i - 4]) * gv[i];
        u32x4 wv4; wv4.x = cvtpk(ov[0], ov[1]); wv4.y = cvtpk(ov[2], ov[3]); wv4.z = cvtpk(ov[4], ov[5]); wv4.w = cvtpk(ov[6], ov[7]);
        *(u32x4*)(MIX + (size_t)(m0 + r) * DM + col) = wv4;
#pragma unroll
        for (int i = 0; i < 8; ++i) S[i] -= td[i]; }
}
__device__ __forceinline__ void pool_window_block(int blk, const bf16_t* __restrict__ Z, const bf16_t* __restrict__ SGP, const float* __restrict__ pscale, bf16_t* MIX, int wv) {
    const int lane = lane_id(), g = wv & 3, m0 = blk * 32 + ((lane >> 5) + 2 * (wv >> 2)) * 8, col = g * 256 + (lane & 31) * 8;
    if (g == 0) pool_window_run<2>(m0, col, Z, SGP, pscale, MIX);
    else if (g == 1) pool_window_run<4>(m0, col, Z, SGP, pscale, MIX);
    else if (g == 2) pool_window_run<8>(m0, col, Z, SGP, pscale, MIX);
    else pool_window_run<16>(m0, col, Z, SGP, pscale, MIX);
}

#define XB_TMO      128
#define XB_XCNT(j)  (256  + 64 * (j))
#define XB_XSUB(j)  (1280 + 64 * (j))
#define XB_XGEN(j)  (2304 + 64 * (j))
#define XB_TOP      3328
#define XB_TOPGEN   3392
#define XCD_BAR_WORDS 3456
#define XB_SPIN_CAP (1u << 22)
__device__ __forceinline__ unsigned xb_ld(unsigned* p)              { return __hip_atomic_load(p, __ATOMIC_RELAXED, __HIP_MEMORY_SCOPE_AGENT); }
__device__ __forceinline__ unsigned xb_add(unsigned* p, unsigned v) { return __hip_atomic_fetch_add(p, v, __ATOMIC_RELAXED, __HIP_MEMORY_SCOPE_AGENT); }
__device__ __forceinline__ unsigned xb_xcc_id() { return (unsigned)__builtin_amdgcn_s_getreg((3 << 11) | 20) & 0xFu; }
#define XB_SPIN(cond, bar) do { unsigned _sp = 0; while (cond) { __builtin_amdgcn_s_sleep(1); \
    if ((++_sp & 255u) == 0u) { if (xb_ld(&(bar)[XB_TMO])) break; if (_sp > XB_SPIN_CAP) { atomicAdd(&(bar)[XB_TMO], 1u); break; } } } } while (0)
struct XcdBarrier { unsigned* bar; unsigned x; volatile LAS unsigned* st; };
__device__ __forceinline__ XcdBarrier xcd_barrier_post(unsigned* bar, volatile LAS unsigned* st, int wv) {
    XcdBarrier b; b.bar = bar; b.x = xb_xcc_id(); b.st = st;
    if (TIDX(wv) == 0) (void)xb_add(&bar[XB_XCNT(b.x)], 1u);
    return b;
}
__device__ __forceinline__ void xcd_barrier_complete(unsigned* bar, unsigned x, unsigned& nloc, unsigned& nx) {
    const unsigned G = gridDim.x * gridDim.y * gridDim.z;
    unsigned sum, cnt, mine, sp = 0u;
    for (;;) {
        sum = 0u; cnt = 0u; mine = 0u;
#pragma unroll
        for (unsigned j = 0; j < 16; ++j) { const unsigned c = xb_ld(&bar[XB_XCNT(j)]); sum += c; cnt += (c > 0u) ? 1u : 0u; mine = (j == x) ? c : mine; }
        if (sum == G) break;
        __builtin_amdgcn_s_sleep(1);
        if ((++sp & 255u) == 0u) { if (xb_ld(&bar[XB_TMO])) break; if (sp > XB_SPIN_CAP) { atomicAdd(&bar[XB_TMO], 1u); break; } }
    }
    nloc = mine > 0u ? mine : 1u; nx = cnt > 0u ? cnt : 1u;
}
__device__ __forceinline__ void xcd_barrier(const XcdBarrier& b, int wv) {
    asm volatile("s_waitcnt vmcnt(0)" ::: "memory");
    __syncthreads();
    if (TIDX(wv) == 0) {
        unsigned* bar = b.bar;
        __builtin_amdgcn_s_waitcnt(0);
        unsigned nloc = b.st[0], nx = b.st[1];
        if (nloc == 0u) { xcd_barrier_complete(bar, b.x, nloc, nx); b.st[0] = nloc; b.st[1] = nx; }
        const unsigned old = xb_add(&bar[XB_XSUB(b.x)], 1u);
        const unsigned gen = old / nloc;
        if (old + 1u == (gen + 1u) * nloc) {
            __builtin_amdgcn_fence(__ATOMIC_RELEASE, "agent");
            asm volatile("s_waitcnt vmcnt(0)" ::: "memory");
            const unsigned og = xb_add(&bar[XB_TOP], 1u);
            const unsigned tg = og / nx;
            if (og + 1u == (tg + 1u) * nx) xb_add(&bar[XB_TOPGEN], 1u);
            else XB_SPIN(xb_ld(&bar[XB_TOPGEN]) == tg, bar);
            __builtin_amdgcn_fence(__ATOMIC_ACQUIRE, "agent");
            xb_add(&bar[XB_XGEN(b.x)], 1u);
            asm volatile("s_waitcnt vmcnt(0)" ::: "memory");
        } else {
            XB_SPIN(xb_ld(&bar[XB_XGEN(b.x)]) == gen, bar);
            __builtin_amdgcn_fence(__ATOMIC_ACQUIRE, "agent");
            asm volatile("s_waitcnt vmcnt(0)" ::: "memory");
        }
    }
    __syncthreads();
}

constexpr int N_PHASES = 5;
__global__ void __launch_bounds__(512, 2) hymba_fwd(Args a) {
    extern __shared__ __attribute__((aligned(16))) unsigned char lds_raw[];
    LAS unsigned char* lds = (LAS unsigned char*)lds_raw;
    LAS unsigned char* scr = lds + SCR_OFF;
    volatile LAS unsigned* MISC = (volatile LAS unsigned*)(lds + MISC_OFF);
    const int wv = __builtin_amdgcn_readfirstlane((int)threadIdx.x >> 6);
    const int tid = TIDX(wv);
    const int G = gridDim.x; const int bx = blockIdx.x; const int vcu = (G % 8 == 0) ? (bx % 8) * (G / 8) + bx / 8 : bx;
    unsigned char* ws = a.ws; float* out = a.out;
    if (tid < 64) MISC[tid] = 0u;
    __syncthreads();
    XcdBarrier bar; bar.bar = (unsigned*)(ws + WS_CTL) + 1024 + a.li * XCD_BAR_WORDS; bar.x = 0; bar.st = nullptr;
    const bool one_launch = (a.ph_hi - a.ph_lo) > 1;
    if (one_launch) bar = xcd_barrier_post((unsigned*)(ws + WS_CTL) + 1024 + a.li * XCD_BAR_WORDS, MISC + 8, wv);
    const int lo = a.ph_lo, hi = a.ph_hi;
#ifndef PHASE_MASK
#define PHASE_MASK 63
#endif
#define IN(k) (((PHASE_MASK >> (k)) & 1) && lo <= (k) && (k) < hi)
#define SEAM(k) do { if (IN(k) && IN((k) + 1)) xcd_barrier(bar, wv); } while (0)
#define WSP(T, off) ((T*)(ws + (off)))
    if (IN(0)) { p0_prologue(a, lds, vcu, G, wv, 0); __syncthreads(); }
    SEAM(0);
    if (IN(1)) {
        pg8::SchedP1 S{(const char*)ws, bx, G};
        pg8::EpiInProj E{ws, out};
        pg8::gemm_phase(lds, scr, S, E, wv);
        __syncthreads(); p0_prologue(a, lds, vcu, G, wv, 1);
    }
    SEAM(1);
    if (IN(2)) {
        { pg8::SchedP2 S{(const char*)ws, bx, G};
          pg8::EpiP2 E{ws};
          pg8::gemm_phase(lds, scr, S, E, wv); }
        {
            const float* c1 = AIN(I_CCKV);
            unsigned* cctr = (unsigned*)(ws + WS_CTL) + 11520 + 64 * a.li; constexpr int NC = (DBATCH - NBT_A) * 256 / 8;
            for (;;) {
                if (TIDX(wv) == 0) MISC[22] = __hip_atomic_fetch_add(cctr, 1u, __ATOMIC_RELAXED, __HIP_MEMORY_SCOPE_AGENT);
                __syncthreads();
                const int ch = (int)MISC[22];
                __syncthreads();
                if (ch >= NC) break;
                const int item = ch * 8 + wv, bb = NBT_A + (item >> 8), kbk = (item & 255) >> 3, nb = item & 7;
                cache_item(c1 + (size_t)bb * PAST * KVRANK, ckvb_base(out, bb), ckvt_base(out, bb), 64 * kbk, 32 * nb, (LAS float*)(lds + wv * 16384), lane_id(), true, true);
            }
            { const bf16_t* CKVN = WSP(bf16_t, WS_CKVN);
              for (int i = vcu * 512 + TIDX(wv); i < DBATCH * 16 * 64; i += G * 512) { const int bb = i >> 10, sb = (i >> 6) & 15, ln = i & 63;
                  const bf16_t* nk = CKVN + (size_t)(MP + bb * DSEQ) * KVRANK; const size_t fo = ((size_t)(64 * 16 + sb) * 64 + ln) * 8;
                  { const int t = ln & 31; u32x4 w = {0u, 0u, 0u, 0u}; if (t < DSEQ) w = *(const u32x4*)(nk + (size_t)t * KVRANK + 16 * sb + 8 * (ln >> 5));
                    *(u32x4*)(ckvb_base(out, bb) + fo) = w; }
                  { const int kq = ln >> 4; u32x4 w = {0u, 0u, 0u, 0u};
                    if (kq < 2) { const bf16_t* p = nk + (size_t)(8 * kq) * KVRANK + 16 * sb + (ln & 15);
                        w.x = p[0] | ((unsigned)p[KVRANK] << 16); w.y = p[2 * KVRANK] | ((unsigned)p[3 * KVRANK] << 16); w.z = p[4 * KVRANK] | ((unsigned)p[5 * KVRANK] << 16); w.w = p[6 * KVRANK] | ((unsigned)p[7 * KVRANK] << 16); }
                    *(u32x4*)(ckvt_base(out, bb) + fo) = w; } } }
        }
    }
    SEAM(2);
    if (IN(3)) {
        const int qx = bx & 7; unsigned* ctr = (unsigned*)(ws + WS_CTL) + 8192 + 1024 * a.li + 64 * qx;
        for (;;) {
            if (TIDX(wv) == 0) MISC[20] = __hip_atomic_fetch_add(ctr, 1u, __ATOMIC_RELAXED, __HIP_MEMORY_SCOPE_AGENT);
            __syncthreads();
            const int it = (int)MISC[20];
            __syncthreads();
            if (it >= 98) break;
            if (it >= 64) { const int blk = (it - 64) * 8 + qx; pool_window_block(blk, WSP(bf16_t, WS_Z), WSP(bf16_t, WS_SGP), AIN(I_PSCALE), WSP(bf16_t, WS_MIX), wv); }
            else if (it >= 8 && it < 40) { const int j = it - 8, sb = qx * 4 + (j >> 3), sh = j & 7;
                sattn::unit(sb, sh, ckvb_base(out, sb), WSP(bf16_t, WS_KRB), WSP(bf16_t, WS_CKVN), WSP(bf16_t, WS_KRN), ckvt_base(out, sb), WSP(bf16_t, WS_WUKV), WSP(bf16_t, WS_QCAT), WSP(bf16_t, WS_SGM), WSP(bf16_t, WS_MIX), lds, scr, wv); }
            else { const int k = it < 8 ? it : it - 32, qb = 7 - (k >> 2), bh = qx * 4 + (k & 3);
                pattn::unit(bh >> 3, bh & 7, qb, WSP(bf16_t, WS_QCAT), WSP(bf16_t, WS_KCAT), WSP(bf16_t, WS_KRN), WSP(bf16_t, WS_V), WSP(bf16_t, WS_SGM), WSP(bf16_t, WS_MIX), lds, wv); }
        }
    }
    SEAM(3);
    if (IN(4)) {
        unsigned* pcnt = (unsigned*)(ws + WS_CTL) + 13312 + 2560 * a.li;
        pg8::EpiP45 E{ws, out};
        { pg8::SchedP45 S{(const char*)ws, pcnt, bx, G, 1}; pg8::gemm_phase(lds, scr, S, E, wv); }
        { pg8::SchedP45 S{(const char*)ws, pcnt, bx, G, 2}; pg8::gemm_phase(lds, scr, S, E, wv); }
    }
#undef IN
#undef SEAM
}

extern "C" void kernel_launch(void* const* d_in, const int* in_sizes, int n_in, void* d_out, int out_size, void* d_ws, size_t ws_size, hipStream_t stream) {
    static int grid = 0;
    if (grid == 0) {
        if (n_in != 24 || in_sizes[0] != MP * DM || out_size != 21164032 || ws_size < WS_END) {
            fprintf(stderr, "kernel_launch: shape mismatch: n_in %d in0 %d out %d ws %zu (need >= %zu)\n", n_in, n_in > 0 ? in_sizes[0] : -1, out_size, ws_size, (size_t)WS_END); grid = -1; return; }
        int dev = 0, cus = 0, per_cu = 0;
        if (hipGetDevice(&dev) != hipSuccess || hipDeviceGetAttribute(&cus, hipDeviceAttributeMultiprocessorCount, dev) != hipSuccess) { fprintf(stderr, "kernel_launch: device query failed\n"); grid = -1; return; }
        if (hipFuncSetAttribute((const void*)hymba_fwd, hipFuncAttributeMaxDynamicSharedMemorySize, LDS_BYTES) != hipSuccess) { fprintf(stderr, "kernel_launch: hipFuncSetAttribute failed\n"); grid = -1; return; }
        if (hipOccupancyMaxActiveBlocksPerMultiprocessor(&per_cu, (const void*)hymba_fwd, 512, LDS_BYTES) != hipSuccess || per_cu < 1)
            fprintf(stderr, "kernel_launch: note: occupancy query reports %d workgroups per CU\n", per_cu);
        (void)hipGetLastError();
        grid = cus;
    }
    if (grid < 0) return;
    if (hipMemsetAsync((char*)d_ws + WS_CTL, 0, CTL_ZERO_BYTES, stream) != hipSuccess) { fprintf(stderr, "kernel_launch: memset failed\n"); return; }
    Args a{};
    for (int i = 0; i < 24; ++i) a.in[i] = (const float*)d_in[i];
    a.out = (float*)d_out; a.ws = (unsigned char*)d_ws;
#if MK_N_LAUNCHES == 1
    a.ph_lo = 0; a.ph_hi = N_PHASES;
    hipLaunchKernelGGL(hymba_fwd, dim3(grid), dim3(512), LDS_BYTES, stream, a);
#else
    for (int p = 0; p < N_PHASES; ++p) { a.ph_lo = p; a.ph_hi = p + 1; hipLaunchKernelGGL(hymba_fwd, dim3(grid), dim3(512), LDS_BYTES, stream, a); }
#endif
    const hipError_t le = hipPeekAtLastError();
    if (le != hipSuccess) fprintf(stderr, "kernel_launch: launch failed: %s\n", hipGetErrorName(le));
}
```

```cpp
#include <hip/hip_runtime.h>
#include <hip/hip_bf16.h>
#include <cstdio>
#include <cstdint>

#ifndef DUP_PHASE
#define DUP_PHASE -1
#endif
#ifndef MK_N_LAUNCHES
#define MK_N_LAUNCHES 1
#endif

#define LAS __attribute__((address_space(3)))
#define GAS __attribute__((address_space(1)))
typedef unsigned short bf16_t;
typedef short bf16x8 __attribute__((ext_vector_type(8)));
typedef short s16x4 __attribute__((ext_vector_type(4)));
typedef float f32x4 __attribute__((ext_vector_type(4)));
typedef float f32x16 __attribute__((ext_vector_type(16)));
typedef unsigned u32x4 __attribute__((ext_vector_type(4)));
typedef unsigned u32x2 __attribute__((ext_vector_type(2)));
typedef float f32x2_t __attribute__((ext_vector_type(2)));
typedef __bf16 bf16x2_t __attribute__((ext_vector_type(2)));

constexpr int DM = 2048, NBATCH = 4, SEQ = 2048, DBATCH = 32, DSEQ = 16, PAST = 2048;
constexpr int MP = NBATCH * SEQ, MS = DBATCH * DSEQ, MT = MP + MS;
constexpr int DPOOL = 1024, NHEAD = 8, DNOPE = 128, DROPE = 64, DV = 128, QRANK = 512, KVRANK = 256, DPLE = 256;
constexpr int DQK = DNOPE + DROPE;
constexpr int DIN = 3904, DINP = 4096;
constexpr int SKV_S = PAST + DSEQ;
constexpr int POOLH = 15;
constexpr int MZ = 9216;
constexpr float EPS = 1e-6f;
constexpr float C2 = 0.07216878364870322f * 1.4426950408889634f;
constexpr size_t O_Y = 0, O_CKVP = 17825792, O_KRP = 19922944, O_POOLP = 20447232, O_CKVS = 20508672, O_KRS = 20639744, O_POOLS = 20672512;

constexpr size_t MiB = 1u << 20;
constexpr size_t WS_CTL = 0, CTL_ZERO_BYTES = 128 * 1024;
constexpr size_t WS_WIN = 1 * MiB;
constexpr size_t WS_WUQ = 17 * MiB;
constexpr size_t WS_WUKV = 18 * MiB + MiB / 2;
constexpr size_t WS_WPOOL = 19 * MiB + MiB / 2;
constexpr size_t WS_WOUT = 20 * MiB;
constexpr size_t WS_WGATE = 28 * MiB;
constexpr size_t WS_WPLE = 36 * MiB;
constexpr size_t WS_COS = 37 * MiB;
constexpr size_t WS_SIN = 37 * MiB + MiB / 2;
constexpr size_t WS_SSQCQ = 38 * MiB;
constexpr size_t WS_SSQH = 38 * MiB + MiB / 2;
constexpr size_t WS_CKVN = 39 * MiB;
constexpr size_t WS_KRN = 43 * MiB + MiB / 2;
constexpr size_t WS_PBF = 45 * MiB;
constexpr size_t WS_XN = 49 * MiB + MiB / 2;
constexpr size_t WS_KRB = 227 * MiB;
constexpr int CKVT_LD = 2080; constexpr size_t CKVT_B = (size_t)KVRANK * CKVT_LD * 2; constexpr int NBT_A = 8;
constexpr size_t OB_CKVB = 0, OB_CKVT = (size_t)DBATCH * CKVT_B;
static_assert(2 * (size_t)DBATCH * CKVT_B <= (size_t)MT * DM * 4, "cache copies fit in the y region of d_out");
constexpr int NB_EARLY = 0;
constexpr size_t WS_UBF = 83 * MiB + MiB / 2;
constexpr size_t WS_CQ = 101 * MiB + MiB / 2;
constexpr size_t WS_MIX = WS_UBF;
constexpr size_t WS_SGP = 117 * MiB + MiB / 2;
constexpr size_t WS_Z = 134 * MiB + MiB / 2;
constexpr size_t WS_PV = WS_SGP;
constexpr size_t WS_PVS = WS_XN;
constexpr size_t WS_SGM = 152 * MiB + MiB / 2;
constexpr size_t WS_QCAT = 169 * MiB + MiB / 2;
constexpr size_t WS_KCAT = 195 * MiB;
constexpr size_t WS_HBF = WS_QCAT;
constexpr size_t WS_V = 211 * MiB;
constexpr size_t WS_END = 256 * MiB;
static_assert(WS_MIX + (size_t)MT * DM * 2 <= WS_SGP && WS_PV + (size_t)MT * DM * 2 <= WS_SGM && WS_HBF + (size_t)MT * DM * 2 <= WS_V && WS_END <= 256 * MiB, "d_ws map");
static_assert(WS_KRB + (size_t)DBATCH * PAST * DROPE * 2 <= WS_END && WS_V + 16 * MiB <= WS_KRB, "d_ws map (cache copies)");

constexpr int RING_BYTES = 131072;
constexpr int SCR_OFF = RING_BYTES;
constexpr int SCR_BYTES = 16384;
constexpr int MISC_OFF = SCR_OFF + SCR_BYTES;
constexpr int LDS_BYTES = 151552;

#define LDS_WAIT() asm volatile("s_waitcnt lgkmcnt(0)" ::: "memory")
#define VM_WAIT() asm volatile("s_waitcnt vmcnt(0)" ::: "memory")
#define WG_BAR() do { asm volatile("s_waitcnt lgkmcnt(0)" ::: "memory"); __builtin_amdgcn_s_barrier(); asm volatile("" ::: "memory"); } while (0)
#define SBAR() __builtin_amdgcn_sched_barrier(0)
__device__ __forceinline__ unsigned cvtpk(float lo, float hi) { f32x2_t v = {lo, hi}; bf16x2_t b = __builtin_convertvector(v, bf16x2_t); return __builtin_bit_cast(unsigned, b); }
__device__ __forceinline__ u32x4 pack8(f32x4 a, f32x4 b) { u32x4 w; w.x = cvtpk(a[0], a[1]); w.y = cvtpk(a[2], a[3]); w.z = cvtpk(b[0], b[1]); w.w = cvtpk(b[2], b[3]); return w; }
typedef __amdgpu_buffer_rsrc_t rsrc_t;
__device__ __forceinline__ rsrc_t make_rsrc(const void* p, unsigned bytes) { return __builtin_amdgcn_make_buffer_rsrc(const_cast<void*>(p), 0, bytes, 0x00020000); }
__device__ __forceinline__ void st16_wt(rsrc_t r, unsigned byteoff, u32x4 v) { __builtin_amdgcn_raw_buffer_store_b128(v, r, byteoff, 0, 16); }
__device__ __forceinline__ void st16_wt(rsrc_t r, unsigned byteoff, f32x4 v) { __builtin_amdgcn_raw_buffer_store_b128(__builtin_bit_cast(u32x4, v), r, byteoff, 0, 16); }
__device__ __forceinline__ float bf2f(unsigned short h) { return __uint_as_float((unsigned)h << 16); }
__device__ __forceinline__ float silu_f(float v) { return v / (1.f + __expf(-v)); }
__device__ __forceinline__ float sigmoid_f(float v) { return 1.f / (1.f + __expf(-v)); }
__device__ __forceinline__ float wave_sum(float v) {
#pragma unroll
    for (int o = 1; o < 64; o <<= 1) v += __shfl_xor(v, o);
    return v;
}
__device__ __forceinline__ int lane_id() { int l; asm volatile("v_mbcnt_lo_u32_b32 %0, -1, 0\n\tv_mbcnt_hi_u32_b32 %0, -1, %0" : "=v"(l)); return l; }
#define TIDX(wv) (((wv) << 6) | lane_id())
__device__ __forceinline__ int row_pos(int row) { return row < MP ? (row & (SEQ - 1)) : PAST + ((row - MP) & (DSEQ - 1)); }

#define AS4 __attribute__((address_space(4)))
__device__ __forceinline__ const float* arg_in(int k) {
    const char AS4* p = (const char AS4*)__builtin_amdgcn_kernarg_segment_ptr(); int off = k * 8; asm volatile("" : "+s"(off));
    return *(const float* const AS4*)(p + off);
}
#define AIN(k) arg_in(k)

namespace pg8 {
constexpr int BM = 256, BK = 64, HALF = 128, HTB = HALF * BK * 2, STAGE_BYTES = 8 * HTB, NXCD = 8, WGM = 8;
__host__ __device__ __forceinline__ int lds_byte(int r, int c) { const int st = (r >> 4) * 2 + (c >> 5), rr = r & 15, cc = c & 31, ob = rr * 64 + cc * 2; return st * 1024 + (ob ^ (((ob >> 9) & 1) << 5)); }
__host__ __device__ __forceinline__ void stage_rc(int b, int& R, int& C) { const int st = b / 1024, sb = b % 1024, swz = sb ^ (((sb >> 9) & 1) << 5); R = (st >> 1) * 16 + swz / 64; C = (st & 1) * 32 + (swz % 64) / 2; }
__host__ __device__ __forceinline__ int perm32(int rho) { const int n = rho >> 4, i = rho & 15; return 8 * (i >> 2) + 4 * n + (i & 3); }

struct Unit { const char* A; const char* B; int lda, ldb, nt, type, row0, pn, half, slice, uid; };
__device__ __forceinline__ void grid_map(int L, int nM, int nN, int& pm, int& pn) {
    const int nwg = nM * nN; int wgid = L; { const int q = nwg / NXCD, r = nwg % NXCD, xcd = wgid % NXCD, off = wgid / NXCD; wgid = (xcd < r ? xcd * (q + 1) : r * (q + 1) + (xcd - r) * q) + off; }
    const int nig = WGM * nN, gid = wgid / nig, fm = gid * WGM, gsz = (nM - fm) < WGM ? (nM - fm) : WGM;
    pm = fm + ((wgid % nig) % gsz); pn = (wgid % nig) / gsz;
}

template <class Sched, class Epi>
__device__ __forceinline__ void gemm_phase(LAS unsigned char* lds, LAS unsigned char* scr, const Sched& S, const Epi& E, int wv) {
    const int wid = wv, lane = lane_id(), tid = (wv << 6) | lane, wr = wid >> 2, wc = wid & 3, fr = lane & 15, fq = lane >> 4;
    Unit cur, nxt; int ui = 0;
    if (!S.get(0, cur)) return;
    int RA[2], RB[2], CC[2];
#pragma unroll
    for (int i = 0; i < 2; ++i) { int R, C; stage_rc(tid * 16 + i * 8192, R, C); RA[i] = R * 2; RB[i] = ((R & ~31) + perm32(R & 31)) * 2; CC[i] = C * 2; }
    unsigned voffA[2], voffB[2], nvA[2], nvB[2];
#pragma unroll
    for (int i = 0; i < 2; ++i) { voffA[i] = (unsigned)(RA[i] * cur.lda + CC[i]); voffB[i] = (unsigned)(RB[i] * cur.ldb + CC[i]); }
    const size_t kstep = (size_t)(BK * 2);
    unsigned hA = cur.half ? 0u : (unsigned)(HALF * cur.lda * 2), hB = (unsigned)(HALF * cur.ldb * 2);
    const unsigned ldsw = (unsigned)wid * 1024u;
    const int aoff = lds_byte(wr * 64 + fr, fq * 8), boff = lds_byte(wc * 32 + fr, fq * 8);
#define PG8_SA(b, h) (((b) * 2 + (h)) * HTB)
#define PG8_SB(b, h) ((4 + (b) * 2 + (h)) * HTB)
#define PG8_STAGE(bufoff, gbase, voff) do { _Pragma("unroll") for (int _i = 0; _i < 2; ++_i) \
        __builtin_amdgcn_global_load_lds((const unsigned*)((const char*)(gbase) + (voff)[_i]), (LAS unsigned*)(lds + (bufoff) + ldsw + _i * 8192), 16, 0, 0); } while (0)
#define PG8_LDA(dst, b, h) do { _Pragma("unroll") for (int m = 0; m < 4; ++m) _Pragma("unroll") for (int k = 0; k < 2; ++k) dst[m][k] = *(const LAS bf16x8*)(lds + PG8_SA(b, h) + aoff + m * 2048 + k * 1024); } while (0)
#define PG8_LDB(dst, b, h) do { _Pragma("unroll") for (int n = 0; n < 2; ++n) _Pragma("unroll") for (int k = 0; k < 2; ++k) dst[n][k] = *(const LAS bf16x8*)(lds + PG8_SB(b, h) + boff + n * 2048 + k * 1024); } while (0)
#define PG8_MMA(ai, bj, At, Bt) do { __builtin_amdgcn_s_setprio(1); _Pragma("unroll") for (int m = 0; m < 4; ++m) _Pragma("unroll") for (int n = 0; n < 2; ++n) _Pragma("unroll") for (int k = 0; k < 2; ++k) \
        acc[ai][bj][m][n] = __builtin_amdgcn_mfma_f32_16x16x32_bf16(Bt[n][k], At[m][k], acc[ai][bj][m][n], 0, 0, 0); __builtin_amdgcn_s_setprio(0); } while (0)
#define PG8_WAIT_V(n) asm volatile("s_waitcnt vmcnt(" #n ")" ::: "memory")
#define PG8_WAIT_L(n) asm volatile("s_waitcnt lgkmcnt(" #n ")" ::: "memory")
#define PG8_BAR __builtin_amdgcn_s_barrier()
#define PG8_SCHED __builtin_amdgcn_sched_barrier(0)
    f32x4 acc[2][2][4][2];
    { int fr_e = fr, fq_e = fq; asm volatile("" : "+v"(fr_e), "+v"(fq_e)); E.init(acc, cur, wr, wc, fr_e, fq_e); }
    bf16x8 At[4][2], B0[2][2], B1[2][2];
    const char* cA = cur.A; const char* cB = cur.B;
    int rot = ((S.c & 7) * cur.nt) >> 3, nrot = 0;
    S.a_ready(cur, wid);
    { const size_t k0 = (size_t)rot * kstep, k1 = (size_t)((rot + 1) & (cur.nt - 1)) * kstep;
    PG8_STAGE(PG8_SB(0, 0), cB + k0, voffB); PG8_STAGE(PG8_SB(0, 1), cB + hB + k0, voffB); PG8_STAGE(PG8_SA(0, 0), cA + k0, voffA); PG8_STAGE(PG8_SA(0, 1), cA + hA + k0, voffA);
    if (wr == 1) PG8_BAR;
    PG8_WAIT_V(2); PG8_BAR;
    PG8_STAGE(PG8_SB(1, 0), cB + k1, voffB); PG8_STAGE(PG8_SA(1, 0), cA + k1, voffA); PG8_STAGE(PG8_SB(1, 1), cB + hB + k1, voffB); }
    PG8_WAIT_V(6); PG8_BAR;
    for (;;) {
        const bool has_next = S.get(ui + 1, nxt);
        if (!has_next) nxt = cur;
#pragma unroll
        for (int i = 0; i < 2; ++i) { nvA[i] = (unsigned)(RA[i] * nxt.lda + CC[i]); nvB[i] = (unsigned)(RB[i] * nxt.ldb + CC[i]); }
        const unsigned nhA = nxt.half ? 0u : (unsigned)(HALF * nxt.lda * 2), nhB = (unsigned)(HALF * nxt.ldb * 2);
        const char* nA = nxt.A; const char* nB = nxt.B; nrot = has_next ? (((S.c & 7) * nxt.nt) >> 3) : (rot + cur.nt - 2); const int nmask = nxt.nt - 1;
        int nt = __builtin_amdgcn_readfirstlane(cur.nt); asm volatile("" : "+s"(nt));
        const bool full = !cur.half;
        for (int t = 0; t < nt; t += 2) {
            const bool last = (t == nt - 2);
            if (last && has_next) S.a_ready(nxt, wid);
            const size_t o1 = (size_t)((t + 1 + rot) & (nt - 1)) * kstep;
            const size_t o2 = (size_t)(last ? (nrot & nmask) : ((t + 2 + rot) & (nt - 1))) * kstep, o3 = (size_t)(last ? ((nrot + 1) & nmask) : ((t + 3 + rot) & (nt - 1))) * kstep;
            const char* a1 = cA + o1;
            const char* a2 = (last ? nA : cA) + o2; const char* b2 = (last ? nB : cB) + o2;
            const char* a3 = (last ? nA : cA) + o3; const char* b3 = (last ? nB : cB) + o3;
            const unsigned hA2 = last ? nhA : hA, hB2 = last ? nhB : hB;
            unsigned vA2[2], vB2[2];
#pragma unroll
            for (int i = 0; i < 2; ++i) { vA2[i] = last ? nvA[i] : voffA[i]; vB2[i] = last ? nvB[i] : voffB[i]; }
            PG8_LDB(B0, 0, 0); PG8_LDB(B1, 0, 1); PG8_SCHED; PG8_LDA(At, 0, 0); PG8_STAGE(PG8_SA(1, 1), a1 + hA, voffA);
            PG8_WAIT_V(8); PG8_WAIT_L(0); PG8_BAR; PG8_MMA(0, 0, At, B0); PG8_MMA(0, 1, At, B1); PG8_BAR; PG8_SCHED;
            if (full) PG8_LDA(At, 0, 1);
            PG8_STAGE(PG8_SB(0, 0), b2, vB2); PG8_STAGE(PG8_SB(0, 1), b2 + hB2, vB2); PG8_STAGE(PG8_SA(0, 0), a2, vA2);
            PG8_WAIT_V(8); PG8_WAIT_L(0); PG8_BAR; if (full) { PG8_MMA(1, 0, At, B0); PG8_MMA(1, 1, At, B1); } PG8_BAR; PG8_SCHED;
            PG8_LDB(B0, 1, 0); PG8_LDB(B1, 1, 1); PG8_SCHED; PG8_LDA(At, 1, 0); PG8_STAGE(PG8_SA(0, 1), a2 + hA2, vA2);
            PG8_WAIT_V(8); PG8_WAIT_L(0); PG8_BAR; PG8_MMA(0, 0, At, B0); PG8_MMA(0, 1, At, B1); PG8_BAR; PG8_SCHED;
            if (full) PG8_LDA(At, 1, 1);
            PG8_STAGE(PG8_SB(1, 0), b3, vB2); PG8_STAGE(PG8_SB(1, 1), b3 + hB2, vB2); PG8_STAGE(PG8_SA(1, 0), a3, vA2);
            PG8_WAIT_V(8); PG8_WAIT_L(0); PG8_BAR; if (full) { PG8_MMA(1, 0, At, B0); PG8_MMA(1, 1, At, B1); } PG8_BAR; PG8_SCHED;
        }
        if (wr == 0) PG8_BAR;
        if constexpr (Sched::SPLITK) {
            if (cur.slice >= 0) {
                constexpr int NSLICE = Sched::NSLICE; constexpr unsigned SLABB = HALF * BM * 4;
                float* sl = S.slab(cur); const rsrc_t rs = make_rsrc(sl, NSLICE * SLABB); const unsigned lo = (unsigned)(wid * 16 * 64 + lane) * 16u;
                const int q = cur.slice;
#pragma unroll
                for (int m = 0; m < 4; ++m) if ((m * NSLICE) / 4 != q)
#pragma unroll
                    for (int bj = 0; bj < 2; ++bj)
#pragma unroll
                        for (int n = 0; n < 2; ++n) st16_wt(rs, (unsigned)cur.slice * SLABB + lo + (unsigned)(bj * 8 + m * 2 + n) * 1024u, acc[0][bj][m][n]);
                asm volatile("s_waitcnt vmcnt(0)" ::: "memory");
                PG8_BAR; asm volatile("" ::: "memory");
                if (wid == 0) {
                    unsigned* tk = S.ticket(cur); unsigned sp = 0;
                    if (lane == 0) __hip_atomic_fetch_add(tk, 1u, __ATOMIC_RELAXED, __HIP_MEMORY_SCOPE_AGENT);
                    while ((unsigned)__builtin_amdgcn_readfirstlane(__hip_atomic_load(tk, __ATOMIC_RELAXED, __HIP_MEMORY_SCOPE_AGENT)) < (unsigned)NSLICE) { __builtin_amdgcn_s_sleep(2); if (++sp > (1u << 22)) break; }
                    __builtin_amdgcn_fence(__ATOMIC_ACQUIRE, "agent");
                    asm volatile("s_waitcnt vmcnt(0)" ::: "memory");
                }
                asm volatile("" ::: "memory"); PG8_BAR; asm volatile("" ::: "memory");
#pragma unroll
                for (int m = 0; m < 4; ++m) if ((m * NSLICE) / 4 == q) {
#pragma unroll
                    for (int sp = 0; sp < NSLICE; ++sp) if (sp != q) { const char* ob = (const char*)sl + (size_t)sp * SLABB + lo;
#pragma unroll
                        for (int bj = 0; bj < 2; ++bj)
#pragma unroll
                            for (int n = 0; n < 2; ++n) acc[0][bj][m][n] += *(const f32x4*)(ob + (bj * 8 + m * 2 + n) * 1024); } }
            }
        }
        { int fr_e = fr, fq_e = fq; asm volatile("" : "+v"(fr_e), "+v"(fq_e));
          E(acc, cur, wr, wc, fr_e, fq_e, scr); }
        S.done(cur, wid);
        if (!has_next) break;
        { int fr_e = fr, fq_e = fq; asm volatile("" : "+v"(fr_e), "+v"(fq_e)); E.init(acc, nxt, wr, wc, fr_e, fq_e); }
        cur = nxt; cA = nA; cB = nB; hA = nhA; hB = nhB; rot = nrot; ++ui;
#pragma unroll
        for (int i = 0; i < 2; ++i) { voffA[i] = nvA[i]; voffB[i] = nvB[i]; }
        if (wr == 1) PG8_BAR;
    }
    PG8_WAIT_V(0);
    PG8_BAR;
#undef PG8_SA
#undef PG8_SB
#undef PG8_STAGE
#undef PG8_LDA
#undef PG8_LDB
#undef PG8_MMA
#undef PG8_WAIT_V
#undef PG8_WAIT_L
#undef PG8_BAR
#undef PG8_SCHED
}

typedef f32x4 Acc[2][2][4][2];
__device__ __forceinline__ void acc_zero(Acc& acc) {
#pragma unroll
    for (int a = 0; a < 2; ++a)
#pragma unroll
        for (int b = 0; b < 2; ++b)
#pragma unroll
            for (int m = 0; m < 4; ++m)
#pragma unroll
                for (int n = 0; n < 2; ++n) acc[a][b][m][n] = (f32x4){0.f, 0.f, 0.f, 0.f};
}
#define EPI_INIT_ZERO __device__ __forceinline__ void init(Acc& acc, const Unit&, int, int, int, int) const { acc_zero(acc); }
template <int NG>
__device__ __forceinline__ void xwave_rowsum(float (&p)[NG][2][4], LAS unsigned char* scr, int wr, int wc, int fr, int fq) {
    LAS float* red = (LAS float*)scr;
    if (fq == 0) {
#pragma unroll
        for (int gq = 0; gq < NG; ++gq)
#pragma unroll
            for (int ai = 0; ai < 2; ++ai)
#pragma unroll
                for (int m = 0; m < 4; ++m) red[gq * 1024 + (ai * HALF + wr * 64 + m * 16 + fr) * 4 + wc] = p[gq][ai][m];
    }
    WG_BAR();
#pragma unroll
    for (int gq = 0; gq < NG; ++gq)
#pragma unroll
        for (int ai = 0; ai < 2; ++ai)
#pragma unroll
            for (int m = 0; m < 4; ++m) { const f32x4 v = *(const LAS f32x4*)(red + gq * 1024 + (ai * HALF + wr * 64 + m * 16 + fr) * 4); p[gq][ai][m] = (v[0] + v[1]) + (v[2] + v[3]); }
    WG_BAR();
}
__device__ __forceinline__ float sq4(f32x4 v) { return (v[0] * v[0] + v[1] * v[1]) + (v[2] * v[2] + v[3] * v[3]); }
__device__ __forceinline__ float fq_sum(float s) { s += __shfl_xor(s, 16); s += __shfl_xor(s, 32); return s; }

struct EpiBf16 {
    EPI_INIT_ZERO
    bf16_t* O; int ldc; int wt;
    __device__ __forceinline__ void operator()(Acc& acc, const Unit& u, int wr, int wc, int fr, int fq, LAS unsigned char*) const {
        const int row0 = u.row0 + wr * 64 + fr, col0 = u.pn * BM + wc * 32 + 8 * fq;
        if (wt) { const rsrc_t rO = make_rsrc(O, (unsigned)MT * DM * 2);
#pragma unroll
            for (int ai = 0; ai < 2; ++ai) if (ai == 0 || !u.half)
#pragma unroll
                for (int m = 0; m < 4; ++m) { const unsigned off = (unsigned)((row0 + ai * HALF + m * 16) * ldc + col0) * 2u;
#pragma unroll
                    for (int bj = 0; bj < 2; ++bj) st16_wt(rO, off + bj * HALF * 2, pack8(acc[ai][bj][m][0], acc[ai][bj][m][1])); }
            return; }
#pragma unroll
        for (int ai = 0; ai < 2; ++ai) if (ai == 0 || !u.half)
#pragma unroll
            for (int m = 0; m < 4; ++m) { bf16_t* rp = O + (size_t)(row0 + ai * HALF + m * 16) * ldc + col0;
#pragma unroll
                for (int bj = 0; bj < 2; ++bj) *(u32x4*)(rp + bj * HALF) = pack8(acc[ai][bj][m][0], acc[ai][bj][m][1]); }
    }
};

struct EpiInProj {
    EPI_INIT_ZERO
    unsigned char* ws; float* out;
    __device__ __forceinline__ void operator()(Acc& acc, const Unit& u, int wr, int wc, int fr, int fq, LAS unsigned char* scr) const {
        const float* kvg = arg_in(11); const float* krg = arg_in(16);
        bf16_t* UBF = (bf16_t*)(ws + WS_UBF); bf16_t* SGP = (bf16_t*)(ws + WS_SGP); bf16_t* CQ = (bf16_t*)(ws + WS_CQ); bf16_t* CKVN = (bf16_t*)(ws + WS_CKVN); bf16_t* SGM = (bf16_t*)(ws + WS_SGM); bf16_t* KRN = (bf16_t*)(ws + WS_KRN);
        float* SSQCQ = (float*)(ws + WS_SSQCQ); const float* COS = (const float*)(ws + WS_COS); const float* SIN = (const float*)(ws + WS_SIN);
        const int row0 = u.row0 + wr * 64 + fr, cl = wc * 32 + 8 * fq, pn = u.pn;
        const int mmask = u.slice >= 0 ? (3 << (2 * u.slice)) : 15;
        if (pn < 4) {
            const bool tail = (((u.row0 >> 8) & 7) == 7) || (u.row0 >= MP);
#pragma unroll
            for (int ai = 0; ai < 2; ++ai) if (ai == 0 || !u.half)
#pragma unroll
                for (int m = 0; m < 4; ++m) { if (!((mmask >> m) & 1)) continue; const int row = row0 + ai * HALF + m * 16; bf16_t* rp = UBF + (size_t)row * DPOOL + pn * BM + cl;
#pragma unroll
                    for (int bj = 0; bj < 2; ++bj) *(u32x4*)(rp + bj * HALF) = pack8(acc[ai][bj][m][0], acc[ai][bj][m][1]);
                    if (tail) { float* dst = nullptr;
                        if (row < MP) { const int t = row & (SEQ - 1), b = row >> 11; if (t >= SEQ - POOLH) dst = out + O_POOLP + (size_t)(b * POOLH + t - (SEQ - POOLH)) * DPOOL; }
                        else { const int s = row - MP, b = s >> 4, t = s & 15; if (t >= 1) dst = out + O_POOLS + (size_t)(b * POOLH + t - 1) * DPOOL; }
                        if (dst) { dst += pn * BM + cl;
#pragma unroll
                            for (int bj = 0; bj < 2; ++bj) { *(f32x4*)(dst + bj * HALF) = acc[ai][bj][m][0]; *(f32x4*)(dst + bj * HALF + 4) = acc[ai][bj][m][1]; } } } }
        } else if (pn < 8 || (pn >= 11 && pn < 15)) {
            bf16_t* G0 = pn < 8 ? SGP + (pn - 4) * BM : SGM + (pn - 11) * BM;
#pragma unroll
            for (int ai = 0; ai < 2; ++ai) if (ai == 0 || !u.half)
#pragma unroll
                for (int m = 0; m < 4; ++m) { if (!((mmask >> m) & 1)) continue; bf16_t* rp = G0 + (size_t)(row0 + ai * HALF + m * 16) * 1024 + cl;
#pragma unroll
                    for (int bj = 0; bj < 2; ++bj) { f32x4 a = acc[ai][bj][m][0], b = acc[ai][bj][m][1];
#pragma unroll
                        for (int j = 0; j < 4; ++j) { a[j] = silu_f(a[j]); b[j] = silu_f(b[j]); }
                        *(u32x4*)(rp + bj * HALF) = pack8(a, b); } }
        } else if (pn < 10) {
            float p[1][2][4];
#pragma unroll
            for (int ai = 0; ai < 2; ++ai)
#pragma unroll
                for (int m = 0; m < 4; ++m) { p[0][ai][m] = 0.f; if (ai == 1 && u.half) continue; const int row = row0 + ai * HALF + m * 16; bf16_t* rp = CQ + (size_t)row * QRANK + (pn - 8) * BM + cl; float s = 0.f;
#pragma unroll
                    for (int bj = 0; bj < 2; ++bj) { if ((mmask >> m) & 1) *(u32x4*)(rp + bj * HALF) = pack8(acc[ai][bj][m][0], acc[ai][bj][m][1]); s += sq4(acc[ai][bj][m][0]) + sq4(acc[ai][bj][m][1]); }
                    p[0][ai][m] = fq_sum(s); }
            xwave_rowsum<1>(p, scr, wr, wc, fr, fq);
            if (wc == 0 && fq == 0) {
#pragma unroll
                for (int ai = 0; ai < 2; ++ai) if (ai == 0 || !u.half)
#pragma unroll
                    for (int m = 0; m < 4; ++m) if ((mmask >> m) & 1) SSQCQ[(size_t)(row0 + ai * HALF + m * 16) * 2 + (pn - 8)] = p[0][ai][m]; }
        } else if (pn == 10) {
            float p[1][2][4];
#pragma unroll
            for (int ai = 0; ai < 2; ++ai) if (ai == 0 || !u.half)
#pragma unroll
                for (int m = 0; m < 4; ++m) { float s = 0.f;
#pragma unroll
                    for (int bj = 0; bj < 2; ++bj) s += sq4(acc[ai][bj][m][0]) + sq4(acc[ai][bj][m][1]);
                    p[0][ai][m] = fq_sum(s); }
            xwave_rowsum<1>(p, scr, wr, wc, fr, fq);
            f32x4 gv[2][2];
#pragma unroll
            for (int bj = 0; bj < 2; ++bj) { gv[bj][0] = *(const f32x4*)(kvg + bj * HALF + cl); gv[bj][1] = *(const f32x4*)(kvg + bj * HALF + cl + 4); }
#pragma unroll
            for (int ai = 0; ai < 2; ++ai) if (ai == 0 || !u.half)
#pragma unroll
                for (int m = 0; m < 4; ++m) { if (!((mmask >> m) & 1)) continue; const int row = row0 + ai * HALF + m * 16; const float r = 1.0f / sqrtf(p[0][ai][m] * (1.f / KVRANK) + EPS);
                    float* dst = (row < MP ? out + O_CKVP + (size_t)row * KVRANK : out + O_CKVS + (size_t)(row - MP) * KVRANK) + cl; bf16_t* rp = CKVN + (size_t)row * KVRANK + cl;
#pragma unroll
                    for (int bj = 0; bj < 2; ++bj) { const f32x4 a = acc[ai][bj][m][0] * r * gv[bj][0], b = acc[ai][bj][m][1] * r * gv[bj][1];
                        *(f32x4*)(dst + bj * HALF) = a; *(f32x4*)(dst + bj * HALF + 4) = b; *(u32x4*)(rp + bj * HALF) = pack8(a, b); } }
        } else {
            if (wc == 0) {
                f32x4 g1[2], g2[2];
#pragma unroll
                for (int n = 0; n < 2; ++n) { g1[n] = *(const f32x4*)(krg + 8 * fq + 4 * n); g2[n] = *(const f32x4*)(krg + 32 + 8 * fq + 4 * n); }
#pragma unroll
                for (int ai = 0; ai < 2; ++ai) if (ai == 0 || !u.half)
#pragma unroll
                    for (int m = 0; m < 4; ++m) { if (!((mmask >> m) & 1)) continue; const int row = row0 + ai * HALF + m * 16; float s = 0.f;
#pragma unroll
                        for (int n = 0; n < 2; ++n) s += sq4(acc[ai][0][m][n]) + sq4(acc[ai][1][m][n]);
                        s = fq_sum(s); const float r = 1.0f / sqrtf(s * (1.f / DROPE) + EPS); const int pos = row_pos(row);
                        float* dst = (row < MP ? out + O_KRP + (size_t)row * DROPE : out + O_KRS + (size_t)(row - MP) * DROPE) + 8 * fq; bf16_t* rp = KRN + (size_t)row * DROPE + 8 * fq;
                        f32x4 o1[2], o2[2];
#pragma unroll
                        for (int n = 0; n < 2; ++n) { const f32x4 cs = *(const f32x4*)(COS + pos * 32 + 8 * fq + 4 * n), sn = *(const f32x4*)(SIN + pos * 32 + 8 * fq + 4 * n);
                            const f32x4 y1 = acc[ai][0][m][n] * r * g1[n], y2 = acc[ai][1][m][n] * r * g2[n]; o1[n] = y1 * cs - y2 * sn; o2[n] = y2 * cs + y1 * sn; }
                        *(f32x4*)(dst) = o1[0]; *(f32x4*)(dst + 4) = o1[1]; *(f32x4*)(dst + 32) = o2[0]; *(f32x4*)(dst + 36) = o2[1];
                        *(u32x4*)(rp) = pack8(o1[0], o1[1]); *(u32x4*)(rp + 32) = pack8(o2[0], o2[1]); }
            }
        }
    }
};

struct EpiQ {
    EPI_INIT_ZERO
    unsigned char* ws; const float* gqn; const float* gkn; const float* gqr;
    __device__ __forceinline__ void operator()(Acc& acc, const Unit& u, int wr, int wc, int fr, int fq, LAS unsigned char* scr) const {
        bf16_t* QCAT = (bf16_t*)(ws + WS_QCAT); const float* SSQCQ = (const float*)(ws + WS_SSQCQ); const float* COS = (const float*)(ws + WS_COS); const float* SIN = (const float*)(ws + WS_SIN);
        const int row0 = u.row0 + wr * 64 + fr, pn = u.pn;
        { f32x2_t sq2[2][4];
#pragma unroll
          for (int ai = 0; ai < 2; ++ai) if (ai == 0 || !u.half)
#pragma unroll
              for (int m = 0; m < 4; ++m) sq2[ai][m] = *(const f32x2_t*)(SSQCQ + (size_t)(row0 + ai * HALF + m * 16) * 2);
#pragma unroll
          for (int ai = 0; ai < 2; ++ai) if (ai == 0 || !u.half)
#pragma unroll
              for (int m = 0; m < 4; ++m) { const float rq = 1.0f / sqrtf((sq2[ai][m][0] + sq2[ai][m][1]) * (1.f / QRANK) + EPS);
#pragma unroll
                for (int bj = 0; bj < 2; ++bj)
#pragma unroll
                    for (int n = 0; n < 2; ++n) acc[ai][bj][m][n] *= rq; }
          asm volatile("" ::: "memory"); }
        if (pn < 4) {
            const int d0 = wc * 32 + 8 * fq; f32x4 gg[2];
#pragma unroll
            for (int n = 0; n < 2; ++n) gg[n] = *(const f32x4*)(gqn + d0 + 4 * n) * *(const f32x4*)(gkn + d0 + 4 * n) * C2;
            float p[2][2][4];
#pragma unroll
            for (int bj = 0; bj < 2; ++bj)
#pragma unroll
                for (int ai = 0; ai < 2; ++ai) if (ai == 0 || !u.half)
#pragma unroll
                    for (int m = 0; m < 4; ++m) p[bj][ai][m] = fq_sum(sq4(acc[ai][bj][m][0]) + sq4(acc[ai][bj][m][1]));
            xwave_rowsum<2>(p, scr, wr, wc, fr, fq);
#pragma unroll
            for (int ai = 0; ai < 2; ++ai) if (ai == 0 || !u.half)
#pragma unroll
                for (int m = 0; m < 4; ++m) { const int row = row0 + ai * HALF + m * 16;
#pragma unroll
                    for (int bj = 0; bj < 2; ++bj) { const float rn = 1.0f / sqrtf(p[bj][ai][m] * (1.f / DNOPE) + EPS);
                        *(u32x4*)(QCAT + (size_t)row * (NHEAD * DQK) + (2 * pn + bj) * DQK + d0) = pack8(acc[ai][bj][m][0] * rn * gg[0], acc[ai][bj][m][1] * rn * gg[1]); } }
        } else {
            const int hd = 4 * (pn - 4) + wc; f32x4 g1[2], g2[2];
#pragma unroll
            for (int n = 0; n < 2; ++n) { g1[n] = *(const f32x4*)(gqr + 8 * fq + 4 * n) * C2; g2[n] = *(const f32x4*)(gqr + 32 + 8 * fq + 4 * n) * C2; }
#pragma unroll
            for (int ai = 0; ai < 2; ++ai) if (ai == 0 || !u.half)
#pragma unroll
                for (int m = 0; m < 4; ++m) { const int row = row0 + ai * HALF + m * 16; float s = 0.f;
#pragma unroll
                    for (int n = 0; n < 2; ++n) s += sq4(acc[ai][0][m][n]) + sq4(acc[ai][1][m][n]);
                    s = fq_sum(s); const float r = 1.0f / sqrtf(s * (1.f / DROPE) + EPS); const int pos = row_pos(row);
                    f32x4 o1[2], o2[2];
#pragma unroll
                    for (int n = 0; n < 2; ++n) { const f32x4 cs = *(const f32x4*)(COS + pos * 32 + 8 * fq + 4 * n), sn = *(const f32x4*)(SIN + pos * 32 + 8 * fq + 4 * n);
                        const f32x4 y1 = acc[ai][0][m][n] * r * g1[n], y2 = acc[ai][1][m][n] * r * g2[n]; o1[n] = y1 * cs - y2 * sn; o2[n] = y2 * cs + y1 * sn; }
                    bf16_t* rp = QCAT + (size_t)row * (NHEAD * DQK) + hd * DQK + DNOPE + 8 * fq;
                    *(u32x4*)(rp) = pack8(o1[0], o1[1]); *(u32x4*)(rp + 32) = pack8(o2[0], o2[1]); }
        }
    }
};

struct EpiKV {
    EPI_INIT_ZERO
    unsigned char* ws;
    __device__ __forceinline__ void operator()(Acc& acc, const Unit& u, int wr, int wc, int fr, int fq, LAS unsigned char* scr) const {
        bf16_t* KCAT = (bf16_t*)(ws + WS_KCAT); bf16_t* V = (bf16_t*)(ws + WS_V);
        const int row0 = u.row0 + wr * 64 + fr, d0 = wc * 32 + 8 * fq, hd = u.pn;
        float p[1][2][4];
#pragma unroll
        for (int ai = 0; ai < 2; ++ai) if (ai == 0 || !u.half)
#pragma unroll
            for (int m = 0; m < 4; ++m) p[0][ai][m] = fq_sum(sq4(acc[ai][0][m][0]) + sq4(acc[ai][0][m][1]));
        xwave_rowsum<1>(p, scr, wr, wc, fr, fq);
#pragma unroll
        for (int ai = 0; ai < 2; ++ai) if (ai == 0 || !u.half)
#pragma unroll
            for (int m = 0; m < 4; ++m) { const int row = row0 + ai * HALF + m * 16; const float rk = 1.0f / sqrtf(p[0][ai][m] * (1.f / DNOPE) + EPS);
                *(u32x4*)(KCAT + (size_t)row * (NHEAD * DNOPE) + hd * DNOPE + d0) = pack8(acc[ai][0][m][0] * rk, acc[ai][0][m][1] * rk);
                *(u32x4*)(V + (size_t)row * (NHEAD * DV) + hd * DV + d0) = pack8(acc[ai][1][m][0], acc[ai][1][m][1]); }
    }
};

struct EpiOut {
    const float* xp; const float* xs; float* Y; unsigned char* ws;
    __device__ __forceinline__ void init(Acc& acc, const Unit& u, int wr, int wc, int fr, int fq) const {
        const int row0 = u.row0 + wr * 64 + fr, col0 = u.pn * BM + wc * 32 + 8 * fq;
#pragma unroll
        for (int ai = 0; ai < 2; ++ai)
#pragma unroll
            for (int m = 0; m < 4; ++m) { const int row = row0 + ai * HALF + m * 16; const float* xr = (row < MP ? xp + (size_t)row * DM : xs + (size_t)(row - MP) * DM) + col0;
#pragma unroll
                for (int bj = 0; bj < 2; ++bj) { if (ai == 0 || !u.half) { acc[ai][bj][m][0] = __builtin_nontemporal_load((const f32x4*)(xr + bj * HALF)); acc[ai][bj][m][1] = __builtin_nontemporal_load((const f32x4*)(xr + bj * HALF + 4)); }
                                                 else { acc[ai][bj][m][0] = (f32x4){0.f, 0.f, 0.f, 0.f}; acc[ai][bj][m][1] = (f32x4){0.f, 0.f, 0.f, 0.f}; } } }
    }
    __device__ __forceinline__ void operator()(Acc& acc, const Unit& u, int wr, int wc, int fr, int fq, LAS unsigned char* scr) const {
        float* SSQH = (float*)(ws + WS_SSQH); const rsrc_t rH = make_rsrc(ws + WS_HBF, (unsigned)MT * DM * 2);
        const int row0 = u.row0 + wr * 64 + fr, col0 = u.pn * BM + wc * 32 + 8 * fq;
        const int mmask = u.slice >= 0 ? (1 << u.slice) : 15;
        float p[1][2][4];
#pragma unroll
        for (int ai = 0; ai < 2; ++ai) if (ai == 0 || !u.half)
#pragma unroll
            for (int m = 0; m < 4; ++m) { const int row = row0 + ai * HALF + m * 16; float s = 0.f; p[0][ai][m] = 0.f; if (!((mmask >> m) & 1)) continue;
#pragma unroll
                for (int bj = 0; bj < 2; ++bj) { const f32x4 a = acc[ai][bj][m][0], b = acc[ai][bj][m][1];
                    const unsigned eo = (unsigned)(row * DM + col0 + bj * HALF);
                    st16_wt(rH, eo * 2u, pack8(a, b)); s += sq4(a) + sq4(b); }
                p[0][ai][m] = fq_sum(s); }
        xwave_rowsum<1>(p, scr, wr, wc, fr, fq);
        if (wc == 0 && fq == 0) {
#pragma unroll
            for (int ai = 0; ai < 2; ++ai) if (ai == 0 || !u.half)
#pragma unroll
                for (int m = 0; m < 4; ++m) if ((mmask >> m) & 1) __hip_atomic_store(SSQH + (size_t)(row0 + ai * HALF + m * 16) * 8 + u.pn, p[0][ai][m], __ATOMIC_RELAXED, __HIP_MEMORY_SCOPE_AGENT);
        }
    }
};

struct EpiGate {
    EPI_INIT_ZERO
    float* Y; unsigned char* ws; const float* bias;
    __device__ __forceinline__ void operator()(Acc& acc, const Unit& u, int wr, int wc, int fr, int fq, LAS unsigned char*) const {
        const bf16_t* PV = u.row0 < MP ? (const bf16_t*)(ws + WS_PV) : (const bf16_t*)(ws + WS_PVS) - (size_t)MP * DM; const bf16_t* HB = (const bf16_t*)(ws + WS_HBF); const float* SSQH = (const float*)(ws + WS_SSQH);
        const int row0 = u.row0 + wr * 64 + fr, col0 = u.pn * BM + wc * 32 + 8 * fq;
        f32x4 bv[2][2];
#pragma unroll
        for (int bj = 0; bj < 2; ++bj) { bv[bj][0] = *(const f32x4*)(bias + col0 + bj * HALF); bv[bj][1] = *(const f32x4*)(bias + col0 + bj * HALF + 4); }
#pragma unroll
        for (int ai = 0; ai < 2; ++ai) if (ai == 0 || !u.half)
#pragma unroll
            for (int m = 0; m < 4; ++m) { if (u.slice >= 0 && m != u.slice) continue;
                const int row = row0 + ai * HALF + m * 16; const f32x4 sa = *(const f32x4*)(SSQH + (size_t)row * 8), sb = *(const f32x4*)(SSQH + (size_t)row * 8 + 4);
                const float rh = 1.0f / sqrtf((((sa[0] + sa[1]) + (sa[2] + sa[3])) + ((sb[0] + sb[1]) + (sb[2] + sb[3]))) * (1.f / DM) + EPS);
#pragma unroll
                for (int bj = 0; bj < 2; ++bj) { float* yp = Y + (size_t)row * DM + col0 + bj * HALF; const u32x4 pw = *(const u32x4*)(PV + (size_t)row * DM + col0 + bj * HALF);
                    const u32x4 hw = *(const u32x4*)(HB + (size_t)row * DM + col0 + bj * HALF);
                    f32x4 h0 = {__uint_as_float(hw.x << 16), __uint_as_float(hw.x & 0xffff0000u), __uint_as_float(hw.y << 16), __uint_as_float(hw.y & 0xffff0000u)};
                    f32x4 h1 = {__uint_as_float(hw.z << 16), __uint_as_float(hw.z & 0xffff0000u), __uint_as_float(hw.w << 16), __uint_as_float(hw.w & 0xffff0000u)}; const f32x4 g0 = acc[ai][bj][m][0] * rh + bv[bj][0], g1 = acc[ai][bj][m][1] * rh + bv[bj][1];
                    h0[0] += sigmoid_f(g0[0]) * __uint_as_float(pw.x << 16); h0[1] += sigmoid_f(g0[1]) * __uint_as_float(pw.x & 0xffff0000u);
                    h0[2] += sigmoid_f(g0[2]) * __uint_as_float(pw.y << 16); h0[3] += sigmoid_f(g0[3]) * __uint_as_float(pw.y & 0xffff0000u);
                    h1[0] += sigmoid_f(g1[0]) * __uint_as_float(pw.z << 16); h1[1] += sigmoid_f(g1[1]) * __uint_as_float(pw.z & 0xffff0000u);
                    h1[2] += sigmoid_f(g1[2]) * __uint_as_float(pw.w << 16); h1[3] += sigmoid_f(g1[3]) * __uint_as_float(pw.w & 0xffff0000u);
                    *(f32x4*)yp = h0; *(f32x4*)(yp + 4) = h1; }
                if (m & 1) asm volatile("" ::: "memory"); }
    }
};

struct SchedP1 { const char* ws; int c, G;
    static constexpr bool SPLITK = true; static constexpr int NSLICE = 2;
    __device__ __forceinline__ float* slab(const Unit& u) const { return (float*)(ws + WS_QCAT) + (size_t)u.uid * (NSLICE * HALF * BM); }
    __device__ __forceinline__ unsigned* ticket(const Unit& u) const { return (unsigned*)(ws + WS_CTL) + 20480 + 64 * u.uid; }
    __device__ __forceinline__ void a_ready(const Unit&, int) const {}
    __device__ __forceinline__ void done(const Unit&, int) const {}
    __device__ __forceinline__ bool get(int i, Unit& u) const {
        constexpr int NF = 32 * 16, NS = 4 * 16 * NSLICE; int nf = (NF - c + G - 1) / G; nf = nf < 0 ? 0 : nf;
        int row0, pn, half = 0, slice = -1, uid = 0, nt = DM / BK; size_t koff = 0; bool ok = true;
        if (i < nf) { int pm; grid_map(c + i * G, 32, 16, pm, pn); row0 = pm * BM; }
        else { const int j = c + (i - nf) * G; ok = j < NS; uid = (j >> 1) & 63; slice = j & 1; row0 = MP + (uid >> 4) * HALF; pn = uid & 15; half = 1; nt = DM / BK / NSLICE; koff = (size_t)slice * nt * BK * 2; }
        u.lda = DM; u.ldb = DM; u.nt = nt; u.type = 0; u.slice = slice; u.uid = uid; u.row0 = row0; u.pn = pn; u.half = half;
        u.A = ws + WS_XN + (size_t)row0 * DM * 2 + koff; u.B = ws + WS_WIN + (size_t)pn * BM * DM * 2 + koff; return ok; }
};
struct SchedP2 { const char* ws; int c, G;
    static constexpr bool SPLITK = false; static constexpr int NSLICE = 1;
    __device__ __forceinline__ float* slab(const Unit&) const { return nullptr; }
    __device__ __forceinline__ unsigned* ticket(const Unit&) const { return nullptr; }
    __device__ __forceinline__ void a_ready(const Unit&, int) const {}
    __device__ __forceinline__ void done(const Unit&, int) const {}
    __device__ __forceinline__ bool get(int i, Unit& u) const {
        int L = c + i * G, pm, pn; u.half = 0; u.slice = -1; u.uid = 0;
        if (L < 204) { grid_map(L, 34, 6, pm, pn); u.type = 0; u.lda = QRANK; u.ldb = QRANK; u.nt = QRANK / BK; u.row0 = pm * BM; u.pn = pn;
            u.A = ws + WS_CQ + (size_t)u.row0 * QRANK * 2; u.B = ws + WS_WUQ + (size_t)pn * BM * QRANK * 2; return true; }
        L -= 204;
        if (L < 256) { grid_map(L, 32, 8, pm, pn); u.type = 1; u.lda = KVRANK; u.ldb = KVRANK; u.nt = KVRANK / BK; u.row0 = pm * BM; u.pn = pn;
            u.A = ws + WS_CKVN + (size_t)u.row0 * KVRANK * 2; u.B = ws + WS_WUKV + (size_t)pn * BM * KVRANK * 2; return true; }
        L -= 256;
        if (L < 144) { grid_map(L, 36, 4, pm, pn); u.type = 2; u.lda = DPOOL; u.ldb = 256; u.nt = 4; u.row0 = pm * BM; u.pn = pn;
            u.A = ws + WS_UBF + ((size_t)u.row0 * DPOOL + pn * 256) * 2; u.B = ws + WS_WPOOL + (size_t)pn * BM * 256 * 2; return true; }
        L -= 144;
        if (L < 16) { u.type = 3; u.lda = DPLE; u.ldb = DPLE; u.nt = DPLE / BK; u.row0 = MP + (L >> 3) * BM; u.pn = L & 7;
            u.A = ws + WS_PBF + (size_t)u.row0 * DPLE * 2; u.B = ws + WS_WPLE + (size_t)u.pn * BM * DPLE * 2; return true; }
        return false; }
};
struct EpiP2 { unsigned char* ws;
    EPI_INIT_ZERO
    __device__ __forceinline__ void operator()(Acc& acc, const Unit& u, int wr, int wc, int fr, int fq, LAS unsigned char* scr) const {
        if (u.type == 0) { const EpiQ q{ws, arg_in(13), arg_in(15), arg_in(14)}; q(acc, u, wr, wc, fr, fq, scr); }
        else if (u.type == 1) { const EpiKV kv{ws}; kv(acc, u, wr, wc, fr, fq, scr); }
        else if (u.type == 2) { const EpiBf16 z{(bf16_t*)(ws + WS_Z), DPOOL, 0}; z(acc, u, wr, wc, fr, fq, scr); }
        else { const EpiBf16 e{(bf16_t*)(ws + WS_PVS) - (size_t)MP * DM, DM, 0}; e(acc, u, wr, wc, fr, fq, scr); } }
};

struct SchedP45 { const char* ws; unsigned* cnt; int c, G, stream;
    static constexpr bool SPLITK = true; static constexpr int NSLICE = 4;
    __device__ __forceinline__ bool warm(const Unit&) const { return false; }
    __device__ __forceinline__ int panel_of(const Unit& u) const { return u.row0 < MP ? (u.row0 >> 8) : 32 + ((u.row0 - MP) >> 7); }
    __device__ __forceinline__ float* slab(const Unit& u) const { return (float*)(ws + (u.type == 0 ? WS_SGM : WS_V)) + (size_t)u.uid * (4 * HALF * BM); }
    __device__ __forceinline__ unsigned* ticket(const Unit& u) const { return cnt + 64 * ((u.type == 0 ? 38 : 70) + u.uid); }
    __device__ __forceinline__ bool get(int i, Unit& u) const {
        constexpr int NF = 32 * 8, NS = 32 * 4; int pm = 0, pn = 0, type, row0, half = 0, slice = -1, uid = 0; bool ok = true;
        int nf = (NF - c + G - 1) / G; nf = nf < 0 ? 0 : nf;
        const int c2 = (c + G - (128 % G)) % G;
        if (stream == 1) {
            if (i < 2 * nf) { grid_map(c + (i >> 1) * G, 32, 8, pm, pn); type = ((i & 1) != (c < NS ? 1 : 0)) ? 1 : 0; row0 = pm * BM; }
            else { const int j = c + (i - 2 * nf) * G; ok = j < NS; type = 0; uid = (j >> 2) & 31; slice = j & 3; row0 = MP + (uid >> 3) * HALF; pn = uid & 7; half = 1; }
        } else {
            type = 2;
            if (i < nf) { grid_map(c + i * G, 32, 8, pm, pn); row0 = pm * BM; }
            else { const int j = c2 + (i - nf) * G; ok = j < NS; uid = (j >> 2) & 31; slice = j & 3; row0 = MP + (uid >> 3) * HALF; pn = uid & 7; half = 1; }
        }
        const bool ple = type == 1; const int ld = ple ? DPLE : DM; const int nt = slice >= 0 ? 8 : ld / BK; const size_t koff = slice >= 0 ? (size_t)slice * 8 * BK * 2 : 0;
        u.type = type; u.row0 = row0; u.pn = pn; u.half = half; u.slice = slice; u.uid = uid; u.lda = ld; u.ldb = ld; u.nt = nt;
        u.A = ws + (ple ? WS_PBF : (type == 0 ? WS_MIX : WS_HBF)) + (size_t)row0 * ld * 2 + koff;
        u.B = ws + (ple ? WS_WPLE : (type == 0 ? WS_WOUT : WS_WGATE)) + (size_t)pn * BM * ld * 2 + koff;
        return ok; }
    __device__ __forceinline__ void a_ready(const Unit& u, int wid) const {
        if (u.type != 2) return;
        if (wid == 0) {
            unsigned* p1 = cnt + 64 * panel_of(u); unsigned sp = 0;
            while ((unsigned)__builtin_amdgcn_readfirstlane(__hip_atomic_load(p1, __ATOMIC_RELAXED, __HIP_MEMORY_SCOPE_AGENT)) < (u.half ? 32u : 8u)) { __builtin_amdgcn_s_sleep(2); if (++sp > (1u << 24)) break; }
            __builtin_amdgcn_fence(__ATOMIC_ACQUIRE, "agent");
            asm volatile("s_waitcnt vmcnt(0)" ::: "memory");
        }
        asm volatile("" ::: "memory"); __builtin_amdgcn_s_barrier(); asm volatile("" ::: "memory");
    }
    __device__ __forceinline__ void done(const Unit& u, int wid) const {
        if (u.type != 0) return;
        asm volatile("s_waitcnt vmcnt(0)" ::: "memory");
        __builtin_amdgcn_s_barrier(); asm volatile("" ::: "memory");
        if (wid == 0 && lane_id() == 0) __hip_atomic_fetch_add(cnt + 64 * panel_of(u), 1u, __ATOMIC_RELAXED, __HIP_MEMORY_SCOPE_AGENT);
    }
};
struct EpiP45 { unsigned char* ws; float* out;
    __device__ __forceinline__ void init(Acc& acc, const Unit& u, int wr, int wc, int fr, int fq) const {
        if (u.type == 0 && u.slice <= 0) { const EpiOut o{arg_in(0), arg_in(1), out + O_Y, ws}; o.init(acc, u, wr, wc, fr, fq); } else acc_zero(acc); }
    __device__ __forceinline__ void operator()(Acc& acc, const Unit& u, int wr, int wc, int fr, int fq, LAS unsigned char* scr) const {
        if (u.type == 0) { const EpiOut o{nullptr, nullptr, out + O_Y, ws}; o(acc, u, wr, wc, fr, fq, scr); }
        else if (u.type == 1) { const EpiBf16 e{(bf16_t*)(ws + WS_PV), DM, 0}; e(acc, u, wr, wc, fr, fq, scr); }
        else { const EpiGate g{out + O_Y, ws, arg_in(22)}; g(acc, u, wr, wc, fr, fq, scr); } }
};
}

struct Args { const float* in[24]; float* out; unsigned char* ws; int ph_lo, ph_hi, li, pad; };
enum { I_XP = 0, I_XS, I_CCKV, I_CKR, I_SPOOL, I_PP, I_PS, I_NORMG, I_WIN, I_QNG, I_WUQ, I_KVNG, I_WUKV, I_QNOPEG, I_QROPEG, I_KNOPEG, I_KROPEG, I_WPOOL, I_PSCALE, I_WOUT, I_PLENG, I_WGATE, I_BGATE, I_WPLE };


__device__ __forceinline__ void cache_item(const float* W, bf16_t* CB, bf16_t* CT, int k0, int n0, LAS float* scr, int lane, bool doB, bool doT) {
    float tv[32];
#pragma unroll
    for (int i = 0; i < 32; ++i) tv[i] = __builtin_nontemporal_load(W + (size_t)(k0 + 2 * i + (lane >> 5)) * KVRANK + n0 + (lane & 31));
#pragma unroll
    for (int i = 0; i < 32; ++i) scr[(2 * i + (lane >> 5)) * 33 + (lane & 31)] = tv[i];
    LDS_WAIT(); asm volatile("" ::: "memory");
    const int kb0 = k0 >> 5, s0 = n0 >> 4;
#pragma unroll
    for (int c = 0; c < 4; ++c) { const int kbl = c >> 1, sl = c & 1;
        if (doB) { const LAS float* p = scr + (kbl * 32 + (lane & 31)) * 33 + sl * 16 + 8 * (lane >> 5);
          u32x4 o; o.x = cvtpk(p[0], p[1]); o.y = cvtpk(p[2], p[3]); o.z = cvtpk(p[4], p[5]); o.w = cvtpk(p[6], p[7]);
          *(u32x4*)(CB + ((size_t)((kb0 + kbl) * 16 + s0 + sl) * 64 + lane) * 8) = o; }
        if (doT) { const LAS float* p = scr + (kbl * 32 + 8 * (lane >> 4)) * 33 + sl * 16 + (lane & 15);
          u32x4 o; o.x = cvtpk(p[0 * 33], p[1 * 33]); o.y = cvtpk(p[2 * 33], p[3 * 33]); o.z = cvtpk(p[4 * 33], p[5 * 33]); o.w = cvtpk(p[6 * 33], p[7 * 33]);
          *(u32x4*)(CT + ((size_t)((kb0 + kbl) * 16 + s0 + sl) * 64 + lane) * 8) = o; } }
    LDS_WAIT(); asm volatile("" ::: "memory");
}
__device__ __forceinline__ bf16_t* ckvb_base(float* out, int b) { return (bf16_t*)((unsigned char*)out + OB_CKVB + (size_t)b * CKVT_B); }
__device__ __forceinline__ bf16_t* ckvt_base(float* out, int b) { return (bf16_t*)((unsigned char*)out + OB_CKVT + (size_t)b * CKVT_B); }

__device__ __forceinline__ void transpose_load(float (&tv)[32], const float* W, int N, int k0, int n0, int lane) {
#pragma unroll
    for (int i = 0; i < 32; ++i) tv[i] = __builtin_nontemporal_load(W + (size_t)(k0 + 2 * i + (lane >> 5)) * N + n0 + (lane & 31));
}
__device__ __forceinline__ void transpose_finish(float (&tv)[32], bf16_t* WT, int ldt, int k0, int n0, int drow0, const float* kgain, LAS float* scr, int lane) {
    if (kgain) {
#pragma unroll
        for (int i = 0; i < 32; ++i) tv[i] *= kgain[k0 + 2 * i + (lane >> 5)]; }
#pragma unroll
    for (int i = 0; i < 32; ++i) scr[(2 * i + (lane >> 5)) * 33 + (lane & 31)] = tv[i];
    LDS_WAIT(); asm volatile("" ::: "memory");
    const int c = lane & 7;
#pragma unroll
    for (int j = 0; j < 4; ++j) { const int n = (lane >> 3) + 8 * j; const LAS float* s = scr + (8 * c) * 33 + n;
        u32x4 o; o.x = cvtpk(s[0 * 33], s[1 * 33]); o.y = cvtpk(s[2 * 33], s[3 * 33]); o.z = cvtpk(s[4 * 33], s[5 * 33]); o.w = cvtpk(s[6 * 33], s[7 * 33]);
        *(u32x4*)(WT + (size_t)(drow0 + n) * ldt + k0 + 8 * c) = o; }
    LDS_WAIT(); asm volatile("" ::: "memory");
}
__device__ __forceinline__ void transpose_item(const float* W, int N, bf16_t* WT, int ldt, int k0, int n0, int drow0, const float* kgain, LAS float* scr, int lane) {
    float tv[32]; transpose_load(tv, W, N, k0, n0, lane); transpose_finish(tv, WT, ldt, k0, n0, drow0, kgain, scr, lane);
}

__device__ __forceinline__ void p1_chunk(const struct Args& a, unsigned char* ws, int ch, LAS float* scr, int lane, int wave, int tid);
__device__ __forceinline__ void p0_prologue(const Args& a, LAS unsigned char* lds, int vcu, int G, int wv, int part) {
    const int lane = lane_id(), wave = wv, tid = (wv << 6) | lane;
    LAS float* scr = (LAS float*)(lds + wave * 16384);
    const int gw = vcu * 8 + wave, NGW = G * 8;
    unsigned char* ws = a.ws;
    bf16_t* Win_t = (bf16_t*)(ws + WS_WIN);
    const int gt = vcu * 512 + tid, NGT = G * 512;
    if (part == 0) {
        constexpr int I_IN = 32 * 122;
        { const float* W = AIN(I_WIN);
          for (int r = gw; r < I_IN; r += 2 * NGW) {
              const int r1 = r + NGW; const bool has1 = r1 < I_IN; float tvA[32], tvB[32];
              const int kbA = r / 122, nA = 32 * (r % 122), dA = nA < 2816 ? nA : (nA == 2816 ? 3840 : (nA == 2848 ? 3968 : nA - 64));
              const int kbB = r1 / 122, nB = 32 * (r1 % 122), dB = nB < 2816 ? nB : (nB == 2816 ? 3840 : (nB == 2848 ? 3968 : nB - 64));
              transpose_load(tvA, W, DIN, 64 * kbA, nA, lane);
              if (has1) transpose_load(tvB, W, DIN, 64 * kbB, nB, lane);
              transpose_finish(tvA, Win_t, DM, 64 * kbA, nA, dA, nullptr, scr, lane);
              if (has1) transpose_finish(tvB, Win_t, DM, 64 * kbB, nB, dB, nullptr, scr, lane); } }
        {
            bf16_t* XN = (bf16_t*)(ws + WS_XN); const float* gp = AIN(I_NORMG); const float* xp = AIN(I_XP); const float* xs = AIN(I_XS);
            f32x4 gv[8];
#pragma unroll
            for (int j = 0; j < 8; ++j) gv[j] = *(const f32x4*)(gp + 4 * lane + 256 * j);
#define XN_LOAD(mm) do { const float* xr_ = ((mm) < MP ? xp + (size_t)(mm) * DM : xs + (size_t)((mm) - MP) * DM) + 4 * lane; _Pragma("unroll") for (int j = 0; j < 8; ++j) v[j] = __builtin_nontemporal_load((const f32x4*)(xr_ + 256 * j)); } while (0)
            f32x4 v[8]; int m = gw;
            if (m < MT) XN_LOAD(m);
            while (m < MT) {
                float sm = 0.f;
#pragma unroll
                for (int j = 0; j < 8; ++j) sm += pg8::sq4(v[j]);
                const float r = 1.0f / sqrtf(wave_sum(sm) * (1.f / DM) + EPS);
                u32x2 w[8];
#pragma unroll
                for (int j = 0; j < 8; ++j) { const f32x4 o = v[j] * r * gv[j]; w[j].x = cvtpk(o[0], o[1]); w[j].y = cvtpk(o[2], o[3]); }
                const int mn = m + NGW;
                if (mn < MT) XN_LOAD(mn);
                asm volatile("" ::: "memory");
#pragma unroll
                for (int j = 0; j < 8; ++j) *(u32x2*)(XN + (size_t)m * DM + 4 * lane + 256 * j) = w[j];
                m = mn;
            }
#undef XN_LOAD
        }
        {
            float* COS = (float*)(ws + WS_COS); float* SIN = (float*)(ws + WS_SIN);
            for (int i = tid * G + vcu; i < SKV_S * 32; i += 512 * G) { const int pos = i >> 5, fi = i & 31; const float inv = (float)exp(-(double)fi * (1.0 / 32.0) * 9.210340371976184); const float ang = (float)pos * inv;
                float sv, cv; sincosf(ang, &sv, &cv); COS[i] = cv; SIN[i] = sv; }
        }
        {
            for (int i = gt; i < 192 * (DM / 8); i += NGT) { const int rr = i >> 8, c = (i & 255) * 8; const int row = 3840 + (rr < 96 ? 32 + rr : 160 + (rr - 96));
                *(u32x4*)(Win_t + (size_t)row * DM + c) = (u32x4){0u, 0u, 0u, 0u}; }
        }
        return;
    }
    unsigned* cctr = (unsigned*)(ws + WS_CTL) + 11776 + 64 * a.li;
    volatile LAS unsigned* MISCp = (volatile LAS unsigned*)(lds + MISC_OFF);
    if (tid == 0) MISCp[23] = __hip_atomic_fetch_add(cctr, 1u, __ATOMIC_RELAXED, __HIP_MEMORY_SCOPE_AGENT);
    __syncthreads();
    for (int ch = (int)MISCp[23];; ) {
        __syncthreads();
        if (ch >= 852 + NBT_A * 32 - 512) break;
        unsigned nxt_ticket = 0u; if (tid == 0) nxt_ticket = __hip_atomic_fetch_add(cctr, 1u, __ATOMIC_RELAXED, __HIP_MEMORY_SCOPE_AGENT);
        p1_chunk(a, ws, ch < 96 ? ch : ch + 512, scr, lane, wave, tid);
        if (tid == 0) MISCp[23] = nxt_ticket;
        __syncthreads();
        ch = (int)MISCp[23];
    }
}
__device__ __forceinline__ void p1_chunk(const Args& a, unsigned char* ws, int ch, LAS float* scr, int lane, int wave, int tid) {
    bf16_t* Wuq_t = (bf16_t*)(ws + WS_WUQ); bf16_t* Wukv_t = (bf16_t*)(ws + WS_WUKV); bf16_t* Wpool_t = (bf16_t*)(ws + WS_WPOOL);
    bf16_t* Wout_t = (bf16_t*)(ws + WS_WOUT); bf16_t* Wgate_t = (bf16_t*)(ws + WS_WGATE); bf16_t* Wple_t = (bf16_t*)(ws + WS_WPLE);
    constexpr int I_UQ = 8 * 48, I_UKV = 4 * 64, I_POOL = 4 * 4 * 8, I_OUT = 32 * 64, I_GATE = 32 * 64;
    {
        if (ch >= 852) { const int item = (ch - 852) * 8 + wave, bb = item >> 8, kbk = (item & 255) >> 3, nb = item & 7;
            cache_item(AIN(I_CCKV) + (size_t)bb * PAST * KVRANK, ckvb_base(a.out, bb), ckvt_base(a.out, bb), 64 * kbk, 32 * nb, scr, lane, true, true); return; }
        if (ch < 640) {
            int r = ch * 8 + wave;
            if (r < I_UQ) { const int kb = r / 48, nb = r % 48, n0 = 32 * nb, h = n0 / DQK, j0 = n0 % DQK;
                const int d = j0 < 128 ? h * 128 + j0 : 1024 + 256 * (h >> 2) + 32 * (h & 3) + (j0 == 160 ? 128 : 0);
                transpose_item(AIN(I_WUQ), NHEAD * DQK, Wuq_t, QRANK, 64 * kb, n0, d, AIN(I_QNG), scr, lane); return; } r -= I_UQ;
            if (r < I_UKV) { const int kb = r / 64, nb = r % 64; transpose_item(AIN(I_WUKV), 2048, Wukv_t, KVRANK, 64 * kb, 32 * nb, 32 * nb, nullptr, scr, lane); return; } r -= I_UKV;
            if (r < I_POOL) { const int gq = r / 32, kb = (r % 32) / 8, nb = r % 8; transpose_item(AIN(I_WPOOL) + (size_t)gq * 65536, 256, Wpool_t, 256, 64 * kb, 32 * nb, gq * 256 + 32 * nb, nullptr, scr, lane); return; } r -= I_POOL;
            if (r < I_OUT) { const int kb = r / 64, nb = r % 64; transpose_item(AIN(I_WOUT), DM, Wout_t, DM, 64 * kb, 32 * nb, 32 * nb, nullptr, scr, lane); return; } r -= I_OUT;
            if (r < I_GATE) { const int kb = r / 64, nb = r % 64; transpose_item(AIN(I_WGATE), DM, Wgate_t, DM, 64 * kb, 32 * nb, 32 * nb, AIN(I_PLENG), scr, lane); return; } r -= I_GATE;
            { const int kb = r / 64, nb = r % 64; transpose_item(AIN(I_WPLE), DM, Wple_t, DPLE, 64 * kb, 32 * nb, 32 * nb, nullptr, scr, lane); }
        } else if (ch < 708) {
            bf16_t* PBF = (bf16_t*)(ws + WS_PBF); const float* pp = AIN(I_PP); const float* ps = AIN(I_PS);
#pragma unroll
            for (int k = 0; k < 8; ++k) { const int i = (ch - 640) * 4096 + tid + k * 512, m = i >> 5, c = (i & 31) * 8; const float* src = (m < MP ? pp + (size_t)m * DPLE : ps + (size_t)(m - MP) * DPLE) + c;
                *(u32x4*)(PBF + (size_t)m * DPLE + c) = pack8(__builtin_nontemporal_load((const f32x4*)src), __builtin_nontemporal_load((const f32x4*)(src + 4))); }
        } else if (ch < 724) {
            bf16_t* UBF = (bf16_t*)(ws + WS_UBF); const float* sp = AIN(I_SPOOL);
#pragma unroll
            for (int k = 0; k < 8; ++k) { const int i = (ch - 708) * 4096 + tid + k * 512, rr = i >> 7, c = (i & 127) * 8; u32x4 w = {0u, 0u, 0u, 0u};
                if (rr < DBATCH * POOLH) { const float* src = sp + (size_t)rr * DPOOL + c; w = pack8(*(const f32x4*)src, *(const f32x4*)(src + 4)); }
                *(u32x4*)(UBF + (size_t)(MT + rr) * DPOOL + c) = w; }
        } else {
            const float* src = AIN(I_CKR) + (size_t)(ch - 724) * 32768; bf16_t* dst = (bf16_t*)(ws + WS_KRB) + (size_t)(ch - 724) * 32768;
#pragma unroll
            for (int k = 0; k < 8; ++k) { const int o = tid * 8 + k * 4096; *(u32x4*)(dst + o) = pack8(__builtin_nontemporal_load((const f32x4*)(src + o)), __builtin_nontemporal_load((const f32x4*)(src + o + 4))); }
        }
    }
}

namespace pattn {
constexpr int KVBLK = 64, NW = 8, QBLK = 32;
constexpr int SHM_V = 16384, SHM_KN = 16384, SHM_KR = 8192;
constexpr int L_V = 0, L_KN = 2 * SHM_V, L_KR = L_KN + 2 * SHM_KN, L_WS = L_KR + 2 * SHM_KR, L_END = L_WS + NW * 64 * 4;
constexpr int LDQ = NHEAD * DQK, LDK = NHEAD * DNOPE, LDV = NHEAD * DV;
constexpr float THR = 4.0f;
#define KSWZ(row, colB) ((row) * 256 + ((colB) ^ (((row) & 7) << 4)))
#define RSWZ(row, colB) ((row) * 128 + ((colB) ^ (((row) & 7) << 4)))
__device__ __forceinline__ int crow(int r, int hi) { return (r & 3) + 8 * (r >> 2) + 4 * hi; }

__device__ __forceinline__ void partialSM(f32x16& p0, f32x16& p1, float& m_reg, float& alpha) {
    float pmax = p0[0];
#pragma unroll
    for (int r = 1; r < 16; ++r) pmax = fmaxf(pmax, p0[r]);
#pragma unroll
    for (int r = 0; r < 16; ++r) pmax = fmaxf(pmax, p1[r]);
    { auto rr = __builtin_amdgcn_permlane32_swap(__float_as_uint(pmax), __float_as_uint(pmax), false, false); pmax = fmaxf(__uint_as_float(rr[0]), __uint_as_float(rr[1])); }
    float mn;
    if (__builtin_expect(__all(pmax - m_reg <= THR), 1)) { mn = m_reg; alpha = 1.f; }
    else { mn = fmaxf(m_reg, pmax); alpha = __builtin_amdgcn_exp2f(m_reg - mn); m_reg = mn; }
#pragma unroll
    for (int r = 0; r < 16; ++r) p0[r] = p0[r] - mn;
#pragma unroll
    for (int r = 0; r < 16; ++r) p1[r] = p1[r] - mn;
#pragma unroll
    for (int r = 0; r < 16; ++r) p0[r] = __builtin_amdgcn_exp2f(p0[r]);
}
__device__ __forceinline__ void finishSM(f32x16& p0, f32x16& p1, float alpha, float& l_reg, bf16x8& pa0, bf16x8& pa1, bf16x8& pa2, bf16x8& pa3) {
#pragma unroll
    for (int r = 0; r < 16; ++r) p1[r] = __builtin_amdgcn_exp2f(p1[r]);
    float ps = 0;
#pragma unroll
    for (int r = 0; r < 16; ++r) ps += p0[r];
#pragma unroll
    for (int r = 0; r < 16; ++r) ps += p1[r];
    { auto rr = __builtin_amdgcn_permlane32_swap(__float_as_uint(ps), __float_as_uint(ps), false, false); ps = __uint_as_float(rr[0]) + __uint_as_float(rr[1]); }
    l_reg = l_reg * alpha + ps;
#define PK4(P, BASE, OUT) do { unsigned a0 = cvtpk(P[BASE + 0], P[BASE + 1]), a1 = cvtpk(P[BASE + 2], P[BASE + 3]);   \
    unsigned b0 = cvtpk(P[BASE + 4], P[BASE + 5]), b1 = cvtpk(P[BASE + 6], P[BASE + 7]);                              \
    auto r0 = __builtin_amdgcn_permlane32_swap(a0, b0, false, false); auto r1 = __builtin_amdgcn_permlane32_swap(a1, b1, false, false); \
    u32x4 w = {r0[0], r1[0], r0[1], r1[1]}; OUT = __builtin_bit_cast(bf16x8, w); } while (0)
    PK4(p0, 0, pa0); PK4(p0, 8, pa1); PK4(p1, 0, pa2); PK4(p1, 8, pa3);
#undef PK4
}
__device__ __forceinline__ void qkt(f32x16& p0, f32x16& p1, LAS const unsigned char* Kn, LAS const unsigned char* Kr, const bf16x8* qr, int r32, int hi) {
    p0 = f32x16{}; p1 = f32x16{};
#pragma unroll
    for (int d0 = 0; d0 < 8; ++d0) { const int cb = (d0 * 16 + hi * 8) * 2;
        const bf16x8 b0 = *(LAS const bf16x8*)(Kn + KSWZ(r32, cb)); const bf16x8 b1 = *(LAS const bf16x8*)(Kn + KSWZ(32 + r32, cb));
        p0 = __builtin_amdgcn_mfma_f32_32x32x16_bf16(b0, qr[d0], p0, 0, 0, 0); p1 = __builtin_amdgcn_mfma_f32_32x32x16_bf16(b1, qr[d0], p1, 0, 0, 0); }
#pragma unroll
    for (int d0 = 0; d0 < 4; ++d0) { const int cb = (d0 * 16 + hi * 8) * 2;
        const bf16x8 b0 = *(LAS const bf16x8*)(Kr + RSWZ(r32, cb)); const bf16x8 b1 = *(LAS const bf16x8*)(Kr + RSWZ(32 + r32, cb));
        p0 = __builtin_amdgcn_mfma_f32_32x32x16_bf16(b0, qr[8 + d0], p0, 0, 0, 0); p1 = __builtin_amdgcn_mfma_f32_32x32x16_bf16(b1, qr[8 + d0], p1, 0, 0, 0); }
}
__device__ __forceinline__ int v_st(int k, int c) { const int kk = (k & ~0xC) | ((k & 4) << 1) | ((k & 8) >> 1); return ((kk >> 3) * 4 + (c >> 5)) * 512 + ((kk & 7) * 32 + (c & 31)) * 2; }
__device__ __forceinline__ int v_rd_base(int lane) { return ((lane & 3) << 3) | (((lane >> 2) & 3) << 6) | (((lane >> 4) & 1) << 5) | (((lane >> 5) & 1) << 8); }
constexpr int v_rd_off(int d0, int ks, int half) { return d0 * 512 + ks * 4096 + half * 2048; }
template <int OFF> __device__ __forceinline__ s16x4 tr_read(int vb) { s16x4 r; asm volatile("ds_read_b64_tr_b16 %0, %1 offset:%2" : "=&v"(r) : "v"(vb), "i"(OFF) : "memory"); return r; }
template <int D0> __device__ __forceinline__ void pv_one(f32x16& od, int vb, bf16x8 pa0, bf16x8 pa1, bf16x8 pa2, bf16x8 pa3) {
    const s16x4 l0 = tr_read<v_rd_off(D0, 0, 0)>(vb), h0 = tr_read<v_rd_off(D0, 0, 1)>(vb), l1 = tr_read<v_rd_off(D0, 1, 0)>(vb), h1 = tr_read<v_rd_off(D0, 1, 1)>(vb);
    const s16x4 l2 = tr_read<v_rd_off(D0, 2, 0)>(vb), h2 = tr_read<v_rd_off(D0, 2, 1)>(vb), l3 = tr_read<v_rd_off(D0, 3, 0)>(vb), h3 = tr_read<v_rd_off(D0, 3, 1)>(vb);
    asm volatile("s_waitcnt lgkmcnt(0)" ::: "memory"); SBAR();
#define PK(L, H) (bf16x8){L[0], L[1], L[2], L[3], H[0], H[1], H[2], H[3]}
    od = __builtin_amdgcn_mfma_f32_32x32x16_bf16(pa0, PK(l0, h0), od, 0, 0, 0);
    od = __builtin_amdgcn_mfma_f32_32x32x16_bf16(pa1, PK(l1, h1), od, 0, 0, 0);
    od = __builtin_amdgcn_mfma_f32_32x32x16_bf16(pa2, PK(l2, h2), od, 0, 0, 0);
    od = __builtin_amdgcn_mfma_f32_32x32x16_bf16(pa3, PK(l3, h3), od, 0, 0, 0);
#undef PK
}
__device__ __forceinline__ void pv_d0(f32x16* o, int vb, bf16x8 pa0, bf16x8 pa1, bf16x8 pa2, bf16x8 pa3) {
    pv_one<0>(o[0], vb, pa0, pa1, pa2, pa3); pv_one<1>(o[1], vb, pa0, pa1, pa2, pa3); pv_one<2>(o[2], vb, pa0, pa1, pa2, pa3); pv_one<3>(o[3], vb, pa0, pa1, pa2, pa3);
}

__device__ __forceinline__ void unit(int b, int h, int qb, const bf16_t* __restrict__ QCAT, const bf16_t* __restrict__ KCAT, const bf16_t* __restrict__ KRN, const bf16_t* __restrict__ Vb, const bf16_t* __restrict__ SGM, bf16_t* MIX, LAS unsigned char* lds, int wv) {
    int lane = lane_id(); asm volatile("" : "+v"(lane));
    const int wid = wv, tid = (wv << 6) | lane, r32 = lane & 31, hi = lane >> 5;
    const long rowbase = (long)b * SEQ; const int q0 = qb * 256;
    LAS unsigned char* V_lds = lds + L_V; LAS unsigned char* KN_lds = lds + L_KN; LAS unsigned char* KR_lds = lds + L_KR;
    LAS float* wsf = (LAS float*)(lds + L_WS) + wid * 64; LAS float* li_l = wsf; LAS float* al_l = wsf + 32;
    const bf16_t* Kh = KCAT + rowbase * LDK + h * DNOPE; const bf16_t* Vh = Vb + rowbase * LDV + h * DV; const bf16_t* Kr = KRN + rowbase * DROPE;
    float m_reg = -1e30f, l_reg = 0.f; f32x16 o[4]; o[0] = f32x16{}; o[1] = f32x16{}; o[2] = f32x16{}; o[3] = f32x16{};
    bf16x8 qr[12];
    { const bf16_t* Qw = QCAT + (rowbase + q0 + wid * QBLK + r32) * LDQ + h * DQK + hi * 8;
#pragma unroll
      for (int d0 = 0; d0 < 12; ++d0) qr[d0] = *(const bf16x8*)(Qw + d0 * 16); }
    const int cw = 4 * qb + (wid >> 1);
    const int NT = 4 * qb + 4;
    const int sr = tid >> 4, sc = (tid & 15) * 8, vst0 = v_st(sr, sc), vst1 = v_st(32 + sr, sc);
    const int krr = tid >> 3, krc = (tid & 7) * 8;
    const int vb0 = (int)(uintptr_t)V_lds + v_rd_base(lane);
    bf16x8 sv0, sv1, sk0, sk1, skr;
#define SLOAD(k0) do { sv0 = *(const bf16x8*)(Vh + (long)((k0) + sr) * LDV + sc); sv1 = *(const bf16x8*)(Vh + (long)((k0) + 32 + sr) * LDV + sc); \
    sk0 = *(const bf16x8*)(Kh + (long)((k0) + sr) * LDK + sc); sk1 = *(const bf16x8*)(Kh + (long)((k0) + 32 + sr) * LDK + sc); \
    skr = *(const bf16x8*)(Kr + (long)((k0) + krr) * DROPE + krc); } while (0)
#define SWRITE(bb) do { *(LAS bf16x8*)(V_lds + (bb) * SHM_V + vst0) = sv0; *(LAS bf16x8*)(V_lds + (bb) * SHM_V + vst1) = sv1; \
    *(LAS bf16x8*)(KN_lds + (bb) * SHM_KN + KSWZ(sr, sc * 2)) = sk0; *(LAS bf16x8*)(KN_lds + (bb) * SHM_KN + KSWZ(32 + sr, sc * 2)) = sk1; \
    *(LAS bf16x8*)(KR_lds + (bb) * SHM_KR + RSWZ(krr, krc * 2)) = skr; } while (0)
#define RESC(a) do { if (__any((a) < 1.f)) { if (hi == 0) al_l[r32] = (a); asm volatile("s_waitcnt lgkmcnt(0)" ::: "memory"); \
    _Pragma("unroll") for (int d = 0; d < 4; ++d) _Pragma("unroll") for (int r = 0; r < 16; ++r) o[d][r] *= al_l[crow(r, hi)]; } } while (0)
#define QKT(P0, P1, bb, j) do { if ((j) <= cw) qkt(P0, P1, KN_lds + (bb) * SHM_KN, KR_lds + (bb) * SHM_KR, qr, r32, hi); \
    else { _Pragma("unroll") for (int r = 0; r < 16; ++r) { P0[r] = -1e30f; P1[r] = -1e30f; } } } while (0)
#define PV(bb, j) do { if ((j) <= cw) pv_d0(o, vb0 + (bb) * SHM_V, pa0, pa1, pa2, pa3); } while (0)
    f32x16 pA0, pA1, pB0, pB1; float alA, alB; bf16x8 pa0, pa1, pa2, pa3;
    SLOAD(0); SWRITE(0); __syncthreads();
    QKT(pA0, pA1, 0, 0); partialSM(pA0, pA1, m_reg, alA);
    SLOAD(KVBLK); SWRITE(1); __syncthreads();
    for (int j = 1; j + 1 < NT; j += 2) {
        SBAR(); QKT(pB0, pB1, 1, j);
        finishSM(pA0, pA1, alA, l_reg, pa0, pa1, pa2, pa3); SBAR();
        SLOAD((j + 1) * KVBLK); SBAR();
        PV(0, j - 1); partialSM(pB0, pB1, m_reg, alB);
        __syncthreads(); SWRITE(0);
        RESC(alB); __syncthreads();
        SBAR(); QKT(pA0, pA1, 0, j + 1);
        finishSM(pB0, pB1, alB, l_reg, pa0, pa1, pa2, pa3); SBAR();
        SLOAD((j + 2) * KVBLK); SBAR();
        PV(1, j); partialSM(pA0, pA1, m_reg, alA);
        __syncthreads(); SWRITE(1);
        RESC(alA); __syncthreads();
    }
    SBAR(); QKT(pB0, pB1, 1, NT - 1);
    finishSM(pA0, pA1, alA, l_reg, pa0, pa1, pa2, pa3); SBAR();
    PV(0, NT - 2); partialSM(pB0, pB1, m_reg, alB);
    __syncthreads(); RESC(alB);
    finishSM(pB0, pB1, alB, l_reg, pa0, pa1, pa2, pa3); SBAR();
    PV(1, NT - 1);
    const long orow0 = rowbase + q0 + wid * QBLK;
    u32x4 gqv[8];
#pragma unroll
    for (int i = 0; i < 8; ++i) gqv[i] = *(const u32x4*)(SGM + (orow0 + i * 4 + (lane >> 4)) * 1024 + h * DV + (lane & 15) * 8);
    if (hi == 0) li_l[r32] = l_reg; asm volatile("s_waitcnt lgkmcnt(0)" ::: "memory");
    float rli[16];
#pragma unroll
    for (int r = 0; r < 16; ++r) rli[r] = __builtin_amdgcn_rcpf(li_l[crow(r, hi)]);
    __syncthreads();
    LAS bf16_t* stg = (LAS bf16_t*)(lds + wid * 8192);
#pragma unroll
    for (int r = 0; r < 16; ++r) { const int orow = crow(r, hi);
#pragma unroll
        for (int d0 = 0; d0 < 4; ++d0) { const float v = o[d0][r] * rli[r]; stg[orow * 128 + d0 * 32 + r32] = (bf16_t)(cvtpk(v, 0.f) & 0xffffu); } }
    asm volatile("s_waitcnt lgkmcnt(0)" ::: "memory");
#pragma unroll
    for (int i = 0; i < 8; ++i) { const int row = i * 4 + (lane >> 4), ch = lane & 15; const u32x4 v = *(LAS const u32x4*)(stg + row * 128 + ch * 8);
        const u32x4 gq = gqv[i]; u32x4 w;
        w.x = cvtpk(__uint_as_float(v.x << 16) * __uint_as_float(gq.x << 16), __uint_as_float(v.x & 0xffff0000u) * __uint_as_float(gq.x & 0xffff0000u));
        w.y = cvtpk(__uint_as_float(v.y << 16) * __uint_as_float(gq.y << 16), __uint_as_float(v.y & 0xffff0000u) * __uint_as_float(gq.y & 0xffff0000u));
        w.z = cvtpk(__uint_as_float(v.z << 16) * __uint_as_float(gq.z << 16), __uint_as_float(v.z & 0xffff0000u) * __uint_as_float(gq.z & 0xffff0000u));
        w.w = cvtpk(__uint_as_float(v.w << 16) * __uint_as_float(gq.w << 16), __uint_as_float(v.w & 0xffff0000u) * __uint_as_float(gq.w & 0xffff0000u));
        *(u32x4*)(MIX + (orow0 + row) * DM + DPOOL + h * DV + ch * 8) = w; }
    __syncthreads();
#undef SLOAD
#undef SWRITE
#undef RESC
#undef QKT
#undef PV
}
}

namespace sattn {
__device__ __forceinline__ int crow(int r, int hi) { return (r & 3) + 8 * (r >> 2) + 4 * hi; }
__device__ __forceinline__ bf16x8 packf8(const f32x16& a, int base, float s) {
    u32x4 w; w.x = cvtpk(a[base + 0] * s, a[base + 1] * s); w.y = cvtpk(a[base + 2] * s, a[base + 3] * s); w.z = cvtpk(a[base + 4] * s, a[base + 5] * s); w.w = cvtpk(a[base + 6] * s, a[base + 7] * s);
    return __builtin_bit_cast(bf16x8, w);
}
constexpr int NKB = (SKV_S + 31) / 32;
constexpr int WROW = 528;
constexpr int PS_OFF = 69632;
constexpr int QF_OFF = 256 * WROW;
constexpr int CQ_STRIDE = 260;

__device__ __forceinline__ void unit(int b, int h, const bf16_t* __restrict__ CKVB, const bf16_t* __restrict__ KRB, const bf16_t* __restrict__ CKVN, const bf16_t* __restrict__ KRN, const bf16_t* __restrict__ CT,
                                     const bf16_t* __restrict__ Wukv_t, const bf16_t* __restrict__ QCAT, const bf16_t* __restrict__ SGM, bf16_t* MIX, LAS unsigned char* lds, LAS unsigned char* scr, int wv) {
    int lane = lane_id(); asm volatile("" : "+v"(lane));
    const int wid = wv, tid = (wv << 6) | lane, r32 = lane & 31, hh = lane >> 5;
    LAS unsigned char* qf = lds + QF_OFF;
    { const bf16_t* Wsrc = Wukv_t + (size_t)h * 256 * KVRANK;
      u32x4 wv8[8];
#pragma unroll
      for (int i = 0; i < 8; ++i) wv8[i] = *(const u32x4*)(Wsrc + (size_t)(tid + 512 * i) * 8);
#pragma unroll
      for (int i = 0; i < 8; ++i) { const int gi = tid + 512 * i, row = gi >> 5, c16 = gi & 31; *(LAS u32x4*)(lds + row * WROW + (c16 << 4)) = wv8[i]; } }
    { const bf16_t* qp = QCAT + (size_t)(MP + b * DSEQ + (r32 & 15)) * (NHEAD * DQK) + h * DQK;
      for (int f = wid; f < 12; f += 8) { u32x4 v = {0u, 0u, 0u, 0u};
          if (r32 < DSEQ) { if (f < 8) { const bf16_t* p = qp + (f >> 1) * 32 + (f & 1) * 16 + 4 * hh; const u32x2 lo = *(const u32x2*)p, hi2 = *(const u32x2*)(p + 8); v = (u32x4){lo.x, lo.y, hi2.x, hi2.y}; }
                            else v = *(const u32x4*)(qp + DNOPE + (f - 8) * 16 + 8 * hh); }
          *(LAS u32x4*)(qf + f * 1024 + lane * 16) = v; } }
    __syncthreads();
    float m_run = -1e30f, l_run = 0.f; f32x4 ol[16];
#pragma unroll
    for (int i = 0; i < 16; ++i) ol[i] = (f32x4){0.f, 0.f, 0.f, 0.f};
    LAS float* rks = (LAS float*)(lds + MISC_OFF + 256) + wid * 32;
    LAS unsigned char* ps = lds + PS_OFF + wid * 2048;
    LAS const unsigned char* wk = lds + r32 * WROW + hh * 16; LAS const unsigned char* qfl = qf + lane * 16;
    const int q16 = lane & 15, kq = lane >> 4;
    const bf16_t* ctl = CT + (size_t)lane * 8; const bf16_t* cbl = CKVB + (size_t)lane * 8;
    for (int kb = wid; kb < NKB; kb += 8) {
        int key = kb * 32 + r32; if (key > SKV_S - 1) key = SKV_S - 1;
        const bf16_t* kp = (key < PAST ? KRB + (size_t)(b * PAST + key) * DROPE : KRN + (size_t)(MP + b * DSEQ + key - PAST) * DROPE) + 8 * hh;
        f32x16 z = f32x16{}; float ssq = 0.f;
        bf16x8 rf[4];
        {
        bf16x8 cf[16];
#pragma unroll
        for (int s = 0; s < 16; ++s) cf[s] = *(const bf16x8*)(cbl + (size_t)(kb * 16 + s) * 512);
#pragma unroll
        for (int s = 0; s < 4; ++s) rf[s] = *(const bf16x8*)(kp + 16 * s);
#pragma unroll
        for (int dh = 0; dh < 2; ++dh) {
            f32x16 acc[2];
#pragma unroll
            for (int d2 = 0; d2 < 2; ++d2) { acc[d2] = f32x16{};
#pragma unroll
                for (int s = 0; s < 16; ++s) { const bf16x8 wa = *(LAS const bf16x8*)(wk + (dh * 2 + d2) * 32 * WROW + s * 32);
                    acc[d2] = __builtin_amdgcn_mfma_f32_32x32x16_bf16(wa, cf[s], acc[d2], 0, 0, 0); } }
            SBAR();
            bf16x8 kn[4];
#pragma unroll
            for (int d2 = 0; d2 < 2; ++d2) {
#pragma unroll
                for (int r = 0; r < 16; ++r) ssq += acc[d2][r] * acc[d2][r];
                kn[2 * d2] = packf8(acc[d2], 0, 1.f); kn[2 * d2 + 1] = packf8(acc[d2], 8, 1.f); }
            SBAR();
#pragma unroll
            for (int f = 0; f < 4; ++f) { const bf16x8 qb = *(LAS const bf16x8*)(qfl + (dh * 4 + f) * 1024); z = __builtin_amdgcn_mfma_f32_32x32x16_bf16(kn[f], qb, z, 0, 0, 0); }
            SBAR();
        }
        }
        bf16x8 af[16];
        { const bf16_t* ck = ctl + (size_t)kb * 16 * 512;
#pragma unroll
          for (int lb = 0; lb < 16; ++lb) af[lb] = *(const bf16x8*)(ck + lb * 512); }
        { auto rr = __builtin_amdgcn_permlane32_swap(__float_as_uint(ssq), __float_as_uint(ssq), false, false); ssq = __uint_as_float(rr[0]) + __uint_as_float(rr[1]); }
        rks[lane & 31] = 1.0f / sqrtf(ssq * (1.f / DNOPE) + EPS);
        asm volatile("s_waitcnt lgkmcnt(0)" ::: "memory");
#pragma unroll
        for (int g4 = 0; g4 < 4; ++g4) { const f32x4 rv = *(LAS const f32x4*)(rks + 8 * g4 + 4 * hh);
#pragma unroll
            for (int j = 0; j < 4; ++j) z[4 * g4 + j] *= rv[j]; }
#pragma unroll
        for (int s = 0; s < 4; ++s) { const bf16x8 qb = *(LAS const bf16x8*)(qfl + (8 + s) * 1024); z = __builtin_amdgcn_mfma_f32_32x32x16_bf16(rf[s], qb, z, 0, 0, 0); }
        SBAR();
        if (kb == NKB - 1) {
#pragma unroll
            for (int r = 0; r < 16; ++r) if (kb * 32 + crow(r, hh) >= SKV_S) z[r] = -1e30f;
        }
        float mx = z[0];
#pragma unroll
        for (int r = 1; r < 16; ++r) mx = fmaxf(mx, z[r]);
        { auto rr = __builtin_amdgcn_permlane32_swap(__float_as_uint(mx), __float_as_uint(mx), false, false); mx = fmaxf(__uint_as_float(rr[0]), __uint_as_float(rr[1])); }
        const float mn = fmaxf(m_run, mx), alpha = __builtin_amdgcn_exp2f(m_run - mn); m_run = mn;
        float psum = 0.f;
#pragma unroll
        for (int r = 0; r < 16; ++r) { z[r] = __builtin_amdgcn_exp2f(z[r] - mn); psum += z[r]; }
        l_run = l_run * alpha + psum;
        if (r32 < DSEQ) {
#pragma unroll
            for (int k4 = 0; k4 < 4; ++k4) { u32x2 w; w.x = cvtpk(z[4 * k4], z[4 * k4 + 1]); w.y = cvtpk(z[4 * k4 + 2], z[4 * k4 + 3]); *(LAS u32x2*)(ps + (r32 * 4 + k4) * 16 + 8 * hh) = w; }
            if (hh == 0) *(LAS float*)(ps + 1024 + 4 * r32) = alpha;
        }
        asm volatile("s_waitcnt lgkmcnt(0)" ::: "memory");
        const bf16x8 pf = *(LAS const bf16x8*)(ps + (q16 * 4 + kq) * 16); const float al16 = *(LAS const float*)(ps + 1024 + 4 * q16);
        SBAR();
#pragma unroll
        for (int lb = 0; lb < 16; ++lb) ol[lb] = __builtin_amdgcn_mfma_f32_16x16x32_bf16(af[lb], pf, ol[lb] * al16, 0, 0, 0);
        SBAR();
    }
    { auto rr = __builtin_amdgcn_permlane32_swap(__float_as_uint(l_run), __float_as_uint(l_run), false, false); l_run = __uint_as_float(rr[0]) + __uint_as_float(rr[1]); }
    __syncthreads();
    LAS float* comb = (LAS float*)lds; LAS float* ml = (LAS float*)(lds + QF_OFF);
    const int lane2 = lane_id(), tid2 = (wv << 6) | lane2;
    { const int qq = lane2 & 15, rq = lane2 >> 4;
#pragma unroll
      for (int lb = 0; lb < 16; ++lb) *(LAS f32x4*)(comb + (wid * 16 + qq) * CQ_STRIDE + lb * 16 + 4 * rq) = ol[lb];
      if (lane2 < DSEQ) { ml[wid * 16 + lane2] = m_run; ml[128 + wid * 16 + lane2] = l_run; } }
    __syncthreads();
    { const int q = tid2 >> 5, l0 = (tid2 & 31) * 8; float M = ml[q];
#pragma unroll
      for (int w = 1; w < 8; ++w) M = fmaxf(M, ml[w * 16 + q]);
      float L = 0.f; f32x4 a0 = {0.f, 0.f, 0.f, 0.f}, a1 = {0.f, 0.f, 0.f, 0.f};
#pragma unroll
      for (int w = 0; w < 8; ++w) { const float e = __builtin_amdgcn_exp2f(ml[w * 16 + q] - M); L += ml[128 + w * 16 + q] * e; const LAS float* cp = comb + (w * 16 + q) * CQ_STRIDE + l0;
          a0 += *(LAS const f32x4*)cp * e; a1 += *(LAS const f32x4*)(cp + 4) * e; }
      const float rl = 1.0f / L;
      __syncthreads();
      *(LAS f32x4*)(comb + q * CQ_STRIDE + l0) = a0 * rl; *(LAS f32x4*)(comb + q * CQ_STRIDE + l0 + 4) = a1 * rl; }
    __syncthreads();
    { const int q16b = lane2 & 15, kqb = lane2 >> 4; const bf16_t* wvp = Wukv_t + ((size_t)h * 256 + 128 + wid * 16 + q16b) * KVRANK + 8 * kqb;
      const LAS float* arow = comb + q16b * CQ_STRIDE + 8 * kqb;
      f32x4 od = {0.f, 0.f, 0.f, 0.f};
#pragma unroll
      for (int ks = 0; ks < 8; ++ks) { const f32x4 x0 = *(LAS const f32x4*)(arow + 32 * ks), x1 = *(LAS const f32x4*)(arow + 32 * ks + 4);
          const bf16x8 af2 = __builtin_bit_cast(bf16x8, pack8(x0, x1)); const bf16x8 bf2 = *(const bf16x8*)(wvp + 32 * ks);
          od = __builtin_amdgcn_mfma_f32_16x16x32_bf16(af2, bf2, od, 0, 0, 0); }
      const int dim = wid * 16 + q16b;
#pragma unroll
      for (int r = 0; r < 4; ++r) { const size_t row = (size_t)(MP + b * DSEQ + 4 * kqb + r);
          const float gt = bf2f(SGM[row * 1024 + h * DV + dim]); MIX[row * DM + DPOOL + h * DV + dim] = (bf16_t)(cvtpk(od[r] * gt, 0.f) & 0xffffu); } }
    __syncthreads();
}
}

__device__ __forceinline__ void bf8_to_f(const u32x4 v, float (&d)[8]) {
    d[0] = __uint_as_float(v.x << 16); d[1] = __uint_as_float(v.x & 0xffff0000u); d[2] = __uint_as_float(v.y << 16); d[3] = __uint_as_float(v.y & 0xffff0000u);
    d[4] = __uint_as_float(v.z << 16); d[5] = __uint_as_float(v.z & 0xffff0000u); d[6] = __uint_as_float(v.w << 16); d[7] = __uint_as_float(v.w & 0xffff0000u); }
template <int W>
__device__ __forceinline__ void pool_window_run(int m0, int col, const bf16_t* __restrict__ Z, const bf16_t* __restrict__ SGP, const float* __restrict__ pscale, bf16_t* MIX) {
    const bool smp = m0 >= MP; const int sb = (m0 - MP) >> 4;
    const int u0 = smp ? POOLH + ((m0 - MP) & 15) : (m0 & (SEQ - 1));
    const long base_new = smp ? (long)(MP + sb * DSEQ) - POOLH : (long)(m0 - u0);
    const long base_hist = (long)MT + sb * POOLH;
    u32x4 zr[W + 7], gq[8];
#pragma unroll
    for (int i = 0; i < W + 7; ++i) { const int u = u0 - (W - 1) + i; zr[i] = (u32x4){0u, 0u, 0u, 0u};
        if (u >= 0) zr[i] = *(const u32x4*)(Z + ((smp && u < POOLH) ? base_hist + u : base_new + u) * DPOOL + col); }
#pragma unroll
    for (int r = 0; r < 8; ++r) gq[r] = *(const u32x4*)(SGP + (size_t)(m0 + r) * DPOOL + col);
    const f32x4 p0 = *(const f32x4*)(pscale + col), p1 = *(const f32x4*)(pscale + col + 4);
    float S[8];
#pragma unroll
    for (int i = 0; i < 8; ++i) S[i] = 0.f;
#pragma unroll
    for (int k = 0; k < W - 1; ++k) { float t[8]; bf8_to_f(zr[k], t);
#pragma unroll
        for (int i = 0; i < 8; ++i) S[i] += t[i]; }
#pragma unroll
    for (int r = 0; r < 8; ++r) { const int u = u0 + r; float zc[8], gv[8], td[8], ov[8]; bf8_to_f(zr[W - 1 + r], zc); bf8_to_f(gq[r], gv); bf8_to_f(zr[r], td);
#pragma unroll
        for (int i = 0; i < 8; ++i) S[i] += zc[i];
        const int pos1 = smp ? SEQ : u + 1; const float rc = 1.0f / (float)(pos1 < W ? pos1 : W);
#pragma unroll
        for (int i = 0; i < 8; ++i) ov[i] = (S[i] * rc - zc[i]) * (i < 4 ? p0[i] : p1[i - 4]) * gv[i];
        u32x4 wv4; wv4.x = cvtpk(ov[0], ov[1]); wv4.y = cvtpk(ov[2], ov[3]); wv4.z = cvtpk(ov[4], ov[5]); wv4.w = cvtpk(ov[6], ov[7]);
        *(u32x4*)(MIX + (size_t)(m0 + r) * DM + col) = wv4;
#pragma unroll
        for (int i = 0; i < 8; ++i) S[i] -= td[i]; }
}
__device__ __forceinline__ void pool_window_block(int blk, const bf16_t* __restrict__ Z, const bf16_t* __restrict__ SGP, const float* __restrict__ pscale, bf16_t* MIX, int wv) {
    const int lane = lane_id(), g = wv & 3, m0 = blk * 32 + ((lane >> 5) + 2 * (wv >> 2)) * 8, col = g * 256 + (lane & 31) * 8;
    if (g == 0) pool_window_run<2>(m0, col, Z, SGP, pscale, MIX);
    else if (g == 1) pool_window_run<4>(m0, col, Z, SGP, pscale, MIX);
    else if (g == 2) pool_window_run<8>(m0, col, Z, SGP, pscale, MIX);
    else pool_window_run<16>(m0, col, Z, SGP, pscale, MIX);
}

#define XB_TMO      128
#define XB_XCNT(j)  (256  + 64 * (j))
#define XB_XSUB(j)  (1280 + 64 * (j))
#define XB_XGEN(j)  (2304 + 64 * (j))
#define XB_TOP      3328
#define XB_TOPGEN   3392
#define XCD_BAR_WORDS 3456
#define XB_SPIN_CAP (1u << 22)
__device__ __forceinline__ unsigned xb_ld(unsigned* p)              { return __hip_atomic_load(p, __ATOMIC_RELAXED, __HIP_MEMORY_SCOPE_AGENT); }
__device__ __forceinline__ unsigned xb_add(unsigned* p, unsigned v) { return __hip_atomic_fetch_add(p, v, __ATOMIC_RELAXED, __HIP_MEMORY_SCOPE_AGENT); }
__device__ __forceinline__ unsigned xb_xcc_id() { return (unsigned)__builtin_amdgcn_s_getreg((3 << 11) | 20) & 0xFu; }
#define XB_SPIN(cond, bar) do { unsigned _sp = 0; while (cond) { __builtin_amdgcn_s_sleep(1); \
    if ((++_sp & 255u) == 0u) { if (xb_ld(&(bar)[XB_TMO])) break; if (_sp > XB_SPIN_CAP) { atomicAdd(&(bar)[XB_TMO], 1u); break; } } } } while (0)
struct XcdBarrier { unsigned* bar; unsigned x; volatile LAS unsigned* st; };
__device__ __forceinline__ XcdBarrier xcd_barrier_post(unsigned* bar, volatile LAS unsigned* st, int wv) {
    XcdBarrier b; b.bar = bar; b.x = xb_xcc_id(); b.st = st;
    if (TIDX(wv) == 0) (void)xb_add(&bar[XB_XCNT(b.x)], 1u);
    return b;
}
__device__ __forceinline__ void xcd_barrier_complete(unsigned* bar, unsigned x, unsigned& nloc, unsigned& nx) {
    const unsigned G = gridDim.x * gridDim.y * gridDim.z;
    unsigned sum, cnt, mine, sp = 0u;
    for (;;) {
        sum = 0u; cnt = 0u; mine = 0u;
#pragma unroll
        for (unsigned j = 0; j < 16; ++j) { const unsigned c = xb_ld(&bar[XB_XCNT(j)]); sum += c; cnt += (c > 0u) ? 1u : 0u; mine = (j == x) ? c : mine; }
        if (sum == G) break;
        __builtin_amdgcn_s_sleep(1);
        if ((++sp & 255u) == 0u) { if (xb_ld(&bar[XB_TMO])) break; if (sp > XB_SPIN_CAP) { atomicAdd(&bar[XB_TMO], 1u); break; } }
    }
    nloc = mine > 0u ? mine : 1u; nx = cnt > 0u ? cnt : 1u;
}
__device__ __forceinline__ void xcd_barrier(const XcdBarrier& b, int wv) {
    asm volatile("s_waitcnt vmcnt(0)" ::: "memory");
    __syncthreads();
    if (TIDX(wv) == 0) {
        unsigned* bar = b.bar;
        __builtin_amdgcn_s_waitcnt(0);
        unsigned nloc = b.st[0], nx = b.st[1];
        if (nloc == 0u) { xcd_barrier_complete(bar, b.x, nloc, nx); b.st[0] = nloc; b.st[1] = nx; }
        const unsigned old = xb_add(&bar[XB_XSUB(b.x)], 1u);
        const unsigned gen = old / nloc;
        if (old + 1u == (gen + 1u) * nloc) {
            __builtin_amdgcn_fence(__ATOMIC_RELEASE, "agent");
            asm volatile("s_waitcnt vmcnt(0)" ::: "memory");
            const unsigned og = xb_add(&bar[XB_TOP], 1u);
            const unsigned tg = og / nx;
            if (og + 1u == (tg + 1u) * nx) xb_add(&bar[XB_TOPGEN], 1u);
            else XB_SPIN(xb_ld(&bar[XB_TOPGEN]) == tg, bar);
            __builtin_amdgcn_fence(__ATOMIC_ACQUIRE, "agent");
            xb_add(&bar[XB_XGEN(b.x)], 1u);
            asm volatile("s_waitcnt vmcnt(0)" ::: "memory");
        } else {
            XB_SPIN(xb_ld(&bar[XB_XGEN(b.x)]) == gen, bar);
            __builtin_amdgcn_fence(__ATOMIC_ACQUIRE, "agent");
            asm volatile("s_waitcnt vmcnt(0)" ::: "memory");
        }
    }
    __syncthreads();
}

constexpr int N_PHASES = 5;
__global__ void __launch_bounds__(512, 2) hymba_fwd(Args a) {
    extern __shared__ __attribute__((aligned(16))) unsigned char lds_raw[];
    LAS unsigned char* lds = (LAS unsigned char*)lds_raw;
    LAS unsigned char* scr = lds + SCR_OFF;
    volatile LAS unsigned* MISC = (volatile LAS unsigned*)(lds + MISC_OFF);
    const int wv = __builtin_amdgcn_readfirstlane((int)threadIdx.x >> 6);
    const int tid = TIDX(wv);
    const int G = gridDim.x; const int bx = blockIdx.x; const int vcu = (G % 8 == 0) ? (bx % 8) * (G / 8) + bx / 8 : bx;
    unsigned char* ws = a.ws; float* out = a.out;
    if (tid < 64) MISC[tid] = 0u;
    __syncthreads();
    XcdBarrier bar; bar.bar = (unsigned*)(ws + WS_CTL) + 1024 + a.li * XCD_BAR_WORDS; bar.x = 0; bar.st = nullptr;
    const bool one_launch = (a.ph_hi - a.ph_lo) > 1;
    if (one_launch) bar = xcd_barrier_post((unsigned*)(ws + WS_CTL) + 1024 + a.li * XCD_BAR_WORDS, MISC + 8, wv);
    const int lo = a.ph_lo, hi = a.ph_hi;
#ifndef PHASE_MASK
#define PHASE_MASK 63
#endif
#define IN(k) (((PHASE_MASK >> (k)) & 1) && lo <= (k) && (k) < hi)
#define SEAM(k) do { if (IN(k) && IN((k) + 1)) xcd_barrier(bar, wv); } while (0)
#define WSP(T, off) ((T*)(ws + (off)))
    if (IN(0)) { p0_prologue(a, lds, vcu, G, wv, 0); __syncthreads(); }
    SEAM(0);
    if (IN(1)) {
        pg8::SchedP1 S{(const char*)ws, bx, G};
        pg8::EpiInProj E{ws, out};
        pg8::gemm_phase(lds, scr, S, E, wv);
        __syncthreads(); p0_prologue(a, lds, vcu, G, wv, 1);
    }
    SEAM(1);
    if (IN(2)) {
        { pg8::SchedP2 S{(const char*)ws, bx, G};
          pg8::EpiP2 E{ws};
          pg8::gemm_phase(lds, scr, S, E, wv); }
        {
            const float* c1 = AIN(I_CCKV);
            unsigned* cctr = (unsigned*)(ws + WS_CTL) + 11520 + 64 * a.li; constexpr int NC = (DBATCH - NBT_A) * 256 / 8;
            for (;;) {
                if (TIDX(wv) == 0) MISC[22] = __hip_atomic_fetch_add(cctr, 1u, __ATOMIC_RELAXED, __HIP_MEMORY_SCOPE_AGENT);
                __syncthreads();
                const int ch = (int)MISC[22];
                __syncthreads();
                if (ch >= NC) break;
                const int item = ch * 8 + wv, bb = NBT_A + (item >> 8), kbk = (item & 255) >> 3, nb = item & 7;
                cache_item(c1 + (size_t)bb * PAST * KVRANK, ckvb_base(out, bb), ckvt_base(out, bb), 64 * kbk, 32 * nb, (LAS float*)(lds + wv * 16384), lane_id(), true, true);
            }
            { const bf16_t* CKVN = WSP(bf16_t, WS_CKVN);
              for (int i = vcu * 512 + TIDX(wv); i < DBATCH * 16 * 64; i += G * 512) { const int bb = i >> 10, sb = (i >> 6) & 15, ln = i & 63;
                  const bf16_t* nk = CKVN + (size_t)(MP + bb * DSEQ) * KVRANK; const size_t fo = ((size_t)(64 * 16 + sb) * 64 + ln) * 8;
                  { const int t = ln & 31; u32x4 w = {0u, 0u, 0u, 0u}; if (t < DSEQ) w = *(const u32x4*)(nk + (size_t)t * KVRANK + 16 * sb + 8 * (ln >> 5));
                    *(u32x4*)(ckvb_base(out, bb) + fo) = w; }
                  { const int kq = ln >> 4; u32x4 w = {0u, 0u, 0u, 0u};
                    if (kq < 2) { const bf16_t* p = nk + (size_t)(8 * kq) * KVRANK + 16 * sb + (ln & 15);
                        w.x = p[0] | ((unsigned)p[KVRANK] << 16); w.y = p[2 * KVRANK] | ((unsigned)p[3 * KVRANK] << 16); w.z = p[4 * KVRANK] | ((unsigned)p[5 * KVRANK] << 16); w.w = p[6 * KVRANK] | ((unsigned)p[7 * KVRANK] << 16); }
                    *(u32x4*)(ckvt_base(out, bb) + fo) = w; } } }
        }
    }
    SEAM(2);
    if (IN(3)) {
        const int qx = bx & 7; unsigned* ctr = (unsigned*)(ws + WS_CTL) + 8192 + 1024 * a.li + 64 * qx;
        for (;;) {
            if (TIDX(wv) == 0) MISC[20] = __hip_atomic_fetch_add(ctr, 1u, __ATOMIC_RELAXED, __HIP_MEMORY_SCOPE_AGENT);
            __syncthreads();
            const int it = (int)MISC[20];
            __syncthreads();
            if (it >= 98) break;
            if (it >= 64) { const int blk = (it - 64) * 8 + qx; pool_window_block(blk, WSP(bf16_t, WS_Z), WSP(bf16_t, WS_SGP), AIN(I_PSCALE), WSP(bf16_t, WS_MIX), wv); }
            else if (it >= 8 && it < 40) { const int j = it - 8, sb = qx * 4 + (j >> 3), sh = j & 7;
                sattn::unit(sb, sh, ckvb_base(out, sb), WSP(bf16_t, WS_KRB), WSP(bf16_t, WS_CKVN), WSP(bf16_t, WS_KRN), ckvt_base(out, sb), WSP(bf16_t, WS_WUKV), WSP(bf16_t, WS_QCAT), WSP(bf16_t, WS_SGM), WSP(bf16_t, WS_MIX), lds, scr, wv); }
            else { const int k = it < 8 ? it : it - 32, qb = 7 - (k >> 2), bh = qx * 4 + (k & 3);
                pattn::unit(bh >> 3, bh & 7, qb, WSP(bf16_t, WS_QCAT), WSP(bf16_t, WS_KCAT), WSP(bf16_t, WS_KRN), WSP(bf16_t, WS_V), WSP(bf16_t, WS_SGM), WSP(bf16_t, WS_MIX), lds, wv); }
        }
        {
            unsigned* wctr = (unsigned*)(ws + WS_CTL) + 12032 + 64 * a.li;
            __syncthreads();
            if (TIDX(wv) == 0) MISC[21] = __hip_atomic_fetch_add(wctr, 1u, __ATOMIC_RELAXED, __HIP_MEMORY_SCOPE_AGENT);
            __syncthreads();
            for (int ch = (int)MISC[21];; ) {
                __syncthreads();
                if (ch >= 512) break;
                unsigned nxt_ticket = 0u; if (TIDX(wv) == 0) nxt_ticket = __hip_atomic_fetch_add(wctr, 1u, __ATOMIC_RELAXED, __HIP_MEMORY_SCOPE_AGENT);
                p1_chunk(a, ws, 96 + ch, (LAS float*)(lds + wv * 16384), lane_id(), wv, TIDX(wv));
                if (TIDX(wv) == 0) MISC[21] = nxt_ticket;
                __syncthreads();
                ch = (int)MISC[21];
            }
        }
    }
    SEAM(3);
    if (IN(4)) {
        unsigned* pcnt = (unsigned*)(ws + WS_CTL) + 13312 + 2560 * a.li;
        pg8::EpiP45 E{ws, out};
        { pg8::SchedP45 S{(const char*)ws, pcnt, bx, G, 1}; pg8::gemm_phase(lds, scr, S, E, wv); }
        { pg8::SchedP45 S{(const char*)ws, pcnt, bx, G, 2}; pg8::gemm_phase(lds, scr, S, E, wv); }
    }
#undef IN
#undef SEAM
}

extern "C" void kernel_launch(void* const* d_in, const int* in_sizes, int n_in, void* d_out, int out_size, void* d_ws, size_t ws_size, hipStream_t stream) {
    static int grid = 0;
    if (grid == 0) {
        if (n_in != 24 || in_sizes[0] != MP * DM || out_size != 21164032 || ws_size < WS_END) {
            fprintf(stderr, "kernel_launch: shape mismatch: n_in %d in0 %d out %d ws %zu (need >= %zu)\n", n_in, n_in > 0 ? in_sizes[0] : -1, out_size, ws_size, (size_t)WS_END); grid = -1; return; }
        int dev = 0, cus = 0, per_cu = 0;
        if (hipGetDevice(&dev) != hipSuccess || hipDeviceGetAttribute(&cus, hipDeviceAttributeMultiprocessorCount, dev) != hipSuccess) { fprintf(stderr, "kernel_launch: device query failed\n"); grid = -1; return; }
        if (hipFuncSetAttribute((const void*)hymba_fwd, hipFuncAttributeMaxDynamicSharedMemorySize, LDS_BYTES) != hipSuccess) { fprintf(stderr, "kernel_launch: hipFuncSetAttribute failed\n"); grid = -1; return; }
        if (hipOccupancyMaxActiveBlocksPerMultiprocessor(&per_cu, (const void*)hymba_fwd, 512, LDS_BYTES) != hipSuccess || per_cu < 1)
            fprintf(stderr, "kernel_launch: note: occupancy query reports %d workgroups per CU\n", per_cu);
        (void)hipGetLastError();
        grid = cus;
    }
    if (grid < 0) return;
    if (hipMemsetAsync((char*)d_ws + WS_CTL, 0, CTL_ZERO_BYTES, stream) != hipSuccess) { fprintf(stderr, "kernel_launch: memset failed\n"); return; }
    Args a{};
    for (int i = 0; i < 24; ++i) a.in[i] = (const float*)d_in[i];
    a.out = (float*)d_out; a.ws = (unsigned char*)d_ws;
#if MK_N_LAUNCHES == 1
    a.ph_lo = 0; a.ph_hi = N_PHASES;
    hipLaunchKernelGGL(hymba_fwd, dim3(grid), dim3(512), LDS_BYTES, stream, a);
#else
    for (int p = 0; p < N_PHASES; ++p) { a.ph_lo = p; a.ph_hi = p + 1; hipLaunchKernelGGL(hymba_fwd, dim3(grid), dim3(512), LDS_BYTES, stream, a); }
#endif
    const hipError_t le = hipPeekAtLastError();
    if (le != hipSuccess) fprintf(stderr, "kernel_launch: launch failed: %s\n", hipGetErrorName(le));
}
```
